# Optimizing an MI355X kernel written in HIP

```python
import math
import jax, jax.numpy as jnp
from jax import lax
import numpy as np

D_MODEL = 1024
BATCH = 16
SEQ = 4096
DEPTH = 2
DEC_BATCH = 2
DEC_SEQ = 8192
PAST_LEN = 128

HEAD_DIM = 64
N_BRANCHES = 4
BRANCH_WIDTH = D_MODEL // 4
RET_HEADS = BRANCH_WIDTH // HEAD_DIM
RET_CHUNK = 128
ROPE_BASE = 10000.0
CONV_CH = BRANCH_WIDTH
CONV_WIDTH = 31
GRID_W = 64
NA_HEADS = BRANCH_WIDTH // HEAD_DIM
NA_WIN_ROWS = 8
NA_WIN_COLS = 16
NA_QBLK_COLS = 16
NA_KBLK_COLS = NA_QBLK_COLS + NA_WIN_COLS
SWA_Q_HEADS = BRANCH_WIDTH // HEAD_DIM
SWA_KV_HEADS = SWA_Q_HEADS // 2
SWA_WINDOW = 128
SWA_BLOCK = 128
T5_BUCKETS = 32
T5_MAX_DIST = 128
D_FF = 4 * D_MODEL
NORM_EPS = 1e-6
NEG_INF = -1e30
IN_SIZES = (BRANCH_WIDTH, BRANCH_WIDTH, BRANCH_WIDTH, BRANCH_WIDTH,
            CONV_CH, CONV_CH,
            BRANCH_WIDTH, BRANCH_WIDTH, BRANCH_WIDTH,
            BRANCH_WIDTH, SWA_KV_HEADS * HEAD_DIM, SWA_KV_HEADS * HEAD_DIM)
IN_COLS = sum(IN_SIZES)

kernel_name = "hybrid_gated_encoder_trunk"


def rmsnorm(x, gain):
    xf = x.astype(jnp.float32)
    y = xf * lax.rsqrt(jnp.mean(xf * xf, axis=-1, keepdims=True) + NORM_EPS)
    return (y * gain.astype(jnp.float32)).astype(x.dtype)


def layernorm(x, gain, bias):
    xf = x.astype(jnp.float32)
    mu = jnp.mean(xf, axis=-1, keepdims=True)
    var = jnp.mean(jnp.square(xf - mu), axis=-1, keepdims=True)
    y = (xf - mu) * lax.rsqrt(var + NORM_EPS)
    return (y * gain.astype(jnp.float32) + bias.astype(jnp.float32)).astype(x.dtype)


def rotary(x, pos):
    half = x.shape[-1] // 2
    inv = ROPE_BASE ** (-np.arange(half, dtype=np.float32) / half)
    ang = pos[:, None] * inv[None, :]
    cos = jnp.cos(ang)[None, :, None, :].astype(x.dtype)
    sin = jnp.sin(ang)[None, :, None, :].astype(x.dtype)
    x1, x2 = x[..., :half], x[..., half:]
    return jnp.concatenate([x1 * cos - x2 * sin, x1 * sin + x2 * cos], axis=-1)


def retention_scan(q, k, v, log_g, include_diag):
    B, T, H, dk = q.shape
    dv = v.shape[-1]
    C = RET_CHUNK
    N = T // C

    def chunks(t):
        return t.reshape(B, N, C, H, t.shape[-1]).transpose(0, 3, 1, 2, 4)

    qc, kc, vc = chunks(q), chunks(k), chunks(v)
    pos = np.arange(C, dtype=np.float32)
    diff = pos[:, None] - pos[None, :]
    mask = (diff >= 0) if include_diag else (diff > 0)
    decay = jnp.exp(jnp.where(mask, diff[None] * log_g[:, None, None], -jnp.inf)).astype(q.dtype)
    scores = jnp.einsum('bhncd,bhnmd->bhncm', qc, kc) * decay[:, None]
    o_intra = jnp.einsum('bhncm,bhnme->bhnce', scores, vc)
    zeta = jnp.exp((C - 1 - pos)[None, :] * log_g[:, None]).astype(q.dtype)[:, None, :, None]
    xi = jnp.exp((pos + 1)[None, :] * log_g[:, None]).astype(q.dtype)[:, None, :, None]
    chunk_state = jnp.einsum('bhnmd,bhnme->nbhde', kc * zeta, vc)
    g_chunk = jnp.exp(C * log_g).astype(q.dtype)[None, :, None, None]

    def step(R, u):
        return g_chunk * R + u, R

    _, R_prev = lax.scan(step, jnp.zeros((B, H, dk, dv), q.dtype), chunk_state)
    o_inter = jnp.einsum('bhncd,nbhde->bhnce', qc * xi, R_prev)
    return (o_intra + o_inter).transpose(0, 2, 3, 1, 4).reshape(B, T, H, dv)


def retention_branch(q, k, v, g, decay_logit, gn_gain):
    B, T, _ = q.shape
    pos = jnp.arange(T, dtype=jnp.float32)
    q = rotary(q.reshape(B, T, RET_HEADS, HEAD_DIM), pos) * (HEAD_DIM ** -0.5)
    k = rotary(k.reshape(B, T, RET_HEADS, HEAD_DIM), pos)
    v = v.reshape(B, T, RET_HEADS, HEAD_DIM)
    log_g = jax.nn.log_sigmoid(decay_logit.astype(jnp.float32))
    fwd = retention_scan(q, k, v, log_g[0], True)
    bwd = retention_scan(q[:, ::-1], k[:, ::-1], v[:, ::-1], log_g[1], False)[:, ::-1]
    of = (fwd + bwd).astype(jnp.float32)
    mu = jnp.mean(of, axis=-1, keepdims=True)
    var = jnp.mean(jnp.square(of - mu), axis=-1, keepdims=True)
    o = ((of - mu) * lax.rsqrt(var + NORM_EPS)).reshape(B, T, BRANCH_WIDTH) * gn_gain.astype(jnp.float32)
    return o.astype(g.dtype) * jax.nn.silu(g)


def conv_branch(a, b, dw_kernel, dw_bias, ln_gain, ln_bias):
    u = a * jax.nn.sigmoid(b)
    y = lax.conv_general_dilated(u, dw_kernel[:, None, :], window_strides=(1,),
                                 padding=[(CONV_WIDTH // 2, CONV_WIDTH // 2)],
                                 dimension_numbers=('NWC', 'WIO', 'NWC'),
                                 feature_group_count=CONV_CH) + dw_bias
    return jax.nn.silu(layernorm(y, ln_gain, ln_bias))


def neighborhood_attention(q, k, v, rpb):
    B, T, H, d = q.shape
    rows = T // GRID_W
    wr = min(NA_WIN_ROWS, rows)
    nblk = GRID_W // NA_QBLK_COLS
    qcol = np.arange(GRID_W).reshape(nblk, NA_QBLK_COLS)
    win_start = np.clip(qcol - NA_WIN_COLS // 2, 0, GRID_W - NA_WIN_COLS)
    kblk_start = np.minimum(win_start[:, 0], GRID_W - NA_KBLK_COLS)
    kcol = kblk_start[:, None] + np.arange(NA_KBLK_COLS)
    rel = kcol[:, None, :] - win_start[:, :, None]
    col_mask = (rel >= 0) & (rel < NA_WIN_COLS)
    dc_idx = np.clip(kcol[:, None, :] - qcol[:, :, None] + NA_WIN_COLS - 1, 0, 2 * NA_WIN_COLS - 2)
    kg = k.reshape(B, rows, GRID_W, H, d)[:, :, kcol]
    vg = v.reshape(B, rows, GRID_W, H, d)[:, :, kcol]
    qg = q.reshape(B, rows, nblk, NA_QBLK_COLS, H, d).transpose(1, 0, 2, 3, 4, 5)
    rpb32 = rpb.astype(jnp.float32)
    scale = d ** -0.5

    def row_block(args):
        r, q_r = args
        start = jnp.clip(r - wr // 2, 0, rows - wr)
        k_r = lax.dynamic_slice_in_dim(kg, start, wr, axis=1)
        v_r = lax.dynamic_slice_in_dim(vg, start, wr, axis=1)
        s = jnp.einsum('bjqhd,bijkhd->bhjqik', q_r, k_r).astype(jnp.float32) * scale
        dr_idx = start + jnp.arange(wr) - r + NA_WIN_ROWS - 1
        bias = rpb32[:, dr_idx][:, :, dc_idx]
        s = s + bias.transpose(0, 2, 3, 1, 4)[None]
        s = jnp.where(col_mask[:, :, None, :], s, NEG_INF)
        p = jax.nn.softmax(s.reshape(B, H, nblk, NA_QBLK_COLS, wr * NA_KBLK_COLS), axis=-1)
        p = p.reshape(s.shape).astype(v.dtype)
        return jnp.einsum('bhjqik,bijkhd->bjqhd', p, v_r)

    out = lax.map(row_block, (jnp.arange(rows), qg))
    return out.transpose(1, 0, 2, 3, 4, 5).reshape(B, T, H * d)


def t5_bucket(rel):
    half = T5_BUCKETS // 2
    exact = half // 2
    n = np.abs(rel)
    large = exact + (np.log(np.maximum(n, 1) / exact) / math.log(T5_MAX_DIST / exact) * (half - exact)).astype(np.int64)
    large = np.minimum(large, half - 1)
    return (rel > 0).astype(np.int64) * half + np.where(n < exact, n, large)


def sliding_window_attention(q, k, v, t5_bias, sink):
    B, T, Hq, d = q.shape
    Hkv = k.shape[2]
    G = Hq // Hkv
    nb = T // SWA_BLOCK
    KB = 3 * SWA_BLOCK
    qb = q.reshape(B, nb, SWA_BLOCK, Hkv, G, d)

    def band(t):
        tb = t.reshape(B, nb, SWA_BLOCK, Hkv, d)
        tp = jnp.pad(tb, ((0, 0), (1, 1), (0, 0), (0, 0), (0, 0)))
        return jnp.concatenate([tp[:, :-2], tp[:, 1:-1], tp[:, 2:]], axis=2)

    kb, vb = band(k), band(v)
    kpos = np.arange(KB) - SWA_BLOCK
    rel = kpos[None, :] - np.arange(SWA_BLOCK)[:, None]
    abs_kpos = np.arange(nb)[:, None] * SWA_BLOCK + kpos[None, :]
    valid = (np.abs(rel) <= SWA_WINDOW)[None] & ((abs_kpos >= 0) & (abs_kpos < T))[:, None, :]
    bias = t5_bias.astype(jnp.float32)[t5_bucket(rel)]
    bias = bias.transpose(2, 0, 1).reshape(Hkv, G, 1, SWA_BLOCK, KB)
    s = jnp.einsum('bnqhgd,bnshd->bhgnqs', qb, kb).astype(jnp.float32) * (d ** -0.5) + bias
    s = jnp.where(valid, s, NEG_INF)
    sk = sink.astype(jnp.float32).reshape(Hkv, G, 1, 1)
    m = jnp.maximum(jnp.max(s, axis=-1), sk)
    p = jnp.exp(s - m[..., None])
    denom = jnp.sum(p, axis=-1) + jnp.exp(sk - m)
    p = (p / denom[..., None]).astype(v.dtype)
    out = jnp.einsum('bhgnqs,bnshd->bnqhgd', p, vb)
    return out.reshape(B, T, Hq * d)


def mixer(h, w_in, ret_decay_logit, ret_gn_gain, conv_dw_kernel, conv_dw_bias, conv_ln_gain, conv_ln_bias,
          na_rpb, swa_sink, t5_bias, w_branch, w_merge, w_out):
    B, T, _ = h.shape
    split_points = [int(s) for s in np.cumsum(IN_SIZES)[:-1]]
    rq, rk, rv, rg, ca, cb, nq, nk, nv, sq, sk, sv = jnp.split(h @ w_in, split_points, axis=-1)
    ret = retention_branch(rq, rk, rv, rg, ret_decay_logit, ret_gn_gain)
    conv = conv_branch(ca, cb, conv_dw_kernel, conv_dw_bias, conv_ln_gain, conv_ln_bias)
    na = neighborhood_attention(nq.reshape(B, T, NA_HEADS, HEAD_DIM), nk.reshape(B, T, NA_HEADS, HEAD_DIM),
                                nv.reshape(B, T, NA_HEADS, HEAD_DIM), na_rpb)
    swa = sliding_window_attention(sq.reshape(B, T, SWA_Q_HEADS, HEAD_DIM), sk.reshape(B, T, SWA_KV_HEADS, HEAD_DIM),
                                   sv.reshape(B, T, SWA_KV_HEADS, HEAD_DIM), t5_bias, swa_sink)
    branches = (ret, conv, na, swa)
    merged = jax.nn.sigmoid(h @ w_merge[0]) * (branches[0] @ w_branch[0])
    for i in range(1, N_BRANCHES):
        merged = merged + jax.nn.sigmoid(h @ w_merge[i]) * (branches[i] @ w_branch[i])
    return merged @ w_out


def trunk(x, c, w_ada, b_ada, norm_gain, w_in, ret_decay_logit, ret_gn_gain, conv_dw_kernel, conv_dw_bias,
          conv_ln_gain, conv_ln_bias, na_rpb, swa_sink, t5_bias, w_branch, w_merge, w_out, w_ff1, w_ff2, final_gain):
    for l in range(DEPTH):
        mod = jax.nn.silu(c) @ w_ada[l] + b_ada[l]
        sh1, sc1, g1, sh2, sc2, g2 = [m[:, None, :] for m in jnp.split(mod, 6, axis=-1)]
        h = rmsnorm(x, norm_gain[l, 0]) * (1 + sc1) + sh1
        x = x + g1 * mixer(h, w_in[l], ret_decay_logit[l], ret_gn_gain[l], conv_dw_kernel[l], conv_dw_bias[l],
                           conv_ln_gain[l], conv_ln_bias[l], na_rpb[l], swa_sink[l], t5_bias,
                           w_branch[l], w_merge[l], w_out[l])
        h = rmsnorm(x, norm_gain[l, 1]) * (1 + sc2) + sh2
        x = x + g2 * (jnp.square(jax.nn.relu(h @ w_ff1[l])) @ w_ff2[l])
    return rmsnorm(x, final_gain)


def setup_inputs(seed: int = 0) -> dict:
    key = jax.random.key(seed)
    ks = jax.random.split(key, 24)

    def nrm(k, shape, scale):
        return jax.random.normal(k, shape, jnp.float32) * scale

    gamma = 1.0 - 2.0 ** (-5.0 - np.arange(RET_HEADS))
    base_logit = np.log(gamma / (1.0 - gamma)).astype(np.float32)
    return {
        "x_prompt": nrm(ks[0], (BATCH, SEQ, D_MODEL), 1.0),
        "x_sample": nrm(ks[1], (DEC_BATCH, DEC_SEQ, D_MODEL), 1.0),
        "c_prompt": nrm(ks[2], (BATCH, D_MODEL), 1.0),
        "c_sample": nrm(ks[3], (DEC_BATCH, D_MODEL), 1.0),
        "w_ada": nrm(ks[4], (DEPTH, D_MODEL, 6 * D_MODEL), 0.5 * D_MODEL ** -0.5),
        "b_ada": nrm(ks[5], (DEPTH, 6 * D_MODEL), 0.02),
        "norm_gain": 1.0 + nrm(ks[6], (DEPTH, 2, D_MODEL), 0.02),
        "w_in": nrm(ks[7], (DEPTH, D_MODEL, IN_COLS), D_MODEL ** -0.5),
        "ret_decay_logit": jnp.asarray(base_logit) + nrm(ks[8], (DEPTH, 2, RET_HEADS), 0.1),
        "ret_gn_gain": 1.0 + nrm(ks[9], (DEPTH, BRANCH_WIDTH), 0.02),
        "conv_dw_kernel": nrm(ks[10], (DEPTH, CONV_WIDTH, CONV_CH), CONV_WIDTH ** -0.5),
        "conv_dw_bias": nrm(ks[11], (DEPTH, CONV_CH), 0.02),
        "conv_ln_gain": 1.0 + nrm(ks[12], (DEPTH, CONV_CH), 0.02),
        "conv_ln_bias": nrm(ks[13], (DEPTH, CONV_CH), 0.02),
        "na_rpb": nrm(ks[14], (DEPTH, NA_HEADS, 2 * NA_WIN_ROWS - 1, 2 * NA_WIN_COLS - 1), 0.1),
        "swa_sink": nrm(ks[15], (DEPTH, SWA_Q_HEADS), 0.5),
        "t5_bias": nrm(ks[16], (T5_BUCKETS, SWA_Q_HEADS), 0.1),
        "w_branch": nrm(ks[17], (DEPTH, N_BRANCHES, BRANCH_WIDTH, D_MODEL), BRANCH_WIDTH ** -0.5),
        "w_merge": nrm(ks[18], (DEPTH, N_BRANCHES, D_MODEL, D_MODEL), D_MODEL ** -0.5),
        "w_out": nrm(ks[19], (DEPTH, D_MODEL, D_MODEL), D_MODEL ** -0.5),
        "w_ff1": nrm(ks[20], (DEPTH, D_MODEL, D_FF), D_MODEL ** -0.5),
        "w_ff2": nrm(ks[21], (DEPTH, D_FF, D_MODEL), D_FF ** -0.5),
        "final_gain": 1.0 + nrm(ks[22], (D_MODEL,), 0.02),
    }


def reference(x_prompt, x_sample, c_prompt, c_sample, w_ada, b_ada, norm_gain, w_in, ret_decay_logit, ret_gn_gain,
              conv_dw_kernel, conv_dw_bias, conv_ln_gain, conv_ln_bias, na_rpb, swa_sink, t5_bias,
              w_branch, w_merge, w_out, w_ff1, w_ff2, final_gain):
    y_prompt = trunk(x_prompt, c_prompt, w_ada, b_ada, norm_gain, w_in, ret_decay_logit, ret_gn_gain,
                     conv_dw_kernel, conv_dw_bias, conv_ln_gain, conv_ln_bias, na_rpb, swa_sink, t5_bias,
                     w_branch, w_merge, w_out, w_ff1, w_ff2, final_gain)
    y_sample = trunk(x_sample, c_sample, w_ada, b_ada, norm_gain, w_in, ret_decay_logit, ret_gn_gain,
                     conv_dw_kernel, conv_dw_bias, conv_ln_gain, conv_ln_bias, na_rpb, swa_sink, t5_bias,
                     w_branch, w_merge, w_out, w_ff1, w_ff2, final_gain)
    return (y_prompt, y_sample)
```

```cpp
#include <hip/hip_runtime.h>
#include <hip/hip_cooperative_groups.h>
#include <cstdio>
namespace cg = cooperative_groups;

typedef unsigned short u16;
typedef short bf16x8 __attribute__((ext_vector_type(8)));
typedef float f32x4 __attribute__((ext_vector_type(4)));
#define DEVI __device__ __forceinline__

constexpr int M = 81920;
constexpr int MP = 65536;
constexpr int SMEM_BYTES = 131072;
constexpr int NTHR = 512;
constexpr int MH = M;

struct Params {
  const float* in[23];
  float* out;
  unsigned char* ws;
};

constexpr size_t SZ_WIN = 3072ull * 1024, SZ_WMERGE = 4ull * 1024 * 1024, SZ_WBRANCH = 4ull * 1024 * 256,
                 SZ_WOUT = 1024ull * 1024, SZ_WFF = 4096ull * 1024;
constexpr size_t OFF_WIN = 0;
constexpr size_t OFF_WMERGE = OFF_WIN + 2 * SZ_WIN * 2;
constexpr size_t OFF_WBRANCH = OFF_WMERGE + 2 * SZ_WMERGE * 2;
constexpr size_t OFF_WOUT = OFF_WBRANCH + 2 * SZ_WBRANCH * 2;
constexpr size_t OFF_WFF1 = OFF_WOUT + 2 * SZ_WOUT * 2;
constexpr size_t OFF_WFF2 = OFF_WFF1 + 2 * SZ_WFF * 2;
constexpr size_t OFF_MOD = OFF_WFF2 + 2 * SZ_WFF * 2;
constexpr size_t OFF_ROPE = OFF_MOD + 2ull * 18 * 6144 * 4;
constexpr size_t OFF_H = OFF_ROPE + 8192ull * 64 * 4;
constexpr size_t OFF_X = OFF_H + (size_t)M * 1024 * 2;
constexpr size_t C256 = (size_t)M * 256 * 2, C128 = (size_t)M * 128 * 2;
constexpr size_t OFF_RQ = OFF_X;
constexpr size_t OFF_RK = OFF_RQ + C256;
constexpr size_t OFF_RKT = OFF_RK + C256;
constexpr size_t OFF_RVT = OFF_RKT + C256;
constexpr size_t OFF_RG = OFF_RVT + C256;
constexpr size_t OFF_CA = OFF_RG + C256;
constexpr size_t OFF_CB = OFF_CA + C256;
constexpr size_t OFF_NQ = OFF_CB + C256;
constexpr size_t OFF_NK = OFF_NQ + C256;
constexpr size_t OFF_NVT = OFF_NK + C256;
constexpr size_t OFF_SQ = OFF_NVT + C256;
constexpr size_t OFF_SK = OFF_SQ + C256;
constexpr size_t OFF_SVT = OFF_SK + C128;
constexpr size_t OFF_U = OFF_SVT + C128;
constexpr size_t OFF_R = OFF_U + 2560ull * 2 * 4096 * 4;
constexpr size_t OFF_BR = OFF_R + 2560ull * 2 * 4096 * 2;
constexpr size_t OFF_END = OFF_BR + (size_t)M * 1024 * 2;
constexpr size_t OFF_BAR = OFF_END;
constexpr size_t WS_NEED = OFF_BAR + 1024;
constexpr size_t OFF_MERGED = OFF_H;
constexpr size_t OFF_GATES = OFF_X;
static_assert(OFF_GATES + (size_t)MH * 4096 * 2 <= OFF_END, "gates fit");
constexpr size_t OFF_HID = OFF_X;
static_assert(OFF_HID + (size_t)M * 4096 * 2 <= OFF_END, "hid fits");

DEVI u16 f2bf(float f) {
  unsigned u = __float_as_uint(f);
  u += 0x7fffu + ((u >> 16) & 1u);
  return (u16)(u >> 16);
}
DEVI float bf2f(u16 h) { return __uint_as_float(((unsigned)h) << 16); }
typedef __bf16 bf16x2_t __attribute__((ext_vector_type(2)));
typedef float f32x2_t __attribute__((ext_vector_type(2)));
DEVI unsigned pack2(float a, float b) {
  f32x2_t v = {a, b};
  bf16x2_t r = __builtin_convertvector(v, bf16x2_t);
  return __builtin_bit_cast(unsigned, r);
}
DEVI uint2 pack4(float a, float b, float c, float d) { return make_uint2(pack2(a, b), pack2(c, d)); }
DEVI float lo16(unsigned u) { return __uint_as_float(u << 16); }
DEVI float hi16(unsigned u) { return __uint_as_float(u & 0xffff0000u); }
union V8 { bf16x8 v; uint4 u; uint2 h[2]; };
DEVI f32x4 mfma16(bf16x8 a, bf16x8 b, f32x4 c) { return __builtin_amdgcn_mfma_f32_16x16x32_bf16(a, b, c, 0, 0, 0); }
DEVI float wave_sum(float v) {
#pragma unroll
  for (int o = 32; o; o >>= 1) v += __shfl_xor(v, o);
  return v;
}
DEVI float fast_rcp(float x) { return __builtin_amdgcn_rcpf(x); }
DEVI float fast_exp(float x) { return __builtin_amdgcn_exp2f(x * 1.4426950408889634f); }
DEVI float sigmoidf_(float x) { return fast_rcp(1.f + fast_exp(-x)); }
DEVI void tokinfo(int tok, int& seq, int& pos, int& T) {
  if (tok < MP) { seq = tok >> 12; pos = tok & 4095; T = 4096; }
  else { int u = tok - MP; seq = 16 + (u >> 13); pos = u & 8191; T = 8192; }
}
DEVI float log_sigmoid(float x) { return -log1pf(expf(-x)); }

DEVI int otid() { int t = threadIdx.x; asm volatile("" : "+v"(t)); return t; }
DEVI int obid() { int t = blockIdx.x; asm volatile("" : "+s"(t)); return t; }
DEVI u16* hbuf(const Params& p) { return (u16*)p.out; }
DEVI u16* brbuf(const Params& p) { return (u16*)p.out + (size_t)M * 1024; }
DEVI u16* xbuf(const Params& p) { return (u16*)(p.ws + OFF_H); }
template <int MI, int NI>
DEVI void gemm_mainloop(const u16* __restrict__ X, int ldx, const u16* __restrict__ Y, int ldy, int K,
                        f32x4 (&acc)[MI][NI], u16* smem) {
  constexpr int XR = MI * 32, YR = NI * 64, LD = 72;
  constexpr int XP = XR / 64, YP = YR / 64;
  u16* sX = smem;
  u16* sY = smem + 2 * XR * LD;
  const int tid = otid(), lane = tid & 63, wid = tid >> 6, wr = wid >> 2, wc = wid & 3, fr = lane & 15,
            fq = lane >> 4;
  const int lrow = tid >> 3, lch = tid & 7;
  uint4 rx[XP], ry[YP];
  const u16* xp = X + (size_t)lrow * ldx + lch * 8;
  const u16* yp = Y + (size_t)lrow * ldy + lch * 8;
#pragma unroll
  for (int i = 0; i < XP; ++i) rx[i] = *(const uint4*)(xp + (size_t)i * 64 * ldx);
#pragma unroll
  for (int i = 0; i < YP; ++i) ry[i] = *(const uint4*)(yp + (size_t)i * 64 * ldy);
#pragma unroll
  for (int i = 0; i < XP; ++i) *(uint4*)(sX + (lrow + i * 64) * LD + lch * 8) = rx[i];
#pragma unroll
  for (int i = 0; i < YP; ++i) *(uint4*)(sY + (lrow + i * 64) * LD + lch * 8) = ry[i];
  __syncthreads();
  const int nk = K >> 6;
  for (int kt = 0; kt < nk; ++kt) {
    const int cur = kt & 1;
    const bool more = (kt + 1 < nk);
    if (more) {
#pragma unroll
      for (int i = 0; i < XP; ++i) rx[i] = *(const uint4*)(xp + (size_t)i * 64 * ldx + (kt + 1) * 64);
#pragma unroll
      for (int i = 0; i < YP; ++i) ry[i] = *(const uint4*)(yp + (size_t)i * 64 * ldy + (kt + 1) * 64);
    }
    const u16* cx = sX + cur * XR * LD + (wr * MI * 16 + fr) * LD + fq * 8;
    const u16* cy = sY + cur * YR * LD + (wc * NI * 16 + fr) * LD + fq * 8;
#pragma unroll
    for (int ks = 0; ks < 2; ++ks) {
      bf16x8 a[MI], b[NI];
#pragma unroll
      for (int mi = 0; mi < MI; ++mi) a[mi] = *(const bf16x8*)(cx + mi * 16 * LD + ks * 32);
#pragma unroll
      for (int ni = 0; ni < NI; ++ni) b[ni] = *(const bf16x8*)(cy + ni * 16 * LD + ks * 32);
#pragma unroll
      for (int mi = 0; mi < MI; ++mi)
#pragma unroll
        for (int ni = 0; ni < NI; ++ni) acc[mi][ni] = mfma16(a[mi], b[ni], acc[mi][ni]);
    }
    if (more) {
      u16* dx = sX + (cur ^ 1) * XR * LD;
      u16* dy = sY + (cur ^ 1) * YR * LD;
#pragma unroll
      for (int i = 0; i < XP; ++i) *(uint4*)(dx + (lrow + i * 64) * LD + lch * 8) = rx[i];
#pragma unroll
      for (int i = 0; i < YP; ++i) *(uint4*)(dy + (lrow + i * 64) * LD + lch * 8) = ry[i];
    }
    __syncthreads();
  }
}

#define LAS __attribute__((address_space(3)))
namespace g8 {
constexpr int BM = 256, BK = 64, HALF = 128, HTB = HALF * BK * 2, NXCD = 8, WGM = 8;
DEVI int lds_byte(int r, int c) {
  const int st = (r >> 4) * 2 + (c >> 5), rr = r & 15, cc = c & 31, ob = rr * 64 + cc * 2;
  return st * 1024 + (ob ^ (((ob >> 9) & 1) << 5));
}
DEVI void stage_rc(int b, int& R, int& C) {
  const int st = b / 1024, sb = b % 1024, swz = sb ^ (((sb >> 9) & 1) << 5);
  R = (st >> 1) * 16 + swz / 64;
  C = (st & 1) * 32 + (swz % 64) / 2;
}
struct Unit { int pm, pn, aux; size_t aoff, boff; };
struct Order {
  int nM, nN, nwg, G, c, K;
  DEVI void init(int nM_, int nN_, int G_, int c_, int K_ = 1024) { nM = nM_; nN = nN_; nwg = nM * nN; G = G_; c = c_; K = K_; }
  DEVI bool next(int i, Unit& u) const {
    const long L = (long)i * G + c;
    if (L >= nwg) return false;
    int wgid = (int)L;
    {
      const int q = nwg / NXCD, r = nwg % NXCD, xcd = wgid % NXCD, off = wgid / NXCD;
      wgid = (xcd < r ? xcd * (q + 1) : r * (q + 1) + (xcd - r) * q) + off;
    }
    const int nig = WGM * nN, gid = wgid / nig, fm = gid * WGM, gsz = (nM - fm) < WGM ? (nM - fm) : WGM;
    u.pm = fm + ((wgid % nig) % gsz);
    u.pn = (wgid % nig) / gsz;
    u.aux = 0;
    u.aoff = (size_t)u.pm * 512 * K;
    u.boff = (size_t)u.pn * 512 * K;
    return true;
  }
};

DEVI int perm32(int rho) { const int n = rho >> 4, i = rho & 15; return 8 * (i >> 2) + 4 * n + (i & 3); }
template <bool PERM, class Epi, class Sched>
DEVI void gemm_phase(LAS unsigned char* lds, const u16* gA, const u16* gBt, const int K, const Sched& S, const Epi& E) {
  const int tid = otid(), wid = __builtin_amdgcn_readfirstlane(tid >> 6), lane = tid & 63, wr = wid >> 2, wc = wid & 3,
            fr = lane & 15, fq = lane >> 4;
  const int nt = K / BK;
  unsigned voffA[2], voffB[2];
#pragma unroll
  for (int i = 0; i < 2; ++i) {
    int R, C;
    stage_rc(tid * 16 + i * 8192, R, C);
    voffA[i] = (unsigned)(R * K + C) * 2u;
    const int Rb = PERM ? ((R & ~31) + perm32(R & 31)) : R;
    voffB[i] = (unsigned)(Rb * K + C) * 2u;
  }
  const size_t kstep = (size_t)(BK * 2);
  const size_t hstep = (size_t)HALF * K * 2;
  const unsigned ldsw = (unsigned)wid * 1024u;
  const int aoff = lds_byte(wr * 64 + fr, fq * 8), boff = lds_byte(wc * 32 + fr, fq * 8);
#define G8_SA(b, h) (((b) * 2 + (h)) * HTB)
#define G8_SB(b, h) ((4 + (b) * 2 + (h)) * HTB)
#define G8_STAGEV(bufoff, gbase, voff) do { _Pragma("unroll") for (int _i = 0; _i < 2; ++_i) \
    __builtin_amdgcn_global_load_lds((const unsigned*)((const char*)(gbase) + (voff)[_i]), (LAS unsigned*)(lds + (bufoff) + ldsw + _i * 8192), 16, 0, 0); } while (0)
#define G8_LDA(dst, b, h) do { _Pragma("unroll") for (int m = 0; m < 4; ++m) _Pragma("unroll") for (int k = 0; k < 2; ++k) dst[m][k] = *(const LAS bf16x8*)(lds + G8_SA(b, h) + aoff + m * 2048 + k * 1024); } while (0)
#define G8_LDB(dst, b, h) do { _Pragma("unroll") for (int n = 0; n < 2; ++n) _Pragma("unroll") for (int k = 0; k < 2; ++k) dst[n][k] = *(const LAS bf16x8*)(lds + G8_SB(b, h) + boff + n * 2048 + k * 1024); } while (0)
#define G8_MMA(ai, bj, At, Bt) do { __builtin_amdgcn_s_setprio(1); _Pragma("unroll") for (int m = 0; m < 4; ++m) _Pragma("unroll") for (int n = 0; n < 2; ++n) _Pragma("unroll") for (int k = 0; k < 2; ++k) \
    acc[ai][bj][m][n] = __builtin_amdgcn_mfma_f32_16x16x32_bf16(Bt[n][k], At[m][k], acc[ai][bj][m][n], 0, 0, 0); __builtin_amdgcn_s_setprio(0); } while (0)
#define G8_WAIT_V(n) asm volatile("s_waitcnt vmcnt(" #n ")" ::: "memory")
#define G8_WAIT_L(n) asm volatile("s_waitcnt lgkmcnt(" #n ")" ::: "memory")
#define G8_BAR __builtin_amdgcn_s_barrier()
#define G8_SCHED __builtin_amdgcn_sched_barrier(0)
  Unit cur, nxt;
  int ui = 0;
  if (!S.next(0, cur)) return;
  f32x4 acc[2][2][4][2];
#pragma unroll
  for (int a = 0; a < 2; ++a)
#pragma unroll
    for (int b = 0; b < 2; ++b)
#pragma unroll
      for (int m = 0; m < 4; ++m)
#pragma unroll
        for (int n = 0; n < 2; ++n) acc[a][b][m][n] = f32x4{0.f, 0.f, 0.f, 0.f};
  bf16x8 At[4][2], B0[2][2], B1[2][2];
  const char* cA = (const char*)gA + cur.aoff;
  const char* cB = (const char*)gBt + cur.boff;
  G8_STAGEV(G8_SB(0, 0), cB, voffB); G8_STAGEV(G8_SA(0, 0), cA, voffA); G8_STAGEV(G8_SB(0, 1), cB + hstep, voffB); G8_STAGEV(G8_SA(0, 1), cA + hstep, voffA);
  if (wr == 1) G8_BAR;
  G8_WAIT_V(4); G8_BAR;
  G8_STAGEV(G8_SB(1, 0), cB + kstep, voffB); G8_STAGEV(G8_SA(1, 0), cA + kstep, voffA); G8_STAGEV(G8_SB(1, 1), cB + hstep + kstep, voffB);
  G8_WAIT_V(6); G8_BAR;
  for (;;) {
    const bool has_next = S.next(ui + 1, nxt);
    const char* nA = has_next ? (const char*)gA + nxt.aoff : cA;
    const char* nB = has_next ? (const char*)gBt + nxt.boff : cB;
    for (int t = 0; t < nt; t += 2) {
      const bool last = (t == nt - 2);
      const char* a1 = cA + (size_t)(t + 1) * kstep;
      const char* a2 = last ? nA : cA + (size_t)(t + 2) * kstep;
      const char* b2 = last ? nB : cB + (size_t)(t + 2) * kstep;
      const char* a3 = a2 + kstep;
      const char* b3 = b2 + kstep;
      G8_LDB(B0, 0, 0); G8_SCHED; G8_LDA(At, 0, 0); G8_STAGEV(G8_SA(1, 1), a1 + hstep, voffA);
      G8_WAIT_L(8); G8_BAR; G8_WAIT_L(0); G8_MMA(0, 0, At, B0); G8_BAR; G8_SCHED;
      G8_LDB(B1, 0, 1); G8_STAGEV(G8_SB(0, 0), b2, voffB);
      G8_BAR; G8_WAIT_L(0); G8_MMA(0, 1, At, B1); G8_BAR;
      G8_LDA(At, 0, 1); G8_STAGEV(G8_SA(0, 0), a2, voffA);
      G8_BAR; G8_WAIT_L(0); G8_MMA(1, 0, At, B0); G8_BAR; G8_SCHED;
      G8_STAGEV(G8_SB(0, 1), b2 + hstep, voffB);
      G8_WAIT_V(6); G8_BAR; G8_MMA(1, 1, At, B1); G8_BAR;
      G8_LDB(B0, 1, 0); G8_SCHED; G8_LDA(At, 1, 0); G8_STAGEV(G8_SA(0, 1), a2 + hstep, voffA);
      G8_WAIT_L(8); G8_BAR; G8_WAIT_L(0); G8_MMA(0, 0, At, B0); G8_BAR; G8_SCHED;
      G8_LDB(B1, 1, 1); G8_STAGEV(G8_SB(1, 0), b3, voffB);
      G8_BAR; G8_WAIT_L(0); G8_MMA(0, 1, At, B1); G8_BAR;
      G8_LDA(At, 1, 1); G8_STAGEV(G8_SA(1, 0), a3, voffA);
      G8_BAR; G8_WAIT_L(0); G8_MMA(1, 0, At, B0); G8_BAR; G8_SCHED;
      G8_STAGEV(G8_SB(1, 1), b3 + hstep, voffB);
      G8_WAIT_V(6); G8_BAR; G8_MMA(1, 1, At, B1); G8_BAR;
    }
    const bool zr = E(acc, cur, wr, wc, fr, fq);
    if (!has_next) break;
    if (zr)
#pragma unroll
    for (int a = 0; a < 2; ++a)
#pragma unroll
      for (int b = 0; b < 2; ++b)
#pragma unroll
        for (int m = 0; m < 4; ++m)
#pragma unroll
          for (int n = 0; n < 2; ++n) acc[a][b][m][n] = f32x4{0.f, 0.f, 0.f, 0.f};
    cur = nxt; cA = nA; cB = nB; ++ui;
  }
  G8_WAIT_V(0);
  if (wr == 0) G8_BAR;
  G8_BAR;
#undef G8_SA
#undef G8_SB
#undef G8_STAGEV
#undef G8_LDA
#undef G8_LDB
#undef G8_MMA
#undef G8_WAIT_V
#undef G8_WAIT_L
#undef G8_BAR
#undef G8_SCHED
}
}

template <int MI, int NI>
DEVI void zero_acc(f32x4 (&acc)[MI][NI]) {
#pragma unroll
  for (int mi = 0; mi < MI; ++mi)
#pragma unroll
    for (int ni = 0; ni < NI; ++ni) acc[mi][ni] = f32x4{0.f, 0.f, 0.f, 0.f};
}

DEVI void mod_item(const Params& p, int item, float* smf) {
  const int l = item / 192, n0 = (item % 192) * 32;
  const int tid = otid();
  for (int i = tid; i < 18 * 1024; i += NTHR) {
    int s = i >> 10, k = i & 1023;
    float c = s < 16 ? p.in[2][s * 1024 + k] : p.in[3][(s - 16) * 1024 + k];
    smf[i] = c / (1.f + expf(-c));
  }
  __syncthreads();
  const int ks = tid >> 5, col = tid & 31;
  float acc[18];
#pragma unroll
  for (int s = 0; s < 18; ++s) acc[s] = 0.f;
  const float* w = p.in[4] + ((size_t)l * 1024 + ks * 64) * 6144 + n0 + col;
#pragma unroll 4
  for (int k = 0; k < 64; ++k) {
    float wv = w[(size_t)k * 6144];
#pragma unroll
    for (int s = 0; s < 18; ++s) acc[s] += smf[s * 1024 + ks * 64 + k] * wv;
  }
  __syncthreads();
#pragma unroll
  for (int s = 0; s < 18; ++s) smf[(ks * 18 + s) * 32 + col] = acc[s];
  __syncthreads();
  float* mod = (float*)(p.ws + OFF_MOD);
  for (int i = tid; i < 18 * 32; i += NTHR) {
    int s = i >> 5, c = i & 31;
    float v = p.in[5][l * 6144 + n0 + c];
#pragma unroll
    for (int k2 = 0; k2 < 16; ++k2) v += smf[(k2 * 18 + s) * 32 + c];
    mod[(size_t)(l * 18 + s) * 6144 + n0 + c] = v;
  }
  __syncthreads();
}

DEVI void rope_table(const Params& p) {
  float* rope = (float*)(p.ws + OFF_ROPE);
  const int g0 = obid() * NTHR + otid(), gs = gridDim.x * NTHR;
  for (int g = g0; g < 8192 * 32; g += gs) {
    int pos = g >> 5, i = g & 31;
    float inv = (float)pow(10000.0, -(double)i / 32.0);
    float angf = (float)pos * inv;
    double x = (double)angf;
    const double TWO_PI = 6.283185307179586476925286766559;
    const double PI = 3.14159265358979323846264338327950288;
    double n = rint(x / TWO_PI);
    double r = x - n * TWO_PI;
    double cs = 1.0;
    if (r > 0.5 * PI) { r = PI - r; cs = -1.0; }
    else if (r < -0.5 * PI) { r = -PI - r; cs = -1.0; }
    double r2 = r * r;
    double sp = 1.0 / 51090942171709440000.0;
    sp = sp * r2 - 1.0 / 121645100408832000.0;
    sp = sp * r2 + 1.0 / 355687428096000.0;
    sp = sp * r2 - 1.0 / 1307674368000.0;
    sp = sp * r2 + 1.0 / 6227020800.0;
    sp = sp * r2 - 1.0 / 39916800.0;
    sp = sp * r2 + 1.0 / 362880.0;
    sp = sp * r2 - 1.0 / 5040.0;
    sp = sp * r2 + 1.0 / 120.0;
    sp = sp * r2 - 1.0 / 6.0;
    sp = sp * r2 + 1.0;
    double sn = sp * r;
    double cp = 1.0 / 2432902008176640000.0;
    cp = cp * r2 - 1.0 / 6402373705728000.0;
    cp = cp * r2 + 1.0 / 20922789888000.0;
    cp = cp * r2 - 1.0 / 87178291200.0;
    cp = cp * r2 + 1.0 / 479001600.0;
    cp = cp * r2 - 1.0 / 3628800.0;
    cp = cp * r2 + 1.0 / 40320.0;
    cp = cp * r2 - 1.0 / 720.0;
    cp = cp * r2 + 1.0 / 24.0;
    cp = cp * r2 - 0.5;
    cp = cp * r2 + 1.0;
    rope[pos * 64 + i] = (float)(cs * cp);
    rope[pos * 64 + 32 + i] = (float)sn;
  }
}

struct MapPlain { DEVI void operator()(int db, int& srcc, bool& perm) const { srcc = db * 64; perm = false; } };
struct MapWin {
  DEVI void operator()(int db, int& srcc, bool& perm) const {
    if (db < 32) {
      const int tile = db >> 2, b = db & 3;
      const int base = tile < 2 ? tile * 256 : (tile < 7 ? (tile + 1) * 256 : (tile + 2) * 256);
      srcc = base + b * 64;
      perm = tile < 2;
    } else {
      const int d2 = db - 32, tile = d2 >> 2, b = d2 & 3;
      if (tile == 0) srcc = 512 + b * 64;
      else if (tile == 1) srcc = 2048 + b * 64;
      else if (tile == 2) srcc = 256 + b * 64;
      else srcc = b < 2 ? 2688 + b * 64 : 2560 + (b - 2) * 64;
      perm = false;
    }
  }
};
template <class MapF>
DEVI void xpose_convert(const float* __restrict__ src, int K, int N, int NB, u16* __restrict__ dst, int rot, float* smf, MapF map) {
  const int tid = otid();
  const int ntile = (K >> 6) * NB;
  const int G = gridDim.x;
  int start = (int)obid() - (rot % G);
  if (start < 0) start += G;
  for (int t = start; t < ntile; t += G) {
    const int k0 = (t / NB) << 6, db = t % NB;
    int srcc; bool perm;
    map(db, srcc, perm);
    {
      const int ch = tid & 15, kr = tid >> 4;
#pragma unroll
      for (int ps = 0; ps < 2; ++ps) {
        int k = ps * 32 + kr;
        float4 v = *(const float4*)(src + (size_t)(k0 + k) * N + srcc + ch * 4);
        float* d = smf + k * 65 + ch * 4;
        d[0] = v.x; d[1] = v.y; d[2] = v.z; d[3] = v.w;
      }
    }
    __syncthreads();
    {
      const int kc = tid & 7, n = tid >> 3;
      const int nc = perm ? ((n >> 5) * 16 + (n & 15) + ((n >> 4) & 1) * 32) : n;
      const float* sp = smf + (kc * 8) * 65 + nc;
      uint4 o;
      o.x = pack2(sp[0], sp[65]);
      o.y = pack2(sp[2 * 65], sp[3 * 65]);
      o.z = pack2(sp[4 * 65], sp[5 * 65]);
      o.w = pack2(sp[6 * 65], sp[7 * 65]);
      *(uint4*)(dst + (size_t)(db * 64 + n) * K + k0 + kc * 8) = o;
    }
    __syncthreads();
  }
}

DEVI void phase0(const Params& p, unsigned char* smem) {
  float* smf = (float*)smem;
  for (int it = obid(); it < 384; it += gridDim.x) mod_item(p, it, smf);
  rope_table(p);
  int rot = 384;
  for (int l = 0; l < 2; ++l) {
    xpose_convert(p.in[7] + (size_t)l * 2816 * 1024, 1024, 2816, 48, (u16*)(p.ws + OFF_WIN) + (size_t)l * SZ_WIN, rot, smf, MapWin());
    rot += 768;
    for (int i = 0; i < 4; ++i) {
      xpose_convert(p.in[18] + ((size_t)l * 4 + i) * 1024 * 1024, 1024, 1024, 16,
                    (u16*)(p.ws + OFF_WMERGE) + ((size_t)l * 4 + i) * 1024 * 1024, rot, smf, MapPlain());
      rot += 256;
    }
    for (int i = 0; i < 4; ++i) {
      xpose_convert(p.in[17] + ((size_t)l * 4 + i) * 256 * 1024, 256, 1024, 16,
                    (u16*)(p.ws + OFF_WBRANCH) + ((size_t)l * 4 + i) * 256 * 1024, rot, smf, MapPlain());
      rot += 64;
    }
    xpose_convert(p.in[19] + (size_t)l * SZ_WOUT, 1024, 1024, 16, (u16*)(p.ws + OFF_WOUT) + (size_t)l * SZ_WOUT, rot, smf, MapPlain());
    rot += 256;
    xpose_convert(p.in[20] + (size_t)l * SZ_WFF, 1024, 4096, 64, (u16*)(p.ws + OFF_WFF1) + (size_t)l * SZ_WFF, rot, smf, MapPlain());
    rot += 1024;
    xpose_convert(p.in[21] + (size_t)l * SZ_WFF, 4096, 1024, 16, (u16*)(p.ws + OFF_WFF2) + (size_t)l * SZ_WFF, rot, smf, MapPlain());
    rot += 1024;
  }
}

DEVI void phase_norm(const Params& p, int layer, int which) {
  const int lane = otid() & 63, wid = otid() >> 6;
  const float* mod = (const float*)(p.ws + OFF_MOD);
  u16* H = hbuf(p);
  const u16* XB = xbuf(p);
  const float* gain = p.in[6] + (layer * 2 + which) * 1024;
  const bool first = (layer == 0 && which == 0);
  float4 g[4];
#pragma unroll
  for (int i = 0; i < 2; ++i) {
    g[2 * i] = *(const float4*)(gain + i * 512 + lane * 8);
    g[2 * i + 1] = *(const float4*)(gain + i * 512 + lane * 8 + 4);
  }
  for (int tp = obid() * 8 + wid; tp < M / 2; tp += gridDim.x * 8) {
    const int tok = tp * 2;
    int seq, pos, T;
    tokinfo(tok, seq, pos, T);
    float4 v[2][4];
    if (first) {
      const float* xr = tok < MP ? p.in[0] + (size_t)tok * 1024 : p.in[1] + (size_t)(tok - MP) * 1024;
#pragma unroll
      for (int k = 0; k < 2; ++k)
#pragma unroll
        for (int i = 0; i < 2; ++i) {
          v[k][2 * i] = *(const float4*)(xr + k * 1024 + i * 512 + lane * 8);
          v[k][2 * i + 1] = *(const float4*)(xr + k * 1024 + i * 512 + lane * 8 + 4);
        }
    } else {
      const u16* xr = XB + (size_t)tok * 1024;
#pragma unroll
      for (int k = 0; k < 2; ++k)
#pragma unroll
        for (int i = 0; i < 2; ++i) {
          const uint4 w = *(const uint4*)(xr + k * 1024 + i * 512 + lane * 8);
          v[k][2 * i] = make_float4(lo16(w.x), hi16(w.x), lo16(w.y), hi16(w.y));
          v[k][2 * i + 1] = make_float4(lo16(w.z), hi16(w.z), lo16(w.w), hi16(w.w));
        }
    }
    const float* msh = mod + (size_t)(layer * 18 + seq) * 6144 + (which ? 3 : 0) * 1024;
    const float* msc = msh + 1024;
    float4 sh[4], sc[4];
#pragma unroll
    for (int i = 0; i < 2; ++i) {
      const int c = i * 512 + lane * 8;
      sh[2 * i] = *(const float4*)(msh + c); sh[2 * i + 1] = *(const float4*)(msh + c + 4);
      sc[2 * i] = *(const float4*)(msc + c); sc[2 * i + 1] = *(const float4*)(msc + c + 4);
    }
    asm volatile("" ::: "memory");
    float ss0 = 0.f, ss1 = 0.f;
#pragma unroll
    for (int i = 0; i < 4; ++i) {
      ss0 += v[0][i].x * v[0][i].x + v[0][i].y * v[0][i].y + v[0][i].z * v[0][i].z + v[0][i].w * v[0][i].w;
      ss1 += v[1][i].x * v[1][i].x + v[1][i].y * v[1][i].y + v[1][i].z * v[1][i].z + v[1][i].w * v[1][i].w;
    }
    ss0 = wave_sum(ss0);
    ss1 = wave_sum(ss1);
    const float rs[2] = {rsqrtf(ss0 * (1.f / 1024.f) + 1e-6f), rsqrtf(ss1 * (1.f / 1024.f) + 1e-6f)};
#pragma unroll
    for (int k = 0; k < 2; ++k)
#pragma unroll
      for (int i = 0; i < 2; ++i) {
        const float rstd = rs[k];
        const float4 xa = v[k][2 * i], xb = v[k][2 * i + 1];
        const float4 ga = g[2 * i], gb = g[2 * i + 1], sa = sc[2 * i], sb2 = sc[2 * i + 1], ha = sh[2 * i], hb = sh[2 * i + 1];
        uint4 w;
        w.x = pack2(xa.x * rstd * ga.x * (1.f + sa.x) + ha.x, xa.y * rstd * ga.y * (1.f + sa.y) + ha.y);
        w.y = pack2(xa.z * rstd * ga.z * (1.f + sa.z) + ha.z, xa.w * rstd * ga.w * (1.f + sa.w) + ha.w);
        w.z = pack2(xb.x * rstd * gb.x * (1.f + sb2.x) + hb.x, xb.y * rstd * gb.y * (1.f + sb2.y) + hb.y);
        w.w = pack2(xb.z * rstd * gb.z * (1.f + sb2.z) + hb.z, xb.w * rstd * gb.w * (1.f + sb2.w) + hb.w);
        *(uint4*)(H + (size_t)(tok + k) * 1024 + i * 512 + lane * 8) = w;
      }
  }
}

DEVI void phase_final(const Params& p) {
  const int lane = otid() & 63, wid = otid() >> 6;
  const float* gain = p.in[22];
  const u16* XB = xbuf(p);
  float4 gg[4];
#pragma unroll
  for (int i = 0; i < 2; ++i) {
    gg[2 * i] = *(const float4*)(gain + i * 512 + lane * 8);
    gg[2 * i + 1] = *(const float4*)(gain + i * 512 + lane * 8 + 4);
  }
  for (int tp = obid() * 8 + wid; tp < M / 2; tp += gridDim.x * 8) {
    const u16* xr = XB + (size_t)tp * 2048;
    float* orow = p.out + (size_t)tp * 2048;
    float4 v[2][4];
#pragma unroll
    for (int k = 0; k < 2; ++k)
#pragma unroll
      for (int i = 0; i < 2; ++i) {
        const uint4 w = *(const uint4*)(xr + k * 1024 + i * 512 + lane * 8);
        v[k][2 * i] = make_float4(lo16(w.x), hi16(w.x), lo16(w.y), hi16(w.y));
        v[k][2 * i + 1] = make_float4(lo16(w.z), hi16(w.z), lo16(w.w), hi16(w.w));
      }
    asm volatile("" ::: "memory");
    float ss0 = 0.f, ss1 = 0.f;
#pragma unroll
    for (int i = 0; i < 4; ++i) {
      ss0 += v[0][i].x * v[0][i].x + v[0][i].y * v[0][i].y + v[0][i].z * v[0][i].z + v[0][i].w * v[0][i].w;
      ss1 += v[1][i].x * v[1][i].x + v[1][i].y * v[1][i].y + v[1][i].z * v[1][i].z + v[1][i].w * v[1][i].w;
    }
    ss0 = wave_sum(ss0);
    ss1 = wave_sum(ss1);
    const float rs[2] = {rsqrtf(ss0 * (1.f / 1024.f) + 1e-6f), rsqrtf(ss1 * (1.f / 1024.f) + 1e-6f)};
#pragma unroll
    for (int k = 0; k < 2; ++k)
#pragma unroll
      for (int i = 0; i < 4; ++i) {
        const int c = (i >> 1) * 512 + lane * 8 + (i & 1) * 4;
        float4 o;
        o.x = v[k][i].x * rs[k] * gg[i].x; o.y = v[k][i].y * rs[k] * gg[i].y;
        o.z = v[k][i].z * rs[k] * gg[i].z; o.w = v[k][i].w * rs[k] * gg[i].w;
        *(float4*)(orow + k * 1024 + c) = o;
      }
  }
}

struct EpiG1Nat {
  unsigned char* ws;
  DEVI bool operator()(f32x4 (&acc)[2][2][4][2], const g8::Unit& u, int wr, int wc, int fr, int fq) const {
    const int t0 = u.pm * 256, pn = u.pn;
    int seq, pos0, T;
    tokinfo(t0, seq, pos0, T);
    if (pn < 2) {
      const float* rope = (const float*)(ws + OFF_ROPE);
      u16* dst = (u16*)(ws + (pn == 0 ? OFF_RQ : OFF_RK));
      const float scale = pn == 0 ? 0.125f : 1.f;
      const int d1 = (wc & 1) * 16 + fq * 4;
      const float* rp0 = rope + (size_t)(pos0 + wr * 64 + fr) * 64 + d1;
      u16* o0 = dst + (size_t)(t0 + wr * 64 + fr) * 256 + (wc >> 1) * 64 + d1;
#pragma unroll
      for (int ai = 0; ai < 2; ++ai) {
        float4 cc[4], ss[4];
#pragma unroll
        for (int m = 0; m < 4; ++m) {
          const float* rp = rp0 + (ai * 128 + m * 16) * 64;
          cc[m] = *(const float4*)rp;
          ss[m] = *(const float4*)(rp + 32);
        }
        asm volatile("" ::: "memory");
#pragma unroll
        for (int m = 0; m < 4; ++m) {
          const float4 c = cc[m], sn = ss[m];
#pragma unroll
          for (int bj = 0; bj < 2; ++bj) {
            const f32x4 x1 = acc[ai][bj][m][0], x2 = acc[ai][bj][m][1];
            u16* o = o0 + (ai * 128 + m * 16) * 256 + bj * 128;
            *(uint2*)o = pack4((x1[0] * c.x - x2[0] * sn.x) * scale, (x1[1] * c.y - x2[1] * sn.y) * scale,
                               (x1[2] * c.z - x2[2] * sn.z) * scale, (x1[3] * c.w - x2[3] * sn.w) * scale);
            *(uint2*)(o + 32) = pack4((x1[0] * sn.x + x2[0] * c.x) * scale, (x1[1] * sn.y + x2[1] * c.y) * scale,
                                      (x1[2] * sn.z + x2[2] * c.z) * scale, (x1[3] * sn.w + x2[3] * c.w) * scale);
          }
        }
        asm volatile("" ::: "memory");
      }
    } else {
      size_t off; int width = 256, op = 0; float scale = 1.f;
      if (pn == 2) { off = OFF_RG; op = 2; }
      else if (pn == 3) { off = OFF_CA; }
      else if (pn == 4) { off = OFF_CB; op = 3; }
      else if (pn == 5) { off = OFF_NQ; scale = 0.125f; }
      else if (pn == 6) { off = OFF_NK; }
      else if (pn == 7) { off = OFF_SQ; scale = 0.125f; }
      else { off = OFF_SK; width = 128; }
      u16* o0 = (u16*)(ws + off) + (size_t)(t0 + wr * 64 + fr) * width + wc * 32 + fq * 4;
#pragma unroll
      for (int ai = 0; ai < 2; ++ai)
#pragma unroll
        for (int m = 0; m < 4; ++m) {
          u16* orow = o0 + (size_t)((ai * 128 + m * 16) * width);
#pragma unroll
          for (int bj = 0; bj < 2; ++bj) {
            if (pn == 8 && bj == 1) continue;
#pragma unroll
            for (int n = 0; n < 2; ++n) {
              const f32x4 v = acc[ai][bj][m][n];
              float q0, q1, q2, q3;
              if (op == 2) { q0 = v[0] * sigmoidf_(v[0]); q1 = v[1] * sigmoidf_(v[1]); q2 = v[2] * sigmoidf_(v[2]); q3 = v[3] * sigmoidf_(v[3]); }
              else if (op == 3) { q0 = sigmoidf_(v[0]); q1 = sigmoidf_(v[1]); q2 = sigmoidf_(v[2]); q3 = sigmoidf_(v[3]); }
              else { q0 = v[0] * scale; q1 = v[1] * scale; q2 = v[2] * scale; q3 = v[3] * scale; }
              *(uint2*)(orow + bj * 128 + n * 16) = pack4(q0, q1, q2, q3);
            }
          }
          asm volatile("" ::: "memory");
        }
    }
    return true;
  }
};
struct EpiG1Tr {
  unsigned char* ws;
  DEVI bool operator()(f32x4 (&acc)[2][2][4][2], const g8::Unit& u, int wr, int wc, int fr, int fq) const {
    const int pm = u.pm, tb = u.pn * 256;
    int seq, pos0, T;
    tokinfo(tb, seq, pos0, T);
    if (pm == 2) {
      const float* rope = (const float*)(ws + OFF_ROPE);
      u16* dst = (u16*)(ws + OFF_RKT);
      const float* rp0 = rope + (size_t)(pos0 + wc * 32 + fq * 4) * 64 + fr;
      u16* o0 = dst + (size_t)(wr * 64 + fr) * M + tb + wc * 32 + fq * 4;
#pragma unroll
      for (int ai = 0; ai < 2; ++ai)
#pragma unroll
        for (int m = 0; m < 2; ++m) {
          float cv[2][2][4], sv[2][2][4];
#pragma unroll
          for (int bj = 0; bj < 2; ++bj)
#pragma unroll
            for (int n = 0; n < 2; ++n) {
              const float* rp = rp0 + (bj * 128 + n * 16) * 64 + m * 16;
#pragma unroll
              for (int j = 0; j < 4; ++j) { cv[bj][n][j] = rp[j * 64]; sv[bj][n][j] = rp[j * 64 + 32]; }
            }
          asm volatile("" ::: "memory");
#pragma unroll
          for (int bj = 0; bj < 2; ++bj)
#pragma unroll
            for (int n = 0; n < 2; ++n) {
              const f32x4 x1 = acc[ai][bj][m][n], x2 = acc[ai][bj][m + 2][n];
              float o1[4], o2[4];
#pragma unroll
              for (int j = 0; j < 4; ++j) {
                const float c = cv[bj][n][j], sn = sv[bj][n][j];
                o1[j] = x1[j] * c - x2[j] * sn;
                o2[j] = x1[j] * sn + x2[j] * c;
              }
              u16* o = o0 + (size_t)(ai * 128 + m * 16) * M + bj * 128 + n * 16;
              *(uint2*)o = pack4(o1[0], o1[1], o1[2], o1[3]);
              *(uint2*)(o + (size_t)32 * M) = pack4(o2[0], o2[1], o2[2], o2[3]);
            }
          asm volatile("" ::: "memory");
        }
    } else {
      u16* dst = (u16*)(ws + (pm == 0 ? OFF_RVT : (pm == 1 ? OFF_NVT : OFF_SVT)));
      u16* o0 = dst + (size_t)(wr * 64 + fr) * M + tb + wc * 32 + fq * 4;
      const long half1 = pm == 3 ? ((long)(OFF_SK - OFF_SVT) / 2 - (long)128 * M) : 0;
#pragma unroll
      for (int ai = 0; ai < 2; ++ai) {
#pragma unroll
        for (int m = 0; m < 4; ++m) {
          u16* orow = o0 + (size_t)(ai * 128 + m * 16) * M + (ai ? half1 : 0);
#pragma unroll
          for (int bj = 0; bj < 2; ++bj)
#pragma unroll
            for (int n = 0; n < 2; ++n) {
              const f32x4 v = acc[ai][bj][m][n];
              *(uint2*)(orow + bj * 128 + n * 16) = pack4(v[0], v[1], v[2], v[3]);
            }
          asm volatile("" ::: "memory");
        }
      }
    }
    return true;
  }
};
DEVI void phase_gemm1(const Params& p, int layer, unsigned char* smem) {
  const u16* H = hbuf(p);
  const u16* W = (const u16*)(p.ws + OFF_WIN) + (size_t)layer * SZ_WIN;
  g8::Order S;
  S.init(M / 256, 8, gridDim.x, obid(), 1024);
  EpiG1Nat e1{p.ws};
  g8::gemm_phase<false>((LAS unsigned char*)smem, H, W, 1024, S, e1);
  g8::Order S2;
  S2.init(4, M / 256, gridDim.x, obid(), 1024);
  EpiG1Tr e2{p.ws};
  g8::gemm_phase<false>((LAS unsigned char*)smem, W + (size_t)2048 * 1024, H, 1024, S2, e2);
}

DEVI void phase_ret_u(const Params& p, int layer) {
  const int lane = otid() & 63, wid = otid() >> 6, fr = lane & 15, fq = lane >> 4;
  const u16* RKT = (const u16*)(p.ws + OFF_RKT);
  const u16* RVT = (const u16*)(p.ws + OFF_RVT);
  float* U = (float*)(p.ws + OFF_U);
  for (int u2 = obid() * 8 + wid; u2 < 5120; u2 += gridDim.x * 8) {
    const int u = u2 >> 1;
    const int h = u & 3, cgi = u >> 2, tok0 = cgi * 128;
    const float l2f = log_sigmoid(p.in[8][(layer * 2 + 0) * 4 + h]) * 1.4426950408889634f;
    const float l2b = log_sigmoid(p.in[8][(layer * 2 + 1) * 4 + h]) * 1.4426950408889634f;
#pragma unroll 1
    for (int hf = (u2 & 1); hf <= (u2 & 1); ++hf) {
      f32x4 aF[4][2], aB[4][2];
      zero_acc<4, 2>(aF);
      zero_acc<4, 2>(aB);
#pragma unroll 1
      for (int ks = 0; ks < 4; ++ks) {
        const int m0 = ks * 32 + fq * 8;
        bf16x8 av[4];
#pragma unroll
        for (int dvt = 0; dvt < 4; ++dvt)
          av[dvt] = *(const bf16x8*)(RVT + (size_t)(h * 64 + dvt * 16 + fr) * M + tok0 + m0);
#pragma unroll
        for (int d2 = 0; d2 < 2; ++d2) {
          const int dkt = hf * 2 + d2;
          uint4 kr = *(const uint4*)(RKT + (size_t)(h * 64 + dkt * 16 + fr) * M + tok0 + m0);
          const unsigned kw[4] = {kr.x, kr.y, kr.z, kr.w};
          V8 kf, kb;
          unsigned of_[4], ob_[4];
#pragma unroll
          for (int e2 = 0; e2 < 4; ++e2) {
            const int m = m0 + e2 * 2;
            const float zf0 = exp2f(l2f * (float)(127 - m)), zf1 = exp2f(l2f * (float)(126 - m));
            const float zb0 = exp2f(l2b * (float)m), zb1 = exp2f(l2b * (float)(m + 1));
            of_[e2] = pack2(lo16(kw[e2]) * zf0, hi16(kw[e2]) * zf1);
            ob_[e2] = pack2(lo16(kw[e2]) * zb0, hi16(kw[e2]) * zb1);
          }
          kf.u = make_uint4(of_[0], of_[1], of_[2], of_[3]);
          kb.u = make_uint4(ob_[0], ob_[1], ob_[2], ob_[3]);
#pragma unroll
          for (int dvt = 0; dvt < 4; ++dvt) {
            aF[dvt][d2] = mfma16(av[dvt], kf.v, aF[dvt][d2]);
            aB[dvt][d2] = mfma16(av[dvt], kb.v, aB[dvt][d2]);
          }
        }
      }
      float* uf = U + (size_t)(u * 2 + 0) * 4096;
      float* ub = U + (size_t)(u * 2 + 1) * 4096;
#pragma unroll
      for (int dvt = 0; dvt < 4; ++dvt)
#pragma unroll
        for (int d2 = 0; d2 < 2; ++d2)
#pragma unroll
          for (int j = 0; j < 4; ++j) {
            const int idx = (dvt * 16 + fq * 4 + j) * 64 + (hf * 2 + d2) * 16 + fr;
            uf[idx] = aF[dvt][d2][j];
            ub[idx] = aB[dvt][d2][j];
          }
    }
  }
}

DEVI void phase_ret_scan(const Params& p, int layer) {
  const float* U = (const float*)(p.ws + OFF_U);
  u16* R = (u16*)(p.ws + OFF_R);
  const int total = 72 * 2 * 4096;
  if (gridDim.x * NTHR == 131072) {
    const int t = obid() * NTHR + otid();
    const int e = t & 4095, dir = (t >> 12) & 1, h = (t >> 13) & 3, b0 = t >> 15;
    const float gC = expf(128.f * log_sigmoid(p.in[8][(layer * 2 + dir) * 4 + h]));
    float run[4] = {0.f, 0.f, 0.f, 0.f};
#pragma unroll 1
    for (int bb = 0; bb < 2; ++bb) {
      float uv[4][16];
#pragma unroll
      for (int q = 0; q < 4; ++q)
#pragma unroll
        for (int k = 0; k < 16; ++k) {
          const int n = dir == 0 ? (bb * 16 + k) : (31 - (bb * 16 + k));
          uv[q][k] = U[((size_t)(((b0 + 4 * q) * 32 + n) * 4 + h) * 2 + dir) * 4096 + e];
        }
      asm volatile("" ::: "memory");
#pragma unroll
      for (int q = 0; q < 4; ++q)
#pragma unroll
        for (int k = 0; k < 16; ++k) {
          const int n = dir == 0 ? (bb * 16 + k) : (31 - (bb * 16 + k));
          R[((size_t)(((b0 + 4 * q) * 32 + n) * 4 + h) * 2 + dir) * 4096 + e] = f2bf(run[q]);
          run[q] = gC * run[q] + uv[q][k];
        }
    }
    if (t < 65536) {
      const int base = 512 + (t >> 15) * 64;
      float rs = 0.f;
#pragma unroll 1
      for (int bb = 0; bb < 4; ++bb) {
        float uv[16];
#pragma unroll
        for (int k = 0; k < 16; ++k) {
          const int n = dir == 0 ? (bb * 16 + k) : (63 - (bb * 16 + k));
          uv[k] = U[((size_t)((base + n) * 4 + h) * 2 + dir) * 4096 + e];
        }
        asm volatile("" ::: "memory");
#pragma unroll
        for (int k = 0; k < 16; ++k) {
          const int n = dir == 0 ? (bb * 16 + k) : (63 - (bb * 16 + k));
          R[((size_t)((base + n) * 4 + h) * 2 + dir) * 4096 + e] = f2bf(rs);
          rs = gC * rs + uv[k];
        }
      }
    }
    return;
  }
  for (int g = obid() * NTHR + otid(); g < total; g += gridDim.x * NTHR) {
    const int e = g & 4095, dir = (g >> 12) & 1, bh = g >> 13, h = bh & 3, b = bh >> 2;
    int base, N;
    if (b < 16) { base = b * 32; N = 32; } else { base = 512 + (b - 16) * 64; N = 64; }
    const float gC = expf(128.f * log_sigmoid(p.in[8][(layer * 2 + dir) * 4 + h]));
    float run = 0.f;
    const int nb = N >> 4;
#pragma unroll 1
    for (int bb = 0; bb < nb; ++bb) {
      float uv[16];
#pragma unroll
      for (int k = 0; k < 16; ++k) {
        const int n = dir == 0 ? (bb * 16 + k) : (N - 1 - (bb * 16 + k));
        uv[k] = U[((size_t)((base + n) * 4 + h) * 2 + dir) * 4096 + e];
      }
      asm volatile("" ::: "memory");
#pragma unroll
      for (int k = 0; k < 16; ++k) {
        const int n = dir == 0 ? (bb * 16 + k) : (N - 1 - (bb * 16 + k));
        R[((size_t)((base + n) * 4 + h) * 2 + dir) * 4096 + e] = f2bf(run);
        run = gC * run + uv[k];
      }
    }
  }
}

DEVI void phase_ret_out(const Params& p, int layer, unsigned char* smem) {
  constexpr int KLD = 68, VLD = 136, RLD = 72;
  u16* Ks = (u16*)smem;
  u16* Vs = (u16*)(smem + 17408);
  u16* Rfs = (u16*)(smem + 34816);
  u16* Rbs = (u16*)(smem + 44032);
  const int tid = otid(), lane = tid & 63, wid = tid >> 6, fr = lane & 15, fq = lane >> 4;
  const u16* RQ = (const u16*)(p.ws + OFF_RQ);
  const u16* RK = (const u16*)(p.ws + OFF_RK);
  const u16* RVT = (const u16*)(p.ws + OFF_RVT);
  const u16* RG = (const u16*)(p.ws + OFF_RG);
  const u16* R = (const u16*)(p.ws + OFF_R);
  u16* BR = brbuf(p);
  const float* gn = p.in[9] + layer * 256;
  for (int it = obid(); it < 2560; it += gridDim.x) {
    const int h = it & 3, cgi = it >> 2, ctok0 = cgi * 128, c0 = wid * 16, tok0 = ctok0 + c0;
    for (int c = tid; c < 3072; c += NTHR) {
      if (c < 1024) {
        const int k = c >> 3, part = c & 7;
        const uint4 v = *(const uint4*)(RK + (size_t)(ctok0 + k) * 256 + h * 64 + part * 8);
        uint2* d = (uint2*)(Ks + k * KLD + part * 8);
        d[0] = make_uint2(v.x, v.y);
        d[1] = make_uint2(v.z, v.w);
      } else if (c < 2048) {
        const int c2 = c - 1024, d = c2 >> 4, part = c2 & 15;
        *(uint4*)(Vs + d * VLD + part * 8) = *(const uint4*)(RVT + (size_t)(h * 64 + d) * M + ctok0 + part * 8);
      } else {
        const int c2 = c - 2048, dir = c2 >> 9, c3 = c2 & 511, dv = c3 >> 3, part = c3 & 7;
        *(uint4*)((dir ? Rbs : Rfs) + dv * RLD + part * 8) =
            *(const uint4*)(R + (size_t)((cgi * 4 + h) * 2 + dir) * 4096 + dv * 64 + part * 8);
      }
    }
    __syncthreads();
    const float l2f = log_sigmoid(p.in[8][(layer * 2 + 0) * 4 + h]) * 1.4426950408889634f;
    const float l2b = log_sigmoid(p.in[8][(layer * 2 + 1) * 4 + h]) * 1.4426950408889634f;
    const u16* qp = RQ + (size_t)(tok0 + fr) * 256 + h * 64 + fq * 8;
    const bf16x8 q0 = *(const bf16x8*)qp, q1 = *(const bf16x8*)(qp + 32);
    const int c = c0 + fr;
    f32x4 s[8];
    const u16* kl0 = Ks + (8 * (fr >> 2) + (fr & 3)) * KLD + fq * 8;
#pragma unroll
    for (int t = 0; t < 8; ++t) {
      const u16* kp = kl0 + ((t >> 1) * 32 + (t & 1) * 4) * KLD;
      V8 k0, k1;
      k0.h[0] = *(const uint2*)kp;        k0.h[1] = *(const uint2*)(kp + 4);
      k1.h[0] = *(const uint2*)(kp + 32); k1.h[1] = *(const uint2*)(kp + 36);
      f32x4 a = {0.f, 0.f, 0.f, 0.f};
      a = mfma16(k0.v, q0, a);
      a = mfma16(k1.v, q1, a);
#pragma unroll
      for (int j = 0; j < 4; ++j) {
        const int m = (t >> 1) * 32 + 8 * fq + 4 * (t & 1) + j;
        const int diff = c - m;
        const float dec = diff >= 0 ? __builtin_amdgcn_exp2f(l2f * (float)diff) : __builtin_amdgcn_exp2f(l2b * (float)(-diff));
        a[j] *= dec;
      }
      s[t] = a;
      asm volatile("" ::: "memory");
    }
    f32x4 o[4], iF[4], iB[4];
#pragma unroll
    for (int dt = 0; dt < 4; ++dt) { o[dt] = f32x4{0.f, 0.f, 0.f, 0.f}; iF[dt] = o[dt]; iB[dt] = o[dt]; }
    const u16* vl0 = Vs + fr * VLD + fq * 8;
#pragma unroll
    for (int ks = 0; ks < 4; ++ks) {
      V8 pb;
      pb.h[0] = pack4(s[2 * ks][0], s[2 * ks][1], s[2 * ks][2], s[2 * ks][3]);
      pb.h[1] = pack4(s[2 * ks + 1][0], s[2 * ks + 1][1], s[2 * ks + 1][2], s[2 * ks + 1][3]);
#pragma unroll
      for (int dt = 0; dt < 4; ++dt) {
        V8 va;
        va.u = *(const uint4*)(vl0 + dt * 16 * VLD + ks * 32);
        o[dt] = mfma16(va.v, pb.v, o[dt]);
      }
      asm volatile("" ::: "memory");
    }
    {
      const u16* rf = Rfs + fr * RLD + fq * 8;
      const u16* rb = Rbs + fr * RLD + fq * 8;
#pragma unroll
      for (int dt = 0; dt < 4; ++dt) {
        iF[dt] = mfma16(*(const bf16x8*)(rf + dt * 16 * RLD), q0, iF[dt]);
        iF[dt] = mfma16(*(const bf16x8*)(rf + dt * 16 * RLD + 32), q1, iF[dt]);
        iB[dt] = mfma16(*(const bf16x8*)(rb + dt * 16 * RLD), q0, iB[dt]);
        iB[dt] = mfma16(*(const bf16x8*)(rb + dt * 16 * RLD + 32), q1, iB[dt]);
      }
    }
    const float xif = exp2f(l2f * (float)(c + 1)), xib = exp2f(l2b * (float)(128 - c));
    float sum = 0.f;
#pragma unroll
    for (int dt = 0; dt < 4; ++dt)
#pragma unroll
      for (int j = 0; j < 4; ++j) {
        o[dt][j] += xif * iF[dt][j] + xib * iB[dt][j];
        sum += o[dt][j];
      }
    sum += __shfl_xor(sum, 16);
    sum += __shfl_xor(sum, 32);
    const float mu = sum * (1.f / 64.f);
    float vs = 0.f;
#pragma unroll
    for (int dt = 0; dt < 4; ++dt)
#pragma unroll
      for (int j = 0; j < 4; ++j) { float d = o[dt][j] - mu; vs += d * d; }
    vs += __shfl_xor(vs, 16);
    vs += __shfl_xor(vs, 32);
    const float rstd = rsqrtf(vs * (1.f / 64.f) + 1e-6f);
#pragma unroll
    for (int dt = 0; dt < 4; ++dt) {
      const int ch = h * 64 + dt * 16 + fq * 4;
      float4 g = *(const float4*)(gn + ch);
      uint2 sg = *(const uint2*)(RG + (size_t)(tok0 + fr) * 256 + ch);
      float r0 = (o[dt][0] - mu) * rstd * g.x * lo16(sg.x);
      float r1 = (o[dt][1] - mu) * rstd * g.y * hi16(sg.x);
      float r2 = (o[dt][2] - mu) * rstd * g.z * lo16(sg.y);
      float r3 = (o[dt][3] - mu) * rstd * g.w * hi16(sg.y);
      *(uint2*)(BR + (size_t)(tok0 + fr) * 256 + ch) = pack4(r0, r1, r2, r3);
    }
    __syncthreads();
  }
}

DEVI void phase_conv(const Params& p, int layer, unsigned char* smem) {
  const int tid = otid(), lane = tid & 63, wid = tid >> 6, half = tid >> 8, ct = tid & 255;
  float* su = (float*)smem + half * (62 * 256);
  const u16* CA = (const u16*)(p.ws + OFF_CA);
  const u16* CB = (const u16*)(p.ws + OFF_CB);
  u16* BR = brbuf(p) + (size_t)1 * M * 256;
  float w[31];
#pragma unroll
  for (int j = 0; j < 31; ++j) w[j] = p.in[10][(layer * 31 + j) * 256 + ct];
  const float bias = p.in[11][layer * 256 + ct];
  const float4 lg = *(const float4*)(p.in[12] + layer * 256 + lane * 4);
  const float4 lbb = *(const float4*)(p.in[13] + layer * 256 + lane * 4);
  for (int it = obid(); it < 1280; it += gridDim.x) {
    const int t0 = (it * 2 + half) * 32;
    int seq, pos0, T;
    tokinfo(t0, seq, pos0, T);
    const int sb = t0 - pos0;
    {
      const int ch = ct & 31, rr = ct >> 5;
#pragma unroll
      for (int ps = 0; ps < 8; ++ps) {
        const int row = ps * 8 + rr;
        if (row < 62) {
          const int pos = pos0 - 15 + row;
          float u[8];
          if (pos >= 0 && pos < T) {
            uint4 a = *(const uint4*)(CA + (size_t)(sb + pos) * 256 + ch * 8);
            uint4 b = *(const uint4*)(CB + (size_t)(sb + pos) * 256 + ch * 8);
            u[0] = lo16(a.x) * lo16(b.x); u[1] = hi16(a.x) * hi16(b.x);
            u[2] = lo16(a.y) * lo16(b.y); u[3] = hi16(a.y) * hi16(b.y);
            u[4] = lo16(a.z) * lo16(b.z); u[5] = hi16(a.z) * hi16(b.z);
            u[6] = lo16(a.w) * lo16(b.w); u[7] = hi16(a.w) * hi16(b.w);
          } else {
#pragma unroll
            for (int e = 0; e < 8; ++e) u[e] = 0.f;
          }
          float* d = su + row * 256 + ch * 8;
          *(float4*)d = make_float4(u[0], u[1], u[2], u[3]);
          *(float4*)(d + 4) = make_float4(u[4], u[5], u[6], u[7]);
        }
      }
    }
    __syncthreads();
    float y[32];
#pragma unroll
    for (int t = 0; t < 32; ++t) y[t] = bias;
#pragma unroll
    for (int r = 0; r < 62; ++r) {
      const float uv = su[r * 256 + ct];
#pragma unroll
      for (int t = 0; t < 32; ++t) {
        const int j = r - t;
        if (j >= 0 && j < 31) y[t] += uv * w[j];
      }
    }
    __syncthreads();
#pragma unroll
    for (int t = 0; t < 32; ++t) su[t * 256 + ct] = y[t];
    __syncthreads();
#pragma unroll 1
    for (int tt = 0; tt < 8; ++tt) {
      const int t = (wid & 3) * 8 + tt;
      float4 v = *(const float4*)(su + t * 256 + lane * 4);
      float sm = wave_sum(v.x + v.y + v.z + v.w);
      const float mu = sm * (1.f / 256.f);
      float d0 = v.x - mu, d1 = v.y - mu, d2 = v.z - mu, d3 = v.w - mu;
      float vs = wave_sum(d0 * d0 + d1 * d1 + d2 * d2 + d3 * d3);
      const float rstd = rsqrtf(vs * (1.f / 256.f) + 1e-6f);
      float z0 = d0 * rstd * lg.x + lbb.x, z1 = d1 * rstd * lg.y + lbb.y, z2 = d2 * rstd * lg.z + lbb.z,
            z3 = d3 * rstd * lg.w + lbb.w;
      z0 *= sigmoidf_(z0); z1 *= sigmoidf_(z1); z2 *= sigmoidf_(z2); z3 *= sigmoidf_(z3);
      *(uint2*)(BR + (size_t)(t0 + t) * 256 + lane * 4) = pack4(z0, z1, z2, z3);
    }
    __syncthreads();
  }
}

DEVI void phase_na(const Params& p, int layer, unsigned char* smem) {
  constexpr int KLD = 68, VLD = 488;
  u16* Ks = (u16*)smem;
  u16* Vs = (u16*)(smem + 65280);
  float* rpb = (float*)(smem + 65280 + 62464);
  const int tid = otid(), lane = tid & 63, wid = tid >> 6, fr = lane & 15, fq = lane >> 4;
  const u16* NQ = (const u16*)(p.ws + OFF_NQ);
  const u16* NK = (const u16*)(p.ws + OFF_NK);
  const u16* NVT = (const u16*)(p.ws + OFF_NVT);
  u16* BR = brbuf(p);
  for (int it = obid(); it < 2560; it += gridDim.x) {
    const int h = it & 3, jb = (it >> 2) & 3, rgi = it >> 4;
    int sb, T, rg;
    if (rgi < 128) { sb = (rgi >> 3) * 4096; T = 4096; rg = rgi & 7; }
    else { const int q = rgi - 128; sb = MP + (q >> 4) * 8192; T = 8192; rg = q & 15; }
    const int rows = T >> 6;
    const int r0 = rg * 8;
    int lo = r0 - 4; lo = lo < 0 ? 0 : (lo > rows - 8 ? rows - 8 : lo);
    int hi = r0 + 7 - 4; hi = hi < 0 ? 0 : (hi > rows - 8 ? rows - 8 : hi); hi += 7;
    const int nrow = hi - lo + 1;
    const int kb = jb == 0 ? 0 : (jb == 1 ? 8 : (jb == 2 ? 24 : 32));
    for (int i = tid; i < 465; i += NTHR) rpb[i] = p.in[14][(layer * 4 + h) * 465 + i];
    {
      const int nk = nrow * 32 * 8;
      for (int c = tid; c < nk; c += NTHR) {
        const int k = c >> 3, part = c & 7;
        const uint4 v = *(const uint4*)(NK + (size_t)(sb + (lo + (k >> 5)) * 64 + kb + (k & 31)) * 256 + h * 64 + part * 8);
        uint2* d = (uint2*)(Ks + k * KLD + part * 8);
        d[0] = make_uint2(v.x, v.y);
        d[1] = make_uint2(v.z, v.w);
      }
      const int nv = 64 * nrow * 4;
      for (int c = tid; c < nv; c += NTHR) {
        const int d = c / (nrow * 4), rem = c - d * (nrow * 4), seg = rem >> 2, part = rem & 3;
        const uint4 v = *(const uint4*)(NVT + (size_t)(h * 64 + d) * M + sb + (lo + seg) * 64 + kb + part * 8);
        *(uint4*)(Vs + d * VLD + seg * 32 + part * 8) = v;
      }
    }
    __syncthreads();
    {
      const int r = r0 + wid;
      const int pos0 = r * 64 + jb * 16, tok0 = sb + pos0, qc0 = jb * 16;
      int start = r - 4;
      start = start < 0 ? 0 : (start > rows - 8 ? rows - 8 : start);
      const int rel0 = start - lo;
      const u16* qp = NQ + (size_t)(tok0 + fr) * 256 + h * 64 + fq * 8;
      const bf16x8 q0 = *(const bf16x8*)qp, q1 = *(const bf16x8*)(qp + 32);
      const int qcol = qc0 + fr;
      int wst = qcol - 8;
      wst = wst < 0 ? 0 : (wst > 48 ? 48 : wst);
      f32x4 s[16];
      float mx = -3e38f;
      const u16* kl0 = Ks + (rel0 * 32 + 8 * (fr >> 2) + (fr & 3)) * KLD + fq * 8;
#pragma unroll
      for (int t = 0; t < 16; ++t) {
        const int i = t >> 1, pp = t & 1;
        const u16* kp = kl0 + (i * 32 + pp * 4) * KLD;
        V8 k0, k1;
        k0.h[0] = *(const uint2*)kp;        k0.h[1] = *(const uint2*)(kp + 4);
        k1.h[0] = *(const uint2*)(kp + 32); k1.h[1] = *(const uint2*)(kp + 36);
        f32x4 a = {0.f, 0.f, 0.f, 0.f};
        a = mfma16(k0.v, q0, a);
        a = mfma16(k1.v, q1, a);
        const int dr = start + i - r + 7;
#pragma unroll
        for (int j = 0; j < 4; ++j) {
          const int kcol = kb + 8 * fq + 4 * pp + j;
          const int rel = kcol - wst;
          int dc = kcol - qcol + 15;
          dc = dc < 0 ? 0 : (dc > 30 ? 30 : dc);
          const bool ok = (rel >= 0) && (rel < 16);
          const float v = ok ? a[j] + rpb[dr * 31 + dc] : -1e30f;
          a[j] = v;
          mx = fmaxf(mx, v);
        }
        s[t] = a;
      }
      mx = fmaxf(mx, __shfl_xor(mx, 16));
      mx = fmaxf(mx, __shfl_xor(mx, 32));
      float sum = 0.f;
#pragma unroll
      for (int t = 0; t < 16; ++t)
#pragma unroll
        for (int j = 0; j < 4; ++j) { float e = fast_exp(s[t][j] - mx); s[t][j] = e; sum += e; }
      sum += __shfl_xor(sum, 16);
      sum += __shfl_xor(sum, 32);
      const float inv = fast_rcp(sum);
      f32x4 o[4];
#pragma unroll
      for (int dt = 0; dt < 4; ++dt) o[dt] = f32x4{0.f, 0.f, 0.f, 0.f};
      const u16* vl0 = Vs + fr * VLD + rel0 * 32 + fq * 8;
#pragma unroll
      for (int ks = 0; ks < 8; ++ks) {
        V8 pb;
        pb.h[0] = pack4(s[2 * ks][0] * inv, s[2 * ks][1] * inv, s[2 * ks][2] * inv, s[2 * ks][3] * inv);
        pb.h[1] = pack4(s[2 * ks + 1][0] * inv, s[2 * ks + 1][1] * inv, s[2 * ks + 1][2] * inv, s[2 * ks + 1][3] * inv);
#pragma unroll
        for (int dt = 0; dt < 4; ++dt) {
          V8 va;
          va.u = *(const uint4*)(vl0 + dt * 16 * VLD + ks * 32);
          o[dt] = mfma16(va.v, pb.v, o[dt]);
        }
      }
#pragma unroll
      for (int dt = 0; dt < 4; ++dt)
        *(uint2*)(BR + (size_t)2 * M * 256 + (size_t)(tok0 + fr) * 256 + h * 64 + dt * 16 + fq * 4) =
            pack4(o[dt][0], o[dt][1], o[dt][2], o[dt][3]);
    }
    __syncthreads();
  }
}

DEVI int t5_bucket_dev(int rel) {
  int n = rel < 0 ? -rel : rel;
  int b;
  if (n < 8) b = n;
  else b = 8 + (n >= 12) + (n >= 16) + (n >= 23) + (n >= 32) + (n >= 46) + (n >= 64) + (n >= 91);
  return (rel > 0 ? 16 : 0) + b;
}

DEVI void phase_swa(const Params& p, int layer, unsigned char* smem) {
  constexpr int KLD = 68, VLD = 392;
  u16* Ks = (u16*)smem;
  u16* Vs = (u16*)(smem + 52224);
  float* lut = (float*)(smem + 52224 + 50176);
  const int tid = otid(), lane = tid & 63, wid = tid >> 6, fr = lane & 15, fq = lane >> 4;
  const u16* SQ = (const u16*)(p.ws + OFF_SQ);
  const u16* SK = (const u16*)(p.ws + OFF_SK);
  const u16* SVT = (const u16*)(p.ws + OFF_SVT);
  u16* BR = brbuf(p);
  for (int it = obid(); it < 1280; it += gridDim.x) {
    const int hkv = it & 1, blk = it >> 1, tokb = blk * 128;
    int seq, posb, T;
    tokinfo(tokb, seq, posb, T);
    const int sb = tokb - posb;
    const int wlo = posb - 128;
    for (int i = tid; i < 2 * 257; i += NTHR) {
      const int g = i / 257, rel = (i % 257) - 128;
      lut[i] = p.in[16][t5_bucket_dev(rel) * 4 + hkv * 2 + g];
    }
    for (int c = tid; c < 64 * 48; c += NTHR) {
      const int d = c / 48, rem = c - d * 48, kofs = (rem >> 2) * 32 + (rem & 3) * 8, kpos = wlo + kofs;
      uint4 v = make_uint4(0u, 0u, 0u, 0u);
      if (kpos >= 0 && kpos < T) v = *(const uint4*)(SK + (size_t)(hkv * 64 + d) * M + sb + kpos);
      u16* kd = Ks + kofs * KLD + d;
      kd[0 * KLD] = (u16)(v.x & 0xffffu); kd[1 * KLD] = (u16)(v.x >> 16);
      kd[2 * KLD] = (u16)(v.y & 0xffffu); kd[3 * KLD] = (u16)(v.y >> 16);
      kd[4 * KLD] = (u16)(v.z & 0xffffu); kd[5 * KLD] = (u16)(v.z >> 16);
      kd[6 * KLD] = (u16)(v.w & 0xffffu); kd[7 * KLD] = (u16)(v.w >> 16);
    }
    for (int c = tid; c < 64 * 48; c += NTHR) {
      const int d = c / 48, rem = c - d * 48, kofs = (rem >> 2) * 32 + (rem & 3) * 8, kpos = wlo + kofs;
      uint4 v = make_uint4(0u, 0u, 0u, 0u);
      if (kpos >= 0 && kpos < T) v = *(const uint4*)(SVT + (size_t)(hkv * 64 + d) * M + sb + kpos);
      *(uint4*)(Vs + d * VLD + kofs) = v;
    }
    __syncthreads();
    const int pos0 = posb + wid * 16, tok0 = sb + pos0;
    const int b0 = wid >> 1;
    const int qoff = 128 + (wid & 1) * 16;
    const u16* kl0 = Ks + (b0 * 32 + 8 * (fr >> 2) + (fr & 3)) * KLD + fq * 8;
    const u16* vl0 = Vs + fr * VLD + b0 * 32 + fq * 8;
#pragma unroll 1
    for (int g = 0; g < 2; ++g) {
      const int hq = hkv * 2 + g;
      const float sink = p.in[15][layer * 4 + hq];
      const u16* qp = SQ + (size_t)(tok0 + fr) * 256 + hq * 64 + fq * 8;
      const bf16x8 q0 = *(const bf16x8*)qp, q1 = *(const bf16x8*)(qp + 32);
      f32x4 s[18];
      float mx = sink;
#pragma unroll
      for (int t = 0; t < 18; ++t) {
        const int bs = wlo + (b0 + (t >> 1)) * 32;
        const bool bv = (bs >= 0) && (bs < T);
        const u16* kp = kl0 + ((t >> 1) * 32 + (t & 1) * 4) * KLD;
        V8 k0, k1;
        k0.h[0] = *(const uint2*)kp;        k0.h[1] = *(const uint2*)(kp + 4);
        k1.h[0] = *(const uint2*)(kp + 32); k1.h[1] = *(const uint2*)(kp + 36);
        f32x4 a = {0.f, 0.f, 0.f, 0.f};
        a = mfma16(k0.v, q0, a);
        a = mfma16(k1.v, q1, a);
#pragma unroll
        for (int j = 0; j < 4; ++j) {
          const int rel = (t >> 1) * 32 + 8 * fq + 4 * (t & 1) + j - qoff - fr;
          const bool ok = bv && rel >= -128 && rel <= 128;
          int li = rel + 128;
          li = li < 0 ? 0 : (li > 256 ? 256 : li);
          const float v = ok ? a[j] + lut[g * 257 + li] : -1e30f;
          a[j] = v;
          mx = fmaxf(mx, v);
        }
        s[t] = a;
        asm volatile("" ::: "memory");
      }
      mx = fmaxf(mx, __shfl_xor(mx, 16));
      mx = fmaxf(mx, __shfl_xor(mx, 32));
      float sum = 0.f;
#pragma unroll
      for (int t = 0; t < 18; ++t)
#pragma unroll
        for (int j = 0; j < 4; ++j) { float e = fast_exp(s[t][j] - mx); s[t][j] = e; sum += e; }
      sum += __shfl_xor(sum, 16);
      sum += __shfl_xor(sum, 32);
      const float inv = fast_rcp(sum + fast_exp(sink - mx));
      f32x4 o[4];
#pragma unroll
      for (int dt = 0; dt < 4; ++dt) o[dt] = f32x4{0.f, 0.f, 0.f, 0.f};
#pragma unroll
      for (int ks = 0; ks < 9; ++ks) {
        V8 pb;
        pb.h[0] = pack4(s[2 * ks][0] * inv, s[2 * ks][1] * inv, s[2 * ks][2] * inv, s[2 * ks][3] * inv);
        pb.h[1] = pack4(s[2 * ks + 1][0] * inv, s[2 * ks + 1][1] * inv, s[2 * ks + 1][2] * inv, s[2 * ks + 1][3] * inv);
#pragma unroll
        for (int dt = 0; dt < 4; ++dt) {
          V8 va;
          va.u = *(const uint4*)(vl0 + dt * 16 * VLD + ks * 32);
          o[dt] = mfma16(va.v, pb.v, o[dt]);
        }
        asm volatile("" ::: "memory");
      }
#pragma unroll
      for (int dt = 0; dt < 4; ++dt)
        *(uint2*)(BR + (size_t)3 * M * 256 + (size_t)(tok0 + fr) * 256 + hq * 64 + dt * 16 + fq * 4) =
            pack4(o[dt][0], o[dt][1], o[dt][2], o[dt][3]);
    }
    __syncthreads();
  }
}

struct EpiGates {
  u16* G;
  DEVI bool operator()(f32x4 (&acc)[2][2][4][2], const g8::Unit& u, int wr, int wc, int fr, int fq) const {
    u16* o0 = G + (size_t)(u.pm * 256 + wr * 64 + fr) * 4096 + u.pn * 256 + wc * 32 + fq * 8;
#pragma unroll
    for (int ai = 0; ai < 2; ++ai)
#pragma unroll
      for (int m = 0; m < 4; ++m) {
        u16* orow = o0 + (size_t)(ai * 128 + m * 16) * 4096;
#pragma unroll
        for (int bj = 0; bj < 2; ++bj) {
          const f32x4 v0 = acc[ai][bj][m][0], v1 = acc[ai][bj][m][1];
          uint4 w;
          w.x = pack2(sigmoidf_(v0[0]), sigmoidf_(v0[1])); w.y = pack2(sigmoidf_(v0[2]), sigmoidf_(v0[3]));
          w.z = pack2(sigmoidf_(v1[0]), sigmoidf_(v1[1])); w.w = pack2(sigmoidf_(v1[2]), sigmoidf_(v1[3]));
          *(uint4*)(orow + bj * 128) = w;
        }
        asm volatile("" ::: "memory");
      }
    return true;
  }
};
DEVI void phase_gates(const Params& p, int layer, int half, unsigned char* smem) {
  const u16* H = hbuf(p) + (size_t)half * MH * 1024;
  const u16* WM = (const u16*)(p.ws + OFF_WMERGE) + (size_t)layer * SZ_WMERGE;
  g8::Order S;
  S.init(MH / 256, 16, gridDim.x, obid(), 1024);
  EpiGates e{(u16*)(p.ws + OFF_GATES)};
  g8::gemm_phase<true>((LAS unsigned char*)smem, H, WM, 1024, S, e);
}
struct MergeOrder {
  g8::Order inner; int half;
  DEVI bool next(int ui, g8::Unit& u) const {
    if (!inner.next(ui >> 2, u)) return false;
    const int i = ui & 3;
    u.aux = i;
    u.aoff = ((size_t)i * M * 256 + (size_t)(half * MH + u.pm * 256) * 256) * 2;
    u.boff = ((size_t)i * 1024 * 256 + (size_t)u.pn * 256 * 256) * 2;
    return true;
  }
};
struct EpiMerge {
  const u16* GT;
  u16* MG;
  int half;
  DEVI bool operator()(f32x4 (&acc)[2][2][4][2], const g8::Unit& u, int wr, int wc, int fr, int fq) const {
    const int i = u.aux;
    const bool last = (i == 3);
    const int gbo = last ? 0 : 1024;
    const u16* g0 = GT + (size_t)(u.pm * 256 + wr * 64 + fr) * 4096 + i * 1024 + u.pn * 256 + wc * 32 + fq * 8;
    u16* o0 = MG + (size_t)(half * MH + u.pm * 256 + wr * 64 + fr) * 1024 + u.pn * 256 + wc * 32 + fq * 8;
#pragma unroll
    for (int ai = 0; ai < 2; ++ai) {
      uint4 ga[4][2], gb[4][2];
#pragma unroll
      for (int m = 0; m < 4; ++m) {
        const u16* gr = g0 + (size_t)(ai * 128 + m * 16) * 4096;
#pragma unroll
        for (int bj = 0; bj < 2; ++bj) {
          ga[m][bj] = *(const uint4*)(gr + bj * 128);
          gb[m][bj] = *(const uint4*)(gr + gbo + bj * 128);
        }
      }
      asm volatile("" ::: "memory");
#pragma unroll
      for (int m = 0; m < 4; ++m) {
        u16* orow = o0 + (size_t)(ai * 128 + m * 16) * 1024;
#pragma unroll
        for (int bj = 0; bj < 2; ++bj) {
          const uint4 a4 = ga[m][bj], b4 = gb[m][bj];
          f32x4 v0 = acc[ai][bj][m][0], v1 = acc[ai][bj][m][1];
          v0[0] *= lo16(a4.x) * (last ? 1.f : fast_rcp(lo16(b4.x)));
          v0[1] *= hi16(a4.x) * (last ? 1.f : fast_rcp(hi16(b4.x)));
          v0[2] *= lo16(a4.y) * (last ? 1.f : fast_rcp(lo16(b4.y)));
          v0[3] *= hi16(a4.y) * (last ? 1.f : fast_rcp(hi16(b4.y)));
          v1[0] *= lo16(a4.z) * (last ? 1.f : fast_rcp(lo16(b4.z)));
          v1[1] *= hi16(a4.z) * (last ? 1.f : fast_rcp(hi16(b4.z)));
          v1[2] *= lo16(a4.w) * (last ? 1.f : fast_rcp(lo16(b4.w)));
          v1[3] *= hi16(a4.w) * (last ? 1.f : fast_rcp(hi16(b4.w)));
          acc[ai][bj][m][0] = v0;
          acc[ai][bj][m][1] = v1;
          if (last) {
            uint4 w;
            w.x = pack2(v0[0], v0[1]); w.y = pack2(v0[2], v0[3]); w.z = pack2(v1[0], v1[1]); w.w = pack2(v1[2], v1[3]);
            *(uint4*)(orow + bj * 128) = w;
          }
        }
      }
      asm volatile("" ::: "memory");
    }
    return last;
  }
};
DEVI void phase_merge(const Params& p, int layer, int half, unsigned char* smem) {
  MergeOrder S;
  S.inner.init(MH / 256, 4, gridDim.x, obid(), 256);
  S.half = half;
  EpiMerge e{(const u16*)(p.ws + OFF_GATES), hbuf(p), half};
  g8::gemm_phase<true>((LAS unsigned char*)smem, brbuf(p),
                 (const u16*)(p.ws + OFF_WBRANCH) + (size_t)layer * SZ_WBRANCH, 256, S, e);
}

template <bool FIRST>
struct EpiResid {
  u16* xb; const float* mod; int layer, gsel;
  const float* xp; const float* xs;
  DEVI bool operator()(f32x4 (&acc)[2][2][4][2], const g8::Unit& u, int wr, int wc, int fr, int fq) const {
    const int t0 = u.pm * 256;
    int seq, pos0, T;
    tokinfo(t0, seq, pos0, T);
    const float* gp = mod + (size_t)(layer * 18 + seq) * 6144 + gsel * 1024 + u.pn * 256 + wc * 32 + fq * 8;
    float4 g[2][2];
#pragma unroll
    for (int bj = 0; bj < 2; ++bj)
#pragma unroll
      for (int n = 0; n < 2; ++n) g[bj][n] = *(const float4*)(gp + bj * 128 + n * 4);
    const size_t lo = (size_t)(wr * 64 + fr) * 1024 + u.pn * 256 + wc * 32 + fq * 8;
    u16* o0 = xb + (size_t)t0 * 1024 + lo;
    if (FIRST) {
      const float* i0 = (t0 < MP ? xp + (size_t)t0 * 1024 : xs + (size_t)(t0 - MP) * 1024) + lo;
#pragma unroll
      for (int ai = 0; ai < 2; ++ai)
#pragma unroll
        for (int mh = 0; mh < 2; ++mh) {
          float4 x[2][2][2];
#pragma unroll
          for (int m2 = 0; m2 < 2; ++m2)
#pragma unroll
            for (int bj = 0; bj < 2; ++bj) {
              const float* ip = i0 + (size_t)(ai * 128 + (mh * 2 + m2) * 16) * 1024 + bj * 128;
              x[m2][bj][0] = *(const float4*)ip;
              x[m2][bj][1] = *(const float4*)(ip + 4);
            }
          asm volatile("" ::: "memory");
#pragma unroll
          for (int m2 = 0; m2 < 2; ++m2) {
            const int m = mh * 2 + m2;
            u16* rowp = o0 + (size_t)(ai * 128 + m * 16) * 1024;
#pragma unroll
            for (int bj = 0; bj < 2; ++bj) {
              const float4 xa = x[m2][bj][0], xc = x[m2][bj][1];
              const f32x4 v0 = acc[ai][bj][m][0], v1 = acc[ai][bj][m][1];
              uint4 w;
              w.x = pack2(xa.x + g[bj][0].x * v0[0], xa.y + g[bj][0].y * v0[1]);
              w.y = pack2(xa.z + g[bj][0].z * v0[2], xa.w + g[bj][0].w * v0[3]);
              w.z = pack2(xc.x + g[bj][1].x * v1[0], xc.y + g[bj][1].y * v1[1]);
              w.w = pack2(xc.z + g[bj][1].z * v1[2], xc.w + g[bj][1].w * v1[3]);
              *(uint4*)(rowp + bj * 128) = w;
            }
          }
          asm volatile("" ::: "memory");
        }
    } else {
#pragma unroll
      for (int ai = 0; ai < 2; ++ai) {
        uint4 xw[4][2];
#pragma unroll
        for (int m = 0; m < 4; ++m)
#pragma unroll
          for (int bj = 0; bj < 2; ++bj) xw[m][bj] = *(const uint4*)(o0 + (size_t)(ai * 128 + m * 16) * 1024 + bj * 128);
        asm volatile("" ::: "memory");
#pragma unroll
        for (int m = 0; m < 4; ++m) {
          u16* rowp = o0 + (size_t)(ai * 128 + m * 16) * 1024;
#pragma unroll
          for (int bj = 0; bj < 2; ++bj) {
            const uint4 xv = xw[m][bj];
            const f32x4 v0 = acc[ai][bj][m][0], v1 = acc[ai][bj][m][1];
            uint4 w;
            w.x = pack2(lo16(xv.x) + g[bj][0].x * v0[0], hi16(xv.x) + g[bj][0].y * v0[1]);
            w.y = pack2(lo16(xv.y) + g[bj][0].z * v0[2], hi16(xv.y) + g[bj][0].w * v0[3]);
            w.z = pack2(lo16(xv.z) + g[bj][1].x * v1[0], hi16(xv.z) + g[bj][1].y * v1[1]);
            w.w = pack2(lo16(xv.w) + g[bj][1].z * v1[2], hi16(xv.w) + g[bj][1].w * v1[3]);
            *(uint4*)(rowp + bj * 128) = w;
          }
        }
        asm volatile("" ::: "memory");
      }
    }
    return true;
  }
};
DEVI void phase_resid(const Params& p, int layer, const u16* A, int K, const u16* Wt, int gsel, unsigned char* smem) {
  g8::Order S;
  S.init(M / 256, 4, gridDim.x, obid(), K);
  if (layer == 0 && gsel == 2) {
    EpiResid<true> e{xbuf(p), (const float*)(p.ws + OFF_MOD), layer, gsel, p.in[0], p.in[1]};
    g8::gemm_phase<true>((LAS unsigned char*)smem, A, Wt, K, S, e);
  } else {
    EpiResid<false> e{xbuf(p), (const float*)(p.ws + OFF_MOD), layer, gsel, nullptr, nullptr};
    g8::gemm_phase<true>((LAS unsigned char*)smem, A, Wt, K, S, e);
  }
}

struct EpiFF1 {
  u16* HID;
  DEVI bool operator()(f32x4 (&acc)[2][2][4][2], const g8::Unit& u, int wr, int wc, int fr, int fq) const {
    u16* o0 = HID + (size_t)(u.pm * 256 + wr * 64 + fr) * 4096 + u.pn * 256 + wc * 32 + fq * 8;
#pragma unroll
    for (int ai = 0; ai < 2; ++ai)
#pragma unroll
      for (int m = 0; m < 4; ++m) {
        u16* orow = o0 + (size_t)(ai * 128 + m * 16) * 4096;
#pragma unroll
        for (int bj = 0; bj < 2; ++bj) {
          const f32x4 v0 = acc[ai][bj][m][0], v1 = acc[ai][bj][m][1];
          const float a0 = fmaxf(v0[0], 0.f), a1 = fmaxf(v0[1], 0.f), a2 = fmaxf(v0[2], 0.f), a3 = fmaxf(v0[3], 0.f);
          const float b0 = fmaxf(v1[0], 0.f), b1 = fmaxf(v1[1], 0.f), b2 = fmaxf(v1[2], 0.f), b3 = fmaxf(v1[3], 0.f);
          uint4 w;
          w.x = pack2(a0 * a0, a1 * a1); w.y = pack2(a2 * a2, a3 * a3);
          w.z = pack2(b0 * b0, b1 * b1); w.w = pack2(b2 * b2, b3 * b3);
          *(uint4*)(orow + bj * 128) = w;
        }
        asm volatile("" ::: "memory");
      }
    return true;
  }
};
DEVI void phase_ff1(const Params& p, int layer, unsigned char* smem) {
  g8::Order S;
  S.init(M / 256, 16, gridDim.x, obid(), 1024);
  EpiFF1 e{(u16*)(p.ws + OFF_HID)};
  g8::gemm_phase<true>((LAS unsigned char*)smem, hbuf(p), (const u16*)(p.ws + OFF_WFF1) + (size_t)layer * SZ_WFF, 1024, S, e);
}

struct CtrBarrier { unsigned* ctr; unsigned target; };
DEVI void ctr_barrier(CtrBarrier& b) {
  asm volatile("s_waitcnt vmcnt(0)" ::: "memory");
  __syncthreads();
  b.target += gridDim.x;
  if (threadIdx.x == 0) {
    __builtin_amdgcn_fence(__ATOMIC_RELEASE, "agent");
    asm volatile("s_waitcnt vmcnt(0)" ::: "memory");
    __hip_atomic_fetch_add(b.ctr, 1u, __ATOMIC_RELAXED, __HIP_MEMORY_SCOPE_AGENT);
    unsigned spins = 0;
    while (__hip_atomic_load(b.ctr, __ATOMIC_RELAXED, __HIP_MEMORY_SCOPE_AGENT) < b.target) {
      __builtin_amdgcn_s_sleep(1);
      if (++spins > (1u << 22)) break;
    }
    __builtin_amdgcn_fence(__ATOMIC_ACQUIRE, "agent");
    asm volatile("s_waitcnt vmcnt(0)" ::: "memory");
  }
  __syncthreads();
}

DEVI void stage_signal(unsigned* cnt) {
  asm volatile("s_waitcnt vmcnt(0)" ::: "memory");
  __syncthreads();
  if (threadIdx.x == 0) {
    __builtin_amdgcn_fence(__ATOMIC_RELEASE, "agent");
    asm volatile("s_waitcnt vmcnt(0)" ::: "memory");
    __hip_atomic_fetch_add(cnt, 1u, __ATOMIC_RELAXED, __HIP_MEMORY_SCOPE_AGENT);
  }
}
DEVI void stage_wait(unsigned* cnt) {
  __syncthreads();
  if (threadIdx.x == 0) {
    unsigned spins = 0;
    while (__hip_atomic_load(cnt, __ATOMIC_RELAXED, __HIP_MEMORY_SCOPE_AGENT) < gridDim.x) {
      __builtin_amdgcn_s_sleep(1);
      if (++spins > (1u << 22)) break;
    }
    __builtin_amdgcn_fence(__ATOMIC_ACQUIRE, "agent");
    asm volatile("s_waitcnt vmcnt(0)" ::: "memory");
  }
  __syncthreads();
}

#define REP_GATES 1
#define REP_NA 1
#define REP_SWA 1
#define REP_C1 1
#define REP_C2 1
#define REP_C3 1
#define REP_FF1 1
#define REP_G1 1
#define REP_MERGE 1
#ifndef REP_MIX
#define REP_MIX 1
#endif
__global__ void __launch_bounds__(512, 2) trunk_megakernel(Params p) {
  cg::grid_group grid = cg::this_grid();
  __shared__ __attribute__((aligned(16))) unsigned char smem[SMEM_BYTES];
  CtrBarrier cb{(unsigned*)(p.ws + OFF_BAR), 0u};
  if (blockIdx.x == 0 && threadIdx.x < 8) cb.ctr[threadIdx.x * 16] = 0u;

  phase0(p, smem);
  grid.sync();
#pragma unroll 1
  for (int l = 0; l < 2; ++l) {
    phase_norm(p, l, 0);
    ctr_barrier(cb);
#pragma unroll 1
    for (int rep = 0; rep < REP_G1; ++rep) {
    phase_gemm1(p, l, smem);
    ctr_barrier(cb);
    }
    {
      unsigned* cntA = cb.ctr + 16 * (1 + 2 * l), * cntB = cb.ctr + 16 * (2 + 2 * l);
      phase_ret_u(p, l);
      stage_signal(cntA);
      phase_conv(p, l, smem);
      phase_na(p, l, smem);
      stage_wait(cntA);
      phase_ret_scan(p, l);
      stage_signal(cntB);
      phase_swa(p, l, smem);
      stage_wait(cntB);
      phase_ret_out(p, l, smem);
      ctr_barrier(cb);
    }
#pragma unroll 1
    for (int hf = 0; hf < 1; ++hf) {
#pragma unroll 1
      for (int rep = 0; rep < REP_GATES; ++rep) {
      phase_gates(p, l, hf, smem);
      ctr_barrier(cb);
      }
#pragma unroll 1
      for (int rep = 0; rep < REP_MERGE; ++rep) {
      phase_merge(p, l, hf, smem);
      ctr_barrier(cb);
      }
    }
    phase_resid(p, l, hbuf(p), 1024, (const u16*)(p.ws + OFF_WOUT) + (size_t)l * SZ_WOUT, 2, smem);
    ctr_barrier(cb);
    phase_norm(p, l, 1);
    ctr_barrier(cb);
#pragma unroll 1
    for (int rep = 0; rep < REP_FF1; ++rep) {
    phase_ff1(p, l, smem);
    ctr_barrier(cb);
    }
    phase_resid(p, l, (const u16*)(p.ws + OFF_HID), 4096, (const u16*)(p.ws + OFF_WFF2) + (size_t)l * SZ_WFF, 5, smem);
    ctr_barrier(cb);
  }
  phase_final(p);
}

extern "C" void kernel_launch(void* const* d_in, const int* in_sizes, int n_in, void* d_out, int out_size, void* d_ws,
                              size_t ws_size, hipStream_t stream) {
  static int grid_blocks = 0;
  if (!grid_blocks) {
    int dev = 0, cus = 0, per_cu = 0;
    (void)hipGetDevice(&dev);
    (void)hipDeviceGetAttribute(&cus, hipDeviceAttributeMultiprocessorCount, dev);
    (void)hipOccupancyMaxActiveBlocksPerMultiprocessor(&per_cu, trunk_megakernel, NTHR, 0);
    if (per_cu > 1) per_cu = 1;
    grid_blocks = (cus * per_cu / 8) * 8;
  }
  Params p{};
  for (int i = 0; i < 23; ++i) p.in[i] = (const float*)d_in[i];
  p.out = (float*)d_out;
  p.ws = (unsigned char*)d_ws;
  if (ws_size < WS_NEED) fprintf(stderr, "workspace too small: %zu < %zu\n", ws_size, (size_t)WS_NEED);
  void* args[] = {&p};
  hipError_t e = hipLaunchCooperativeKernel((void*)trunk_megakernel, dim3(grid_blocks), dim3(NTHR), args, 0, stream);
  if (e != hipSuccess) fprintf(stderr, "cooperative launch failed: %s (grid %d)\n", hipGetErrorString(e), grid_blocks);
}
```

```cpp
#include <hip/hip_runtime.h>
#include <hip/hip_cooperative_groups.h>
#include <cstdio>
namespace cg = cooperative_groups;

typedef unsigned short u16;
typedef short bf16x8 __attribute__((ext_vector_type(8)));
typedef float f32x4 __attribute__((ext_vector_type(4)));
#define DEVI __device__ __forceinline__

constexpr int M = 81920;
constexpr int MP = 65536;
constexpr int SMEM_BYTES = 131072;
constexpr int NTHR = 512;
constexpr int MH = M;

struct Params {
  const float* in[23];
  float* out;
  unsigned char* ws;
};

constexpr size_t SZ_WIN = 3072ull * 1024, SZ_WMERGE = 4ull * 1024 * 1024, SZ_WBRANCH = 4ull * 1024 * 256,
                 SZ_WOUT = 1024ull * 1024, SZ_WFF = 4096ull * 1024;
constexpr size_t OFF_WIN = 0;
constexpr size_t OFF_WMERGE = OFF_WIN + 2 * SZ_WIN * 2;
constexpr size_t OFF_WBRANCH = OFF_WMERGE + 2 * SZ_WMERGE * 2;
constexpr size_t OFF_WOUT = OFF_WBRANCH + 2 * SZ_WBRANCH * 2;
constexpr size_t OFF_WFF1 = OFF_WOUT + 2 * SZ_WOUT * 2;
constexpr size_t OFF_WFF2 = OFF_WFF1 + 2 * SZ_WFF * 2;
constexpr size_t OFF_MOD = OFF_WFF2 + 2 * SZ_WFF * 2;
constexpr size_t OFF_ROPE = OFF_MOD + 2ull * 18 * 6144 * 4;
constexpr size_t OFF_H = OFF_ROPE + 8192ull * 64 * 4;
constexpr size_t OFF_X = OFF_H + (size_t)M * 1024 * 2;
constexpr size_t C256 = (size_t)M * 256 * 2, C128 = (size_t)M * 128 * 2;
constexpr size_t OFF_RQ = OFF_X;
constexpr size_t OFF_RK = OFF_RQ + C256;
constexpr size_t OFF_RKT = OFF_RK + C256;
constexpr size_t OFF_RVT = OFF_RKT + C256;
constexpr size_t OFF_RG = OFF_RVT + C256;
constexpr size_t OFF_CA = OFF_RG + C256;
constexpr size_t OFF_CB = OFF_CA + C256;
constexpr size_t OFF_NQ = OFF_CB + C256;
constexpr size_t OFF_NK = OFF_NQ + C256;
constexpr size_t OFF_NVT = OFF_NK + C256;
constexpr size_t OFF_SQ = OFF_NVT + C256;
constexpr size_t OFF_SK = OFF_SQ + C256;
constexpr size_t OFF_SVT = OFF_SK + C128;
constexpr size_t OFF_U = OFF_SVT + C128;
constexpr size_t OFF_R = OFF_U + 2560ull * 2 * 4096 * 4;
constexpr size_t OFF_BR = OFF_R + 2560ull * 2 * 4096 * 2;
constexpr size_t OFF_END = OFF_BR + (size_t)M * 1024 * 2;
constexpr size_t OFF_BAR = OFF_END;
constexpr size_t WS_NEED = OFF_BAR + 1024;
constexpr size_t OFF_MERGED = OFF_BR;
constexpr size_t OFF_GSCR = OFF_X;
constexpr size_t OFF_GATES = OFF_X;
static_assert(OFF_GATES + (size_t)MH * 4096 * 2 <= OFF_END, "gates fit");
constexpr size_t OFF_HID = OFF_X;
static_assert(OFF_HID + (size_t)M * 4096 * 2 <= OFF_END, "hid fits");

DEVI u16 f2bf(float f) {
  unsigned u = __float_as_uint(f);
  u += 0x7fffu + ((u >> 16) & 1u);
  return (u16)(u >> 16);
}
DEVI float bf2f(u16 h) { return __uint_as_float(((unsigned)h) << 16); }
typedef __bf16 bf16x2_t __attribute__((ext_vector_type(2)));
typedef float f32x2_t __attribute__((ext_vector_type(2)));
DEVI unsigned pack2(float a, float b) {
  f32x2_t v = {a, b};
  bf16x2_t r = __builtin_convertvector(v, bf16x2_t);
  return __builtin_bit_cast(unsigned, r);
}
DEVI uint2 pack4(float a, float b, float c, float d) { return make_uint2(pack2(a, b), pack2(c, d)); }
DEVI float lo16(unsigned u) { return __uint_as_float(u << 16); }
DEVI float hi16(unsigned u) { return __uint_as_float(u & 0xffff0000u); }
union V8 { bf16x8 v; uint4 u; uint2 h[2]; };
DEVI f32x4 mfma16(bf16x8 a, bf16x8 b, f32x4 c) { return __builtin_amdgcn_mfma_f32_16x16x32_bf16(a, b, c, 0, 0, 0); }
DEVI float wave_sum(float v) {
#pragma unroll
  for (int o = 32; o; o >>= 1) v += __shfl_xor(v, o);
  return v;
}
DEVI float fast_rcp(float x) { return __builtin_amdgcn_rcpf(x); }
DEVI float fast_exp(float x) { return __builtin_amdgcn_exp2f(x * 1.4426950408889634f); }
DEVI float sigmoidf_(float x) { return fast_rcp(1.f + fast_exp(-x)); }
DEVI void tokinfo(int tok, int& seq, int& pos, int& T) {
  if (tok < MP) { seq = tok >> 12; pos = tok & 4095; T = 4096; }
  else { int u = tok - MP; seq = 16 + (u >> 13); pos = u & 8191; T = 8192; }
}
DEVI float log_sigmoid(float x) { return -log1pf(expf(-x)); }

DEVI int otid() { int t = threadIdx.x; asm volatile("" : "+v"(t)); return t; }
DEVI int obid() { int t = blockIdx.x; asm volatile("" : "+s"(t)); return t; }
DEVI u16* hbuf(const Params& p) { return (u16*)p.out; }
DEVI u16* brbuf(const Params& p) { return (u16*)p.out + (size_t)M * 1024; }
DEVI u16* xbuf(const Params& p) { return (u16*)(p.ws + OFF_H); }
template <int MI, int NI>
DEVI void gemm_mainloop(const u16* __restrict__ X, int ldx, const u16* __restrict__ Y, int ldy, int K,
                        f32x4 (&acc)[MI][NI], u16* smem) {
  constexpr int XR = MI * 32, YR = NI * 64, LD = 72;
  constexpr int XP = XR / 64, YP = YR / 64;
  u16* sX = smem;
  u16* sY = smem + 2 * XR * LD;
  const int tid = otid(), lane = tid & 63, wid = tid >> 6, wr = wid >> 2, wc = wid & 3, fr = lane & 15,
            fq = lane >> 4;
  const int lrow = tid >> 3, lch = tid & 7;
  uint4 rx[XP], ry[YP];
  const u16* xp = X + (size_t)lrow * ldx + lch * 8;
  const u16* yp = Y + (size_t)lrow * ldy + lch * 8;
#pragma unroll
  for (int i = 0; i < XP; ++i) rx[i] = *(const uint4*)(xp + (size_t)i * 64 * ldx);
#pragma unroll
  for (int i = 0; i < YP; ++i) ry[i] = *(const uint4*)(yp + (size_t)i * 64 * ldy);
#pragma unroll
  for (int i = 0; i < XP; ++i) *(uint4*)(sX + (lrow + i * 64) * LD + lch * 8) = rx[i];
#pragma unroll
  for (int i = 0; i < YP; ++i) *(uint4*)(sY + (lrow + i * 64) * LD + lch * 8) = ry[i];
  __syncthreads();
  const int nk = K >> 6;
  for (int kt = 0; kt < nk; ++kt) {
    const int cur = kt & 1;
    const bool more = (kt + 1 < nk);
    if (more) {
#pragma unroll
      for (int i = 0; i < XP; ++i) rx[i] = *(const uint4*)(xp + (size_t)i * 64 * ldx + (kt + 1) * 64);
#pragma unroll
      for (int i = 0; i < YP; ++i) ry[i] = *(const uint4*)(yp + (size_t)i * 64 * ldy + (kt + 1) * 64);
    }
    const u16* cx = sX + cur * XR * LD + (wr * MI * 16 + fr) * LD + fq * 8;
    const u16* cy = sY + cur * YR * LD + (wc * NI * 16 + fr) * LD + fq * 8;
#pragma unroll
    for (int ks = 0; ks < 2; ++ks) {
      bf16x8 a[MI], b[NI];
#pragma unroll
      for (int mi = 0; mi < MI; ++mi) a[mi] = *(const bf16x8*)(cx + mi * 16 * LD + ks * 32);
#pragma unroll
      for (int ni = 0; ni < NI; ++ni) b[ni] = *(const bf16x8*)(cy + ni * 16 * LD + ks * 32);
#pragma unroll
      for (int mi = 0; mi < MI; ++mi)
#pragma unroll
        for (int ni = 0; ni < NI; ++ni) acc[mi][ni] = mfma16(a[mi], b[ni], acc[mi][ni]);
    }
    if (more) {
      u16* dx = sX + (cur ^ 1) * XR * LD;
      u16* dy = sY + (cur ^ 1) * YR * LD;
#pragma unroll
      for (int i = 0; i < XP; ++i) *(uint4*)(dx + (lrow + i * 64) * LD + lch * 8) = rx[i];
#pragma unroll
      for (int i = 0; i < YP; ++i) *(uint4*)(dy + (lrow + i * 64) * LD + lch * 8) = ry[i];
    }
    __syncthreads();
  }
}

#define LAS __attribute__((address_space(3)))
namespace g8 {
constexpr int BM = 256, BK = 64, HALF = 128, HTB = HALF * BK * 2, NXCD = 8, WGM = 8;
DEVI int lds_byte(int r, int c) {
  const int st = (r >> 4) * 2 + (c >> 5), rr = r & 15, cc = c & 31, ob = rr * 64 + cc * 2;
  return st * 1024 + (ob ^ (((ob >> 9) & 1) << 5));
}
DEVI void stage_rc(int b, int& R, int& C) {
  const int st = b / 1024, sb = b % 1024, swz = sb ^ (((sb >> 9) & 1) << 5);
  R = (st >> 1) * 16 + swz / 64;
  C = (st & 1) * 32 + (swz % 64) / 2;
}
struct Unit { int pm, pn, aux, nt; size_t aoff, boff; };
struct Order {
  int nM, nN, nwg, G, c, K;
  DEVI void init(int nM_, int nN_, int G_, int c_, int K_ = 1024) { nM = nM_; nN = nN_; nwg = nM * nN; G = G_; c = c_; K = K_; }
  DEVI bool next(int i, Unit& u) const {
    const long L = (long)i * G + c;
    if (L >= nwg) return false;
    int wgid = (int)L;
    {
      const int q = nwg / NXCD, r = nwg % NXCD, xcd = wgid % NXCD, off = wgid / NXCD;
      wgid = (xcd < r ? xcd * (q + 1) : r * (q + 1) + (xcd - r) * q) + off;
    }
    const int nig = WGM * nN, gid = wgid / nig, fm = gid * WGM, gsz = (nM - fm) < WGM ? (nM - fm) : WGM;
    u.pm = fm + ((wgid % nig) % gsz);
    u.pn = (wgid % nig) / gsz;
    u.aux = 0;
    u.nt = K >> 6;
    u.aoff = (size_t)u.pm * 512 * K;
    u.boff = (size_t)u.pn * 512 * K;
    return true;
  }
};

DEVI int perm32(int rho) { const int n = rho >> 4, i = rho & 15; return 8 * (i >> 2) + 4 * n + (i & 3); }
template <bool PERM, class Epi, class Sched>
DEVI void gemm_phase(LAS unsigned char* lds, const u16* gA, const u16* gBt, const int K, const Sched& S, const Epi& E) {
  const int tid = otid(), wid = __builtin_amdgcn_readfirstlane(tid >> 6), lane = tid & 63, wr = wid >> 2, wc = wid & 3,
            fr = lane & 15, fq = lane >> 4;
  unsigned voffA[2], voffB[2];
#pragma unroll
  for (int i = 0; i < 2; ++i) {
    int R, C;
    stage_rc(tid * 16 + i * 8192, R, C);
    voffA[i] = (unsigned)(R * K + C) * 2u;
    const int Rb = PERM ? ((R & ~31) + perm32(R & 31)) : R;
    voffB[i] = (unsigned)(Rb * K + C) * 2u;
  }
  const size_t kstep = (size_t)(BK * 2);
  const size_t hstep = (size_t)HALF * K * 2;
  const unsigned ldsw = (unsigned)wid * 1024u;
  const int aoff = lds_byte(wr * 64 + fr, fq * 8), boff = lds_byte(wc * 32 + fr, fq * 8);
#define G8_SA(b, h) (((b) * 2 + (h)) * HTB)
#define G8_SB(b, h) ((4 + (b) * 2 + (h)) * HTB)
#define G8_STAGEV(bufoff, gbase, voff) do { _Pragma("unroll") for (int _i = 0; _i < 2; ++_i) \
    __builtin_amdgcn_global_load_lds((const unsigned*)((const char*)(gbase) + (voff)[_i]), (LAS unsigned*)(lds + (bufoff) + ldsw + _i * 8192), 16, 0, 0); } while (0)
#define G8_LDA(dst, b, h) do { _Pragma("unroll") for (int m = 0; m < 4; ++m) _Pragma("unroll") for (int k = 0; k < 2; ++k) dst[m][k] = *(const LAS bf16x8*)(lds + G8_SA(b, h) + aoff + m * 2048 + k * 1024); } while (0)
#define G8_LDB(dst, b, h) do { _Pragma("unroll") for (int n = 0; n < 2; ++n) _Pragma("unroll") for (int k = 0; k < 2; ++k) dst[n][k] = *(const LAS bf16x8*)(lds + G8_SB(b, h) + boff + n * 2048 + k * 1024); } while (0)
#define G8_MMA(ai, bj, At, Bt) do { __builtin_amdgcn_s_setprio(1); _Pragma("unroll") for (int m = 0; m < 4; ++m) _Pragma("unroll") for (int n = 0; n < 2; ++n) _Pragma("unroll") for (int k = 0; k < 2; ++k) \
    acc[ai][bj][m][n] = __builtin_amdgcn_mfma_f32_16x16x32_bf16(Bt[n][k], At[m][k], acc[ai][bj][m][n], 0, 0, 0); __builtin_amdgcn_s_setprio(0); } while (0)
#define G8_WAIT_V(n) asm volatile("s_waitcnt vmcnt(" #n ")" ::: "memory")
#define G8_WAIT_L(n) asm volatile("s_waitcnt lgkmcnt(" #n ")" ::: "memory")
#define G8_BAR __builtin_amdgcn_s_barrier()
#define G8_SCHED __builtin_amdgcn_sched_barrier(0)
  Unit cur, nxt;
  int ui = 0;
  if (!S.next(0, cur)) return;
  f32x4 acc[2][2][4][2];
#pragma unroll
  for (int a = 0; a < 2; ++a)
#pragma unroll
    for (int b = 0; b < 2; ++b)
#pragma unroll
      for (int m = 0; m < 4; ++m)
#pragma unroll
        for (int n = 0; n < 2; ++n) acc[a][b][m][n] = f32x4{0.f, 0.f, 0.f, 0.f};
  bf16x8 At[4][2], B0[2][2], B1[2][2];
  const char* cA = (const char*)gA + cur.aoff;
  const char* cB = (const char*)gBt + cur.boff;
  G8_STAGEV(G8_SB(0, 0), cB, voffB); G8_STAGEV(G8_SA(0, 0), cA, voffA); G8_STAGEV(G8_SB(0, 1), cB + hstep, voffB); G8_STAGEV(G8_SA(0, 1), cA + hstep, voffA);
  if (wr == 1) G8_BAR;
  G8_WAIT_V(4); G8_BAR;
  G8_STAGEV(G8_SB(1, 0), cB + kstep, voffB); G8_STAGEV(G8_SA(1, 0), cA + kstep, voffA); G8_STAGEV(G8_SB(1, 1), cB + hstep + kstep, voffB);
  G8_WAIT_V(6); G8_BAR;
  for (;;) {
    const bool has_next = S.next(ui + 1, nxt);
    const char* nA = has_next ? (const char*)gA + nxt.aoff : cA;
    const char* nB = has_next ? (const char*)gBt + nxt.boff : cB;
    const int nt = cur.nt;
    for (int t = 0; t < nt; t += 2) {
      const bool last = (t == nt - 2);
      const char* a1 = cA + (size_t)(t + 1) * kstep;
      const char* a2 = last ? nA : cA + (size_t)(t + 2) * kstep;
      const char* b2 = last ? nB : cB + (size_t)(t + 2) * kstep;
      const char* a3 = a2 + kstep;
      const char* b3 = b2 + kstep;
      G8_LDB(B0, 0, 0); G8_SCHED; G8_LDA(At, 0, 0); G8_STAGEV(G8_SA(1, 1), a1 + hstep, voffA);
      G8_WAIT_L(8); G8_BAR; G8_WAIT_L(0); G8_MMA(0, 0, At, B0); G8_BAR; G8_SCHED;
      G8_LDB(B1, 0, 1); G8_STAGEV(G8_SB(0, 0), b2, voffB);
      G8_BAR; G8_WAIT_L(0); G8_MMA(0, 1, At, B1); G8_BAR;
      G8_LDA(At, 0, 1); G8_STAGEV(G8_SA(0, 0), a2, voffA);
      G8_BAR; G8_WAIT_L(0); G8_MMA(1, 0, At, B0); G8_BAR; G8_SCHED;
      G8_STAGEV(G8_SB(0, 1), b2 + hstep, voffB);
      G8_WAIT_V(6); G8_BAR; G8_MMA(1, 1, At, B1); G8_BAR;
      G8_LDB(B0, 1, 0); G8_SCHED; G8_LDA(At, 1, 0); G8_STAGEV(G8_SA(0, 1), a2 + hstep, voffA);
      G8_WAIT_L(8); G8_BAR; G8_WAIT_L(0); G8_MMA(0, 0, At, B0); G8_BAR; G8_SCHED;
      G8_LDB(B1, 1, 1); G8_STAGEV(G8_SB(1, 0), b3, voffB);
      G8_BAR; G8_WAIT_L(0); G8_MMA(0, 1, At, B1); G8_BAR;
      G8_LDA(At, 1, 1); G8_STAGEV(G8_SA(1, 0), a3, voffA);
      G8_BAR; G8_WAIT_L(0); G8_MMA(1, 0, At, B0); G8_BAR; G8_SCHED;
      G8_STAGEV(G8_SB(1, 1), b3 + hstep, voffB);
      G8_WAIT_V(6); G8_BAR; G8_MMA(1, 1, At, B1); G8_BAR;
    }
    const bool zr = E(acc, cur, wr, wc, fr, fq);
    if (!has_next) break;
    if (zr)
#pragma unroll
    for (int a = 0; a < 2; ++a)
#pragma unroll
      for (int b = 0; b < 2; ++b)
#pragma unroll
        for (int m = 0; m < 4; ++m)
#pragma unroll
          for (int n = 0; n < 2; ++n) acc[a][b][m][n] = f32x4{0.f, 0.f, 0.f, 0.f};
    cur = nxt; cA = nA; cB = nB; ++ui;
  }
  G8_WAIT_V(0);
  if (wr == 0) G8_BAR;
  G8_BAR;
#undef G8_SA
#undef G8_SB
#undef G8_STAGEV
#undef G8_LDA
#undef G8_LDB
#undef G8_MMA
#undef G8_WAIT_V
#undef G8_WAIT_L
#undef G8_BAR
#undef G8_SCHED
}
}

template <int MI, int NI>
DEVI void zero_acc(f32x4 (&acc)[MI][NI]) {
#pragma unroll
  for (int mi = 0; mi < MI; ++mi)
#pragma unroll
    for (int ni = 0; ni < NI; ++ni) acc[mi][ni] = f32x4{0.f, 0.f, 0.f, 0.f};
}

DEVI void mod_item(const Params& p, int item, float* smf) {
  const int l = item / 192, n0 = (item % 192) * 32;
  const int tid = otid();
  for (int i = tid; i < 18 * 1024; i += NTHR) {
    int s = i >> 10, k = i & 1023;
    float c = s < 16 ? p.in[2][s * 1024 + k] : p.in[3][(s - 16) * 1024 + k];
    smf[i] = c / (1.f + expf(-c));
  }
  __syncthreads();
  const int ks = tid >> 5, col = tid & 31;
  float acc[18];
#pragma unroll
  for (int s = 0; s < 18; ++s) acc[s] = 0.f;
  const float* w = p.in[4] + ((size_t)l * 1024 + ks * 64) * 6144 + n0 + col;
#pragma unroll 4
  for (int k = 0; k < 64; ++k) {
    float wv = w[(size_t)k * 6144];
#pragma unroll
    for (int s = 0; s < 18; ++s) acc[s] += smf[s * 1024 + ks * 64 + k] * wv;
  }
  __syncthreads();
#pragma unroll
  for (int s = 0; s < 18; ++s) smf[(ks * 18 + s) * 32 + col] = acc[s];
  __syncthreads();
  float* mod = (float*)(p.ws + OFF_MOD);
  for (int i = tid; i < 18 * 32; i += NTHR) {
    int s = i >> 5, c = i & 31;
    float v = p.in[5][l * 6144 + n0 + c];
#pragma unroll
    for (int k2 = 0; k2 < 16; ++k2) v += smf[(k2 * 18 + s) * 32 + c];
    mod[(size_t)(l * 18 + s) * 6144 + n0 + c] = v;
  }
  __syncthreads();
}

DEVI void rope_table(const Params& p) {
  float* rope = (float*)(p.ws + OFF_ROPE);
  const int g0 = obid() * NTHR + otid(), gs = gridDim.x * NTHR;
  for (int g = g0; g < 8192 * 32; g += gs) {
    int pos = g >> 5, i = g & 31;
    float inv = (float)pow(10000.0, -(double)i / 32.0);
    float angf = (float)pos * inv;
    double x = (double)angf;
    const double TWO_PI = 6.283185307179586476925286766559;
    const double PI = 3.14159265358979323846264338327950288;
    double n = rint(x / TWO_PI);
    double r = x - n * TWO_PI;
    double cs = 1.0;
    if (r > 0.5 * PI) { r = PI - r; cs = -1.0; }
    else if (r < -0.5 * PI) { r = -PI - r; cs = -1.0; }
    double r2 = r * r;
    double sp = 1.0 / 51090942171709440000.0;
    sp = sp * r2 - 1.0 / 121645100408832000.0;
    sp = sp * r2 + 1.0 / 355687428096000.0;
    sp = sp * r2 - 1.0 / 1307674368000.0;
    sp = sp * r2 + 1.0 / 6227020800.0;
    sp = sp * r2 - 1.0 / 39916800.0;
    sp = sp * r2 + 1.0 / 362880.0;
    sp = sp * r2 - 1.0 / 5040.0;
    sp = sp * r2 + 1.0 / 120.0;
    sp = sp * r2 - 1.0 / 6.0;
    sp = sp * r2 + 1.0;
    double sn = sp * r;
    double cp = 1.0 / 2432902008176640000.0;
    cp = cp * r2 - 1.0 / 6402373705728000.0;
    cp = cp * r2 + 1.0 / 20922789888000.0;
    cp = cp * r2 - 1.0 / 87178291200.0;
    cp = cp * r2 + 1.0 / 479001600.0;
    cp = cp * r2 - 1.0 / 3628800.0;
    cp = cp * r2 + 1.0 / 40320.0;
    cp = cp * r2 - 1.0 / 720.0;
    cp = cp * r2 + 1.0 / 24.0;
    cp = cp * r2 - 0.5;
    cp = cp * r2 + 1.0;
    rope[pos * 64 + i] = (float)(cs * cp);
    rope[pos * 64 + 32 + i] = (float)sn;
  }
}

struct MapPlain { DEVI void operator()(int db, int& srcc, bool& perm) const { srcc = db * 64; perm = false; } };
struct MapWin {
  DEVI void operator()(int db, int& srcc, bool& perm) const {
    if (db < 32) {
      const int tile = db >> 2, b = db & 3;
      const int base = tile < 2 ? tile * 256 : (tile < 7 ? (tile + 1) * 256 : (tile + 2) * 256);
      srcc = base + b * 64;
      perm = tile < 2;
    } else {
      const int d2 = db - 32, tile = d2 >> 2, b = d2 & 3;
      if (tile == 0) srcc = 512 + b * 64;
      else if (tile == 1) srcc = 2048 + b * 64;
      else if (tile == 2) srcc = 256 + b * 64;
      else srcc = b < 2 ? 2688 + b * 64 : 2560 + (b - 2) * 64;
      perm = false;
    }
  }
};
template <class MapF>
DEVI void xpose_convert(const float* __restrict__ src, int K, int N, int NB, u16* __restrict__ dst, int rot, float* smf, MapF map, int DK = 0, int koff = 0) {
  if (DK == 0) DK = K;
  const int tid = otid();
  const int ntile = (K >> 6) * NB;
  const int G = gridDim.x;
  int start = (int)obid() - (rot % G);
  if (start < 0) start += G;
  for (int t = start; t < ntile; t += G) {
    const int k0 = (t / NB) << 6, db = t % NB;
    int srcc; bool perm;
    map(db, srcc, perm);
    {
      const int ch = tid & 15, kr = tid >> 4;
#pragma unroll
      for (int ps = 0; ps < 2; ++ps) {
        int k = ps * 32 + kr;
        float4 v = *(const float4*)(src + (size_t)(k0 + k) * N + srcc + ch * 4);
        float* d = smf + k * 65 + ch * 4;
        d[0] = v.x; d[1] = v.y; d[2] = v.z; d[3] = v.w;
      }
    }
    __syncthreads();
    {
      const int kc = tid & 7, n = tid >> 3;
      const int nc = perm ? ((n >> 5) * 16 + (n & 15) + ((n >> 4) & 1) * 32) : n;
      const float* sp = smf + (kc * 8) * 65 + nc;
      uint4 o;
      o.x = pack2(sp[0], sp[65]);
      o.y = pack2(sp[2 * 65], sp[3 * 65]);
      o.z = pack2(sp[4 * 65], sp[5 * 65]);
      o.w = pack2(sp[6 * 65], sp[7 * 65]);
      *(uint4*)(dst + (size_t)(db * 64 + n) * DK + koff + k0 + kc * 8) = o;
    }
    __syncthreads();
  }
}

DEVI void phase0(const Params& p, unsigned char* smem) {
  float* smf = (float*)smem;
  for (int it = obid(); it < 384; it += gridDim.x) mod_item(p, it, smf);
  rope_table(p);
  int rot = 384;
  for (int l = 0; l < 2; ++l) {
    xpose_convert(p.in[7] + (size_t)l * 2816 * 1024, 1024, 2816, 48, (u16*)(p.ws + OFF_WIN) + (size_t)l * SZ_WIN, rot, smf, MapWin());
    rot += 768;
    for (int i = 0; i < 4; ++i) {
      xpose_convert(p.in[18] + ((size_t)l * 4 + i) * 1024 * 1024, 1024, 1024, 16,
                    (u16*)(p.ws + OFF_WMERGE) + ((size_t)l * 4 + i) * 1024 * 1024, rot, smf, MapPlain());
      rot += 256;
    }
    for (int i = 0; i < 4; ++i) {
      xpose_convert(p.in[17] + ((size_t)l * 4 + i) * 256 * 1024, 256, 1024, 16,
                    (u16*)(p.ws + OFF_WBRANCH) + (size_t)l * SZ_WBRANCH, rot, smf, MapPlain(), 1024, i * 256);
      rot += 64;
    }
    xpose_convert(p.in[19] + (size_t)l * SZ_WOUT, 1024, 1024, 16, (u16*)(p.ws + OFF_WOUT) + (size_t)l * SZ_WOUT, rot, smf, MapPlain());
    rot += 256;
    xpose_convert(p.in[20] + (size_t)l * SZ_WFF, 1024, 4096, 64, (u16*)(p.ws + OFF_WFF1) + (size_t)l * SZ_WFF, rot, smf, MapPlain());
    rot += 1024;
    xpose_convert(p.in[21] + (size_t)l * SZ_WFF, 4096, 1024, 16, (u16*)(p.ws + OFF_WFF2) + (size_t)l * SZ_WFF, rot, smf, MapPlain());
    rot += 1024;
  }
}

DEVI void phase_norm(const Params& p, int layer, int which) {
  const int lane = otid() & 63, wid = otid() >> 6;
  const float* mod = (const float*)(p.ws + OFF_MOD);
  u16* H = hbuf(p);
  const u16* XB = xbuf(p);
  const float* gain = p.in[6] + (layer * 2 + which) * 1024;
  const bool first = (layer == 0 && which == 0);
  float4 g[4];
#pragma unroll
  for (int i = 0; i < 2; ++i) {
    g[2 * i] = *(const float4*)(gain + i * 512 + lane * 8);
    g[2 * i + 1] = *(const float4*)(gain + i * 512 + lane * 8 + 4);
  }
  for (int tp = obid() * 8 + wid; tp < M / 2; tp += gridDim.x * 8) {
    const int tok = tp * 2;
    int seq, pos, T;
    tokinfo(tok, seq, pos, T);
    float4 v[2][4];
    if (first) {
      const float* xr = tok < MP ? p.in[0] + (size_t)tok * 1024 : p.in[1] + (size_t)(tok - MP) * 1024;
#pragma unroll
      for (int k = 0; k < 2; ++k)
#pragma unroll
        for (int i = 0; i < 2; ++i) {
          v[k][2 * i] = *(const float4*)(xr + k * 1024 + i * 512 + lane * 8);
          v[k][2 * i + 1] = *(const float4*)(xr + k * 1024 + i * 512 + lane * 8 + 4);
        }
    } else {
      const u16* xr = XB + (size_t)tok * 1024;
#pragma unroll
      for (int k = 0; k < 2; ++k)
#pragma unroll
        for (int i = 0; i < 2; ++i) {
          const uint4 w = *(const uint4*)(xr + k * 1024 + i * 512 + lane * 8);
          v[k][2 * i] = make_float4(lo16(w.x), hi16(w.x), lo16(w.y), hi16(w.y));
          v[k][2 * i + 1] = make_float4(lo16(w.z), hi16(w.z), lo16(w.w), hi16(w.w));
        }
    }
    const float* msh = mod + (size_t)(layer * 18 + seq) * 6144 + (which ? 3 : 0) * 1024;
    const float* msc = msh + 1024;
    float4 sh[4], sc[4];
#pragma unroll
    for (int i = 0; i < 2; ++i) {
      const int c = i * 512 + lane * 8;
      sh[2 * i] = *(const float4*)(msh + c); sh[2 * i + 1] = *(const float4*)(msh + c + 4);
      sc[2 * i] = *(const float4*)(msc + c); sc[2 * i + 1] = *(const float4*)(msc + c + 4);
    }
    asm volatile("" ::: "memory");
    float ss0 = 0.f, ss1 = 0.f;
#pragma unroll
    for (int i = 0; i < 4; ++i) {
      ss0 += v[0][i].x * v[0][i].x + v[0][i].y * v[0][i].y + v[0][i].z * v[0][i].z + v[0][i].w * v[0][i].w;
      ss1 += v[1][i].x * v[1][i].x + v[1][i].y * v[1][i].y + v[1][i].z * v[1][i].z + v[1][i].w * v[1][i].w;
    }
    ss0 = wave_sum(ss0);
    ss1 = wave_sum(ss1);
    const float rs[2] = {rsqrtf(ss0 * (1.f / 1024.f) + 1e-6f), rsqrtf(ss1 * (1.f / 1024.f) + 1e-6f)};
#pragma unroll
    for (int k = 0; k < 2; ++k)
#pragma unroll
      for (int i = 0; i < 2; ++i) {
        const float rstd = rs[k];
        const float4 xa = v[k][2 * i], xb = v[k][2 * i + 1];
        const float4 ga = g[2 * i], gb = g[2 * i + 1], sa = sc[2 * i], sb2 = sc[2 * i + 1], ha = sh[2 * i], hb = sh[2 * i + 1];
        uint4 w;
        w.x = pack2(xa.x * rstd * ga.x * (1.f + sa.x) + ha.x, xa.y * rstd * ga.y * (1.f + sa.y) + ha.y);
        w.y = pack2(xa.z * rstd * ga.z * (1.f + sa.z) + ha.z, xa.w * rstd * ga.w * (1.f + sa.w) + ha.w);
        w.z = pack2(xb.x * rstd * gb.x * (1.f + sb2.x) + hb.x, xb.y * rstd * gb.y * (1.f + sb2.y) + hb.y);
        w.w = pack2(xb.z * rstd * gb.z * (1.f + sb2.z) + hb.z, xb.w * rstd * gb.w * (1.f + sb2.w) + hb.w);
        *(uint4*)(H + (size_t)(tok + k) * 1024 + i * 512 + lane * 8) = w;
      }
  }
}

DEVI void phase_final(const Params& p) {
  const int lane = otid() & 63, wid = otid() >> 6;
  const float* gain = p.in[22];
  const u16* XB = xbuf(p);
  float4 gg[4];
#pragma unroll
  for (int i = 0; i < 2; ++i) {
    gg[2 * i] = *(const float4*)(gain + i * 512 + lane * 8);
    gg[2 * i + 1] = *(const float4*)(gain + i * 512 + lane * 8 + 4);
  }
  for (int tp = obid() * 8 + wid; tp < M / 2; tp += gridDim.x * 8) {
    const u16* xr = XB + (size_t)tp * 2048;
    float* orow = p.out + (size_t)tp * 2048;
    float4 v[2][4];
#pragma unroll
    for (int k = 0; k < 2; ++k)
#pragma unroll
      for (int i = 0; i < 2; ++i) {
        const uint4 w = *(const uint4*)(xr + k * 1024 + i * 512 + lane * 8);
        v[k][2 * i] = make_float4(lo16(w.x), hi16(w.x), lo16(w.y), hi16(w.y));
        v[k][2 * i + 1] = make_float4(lo16(w.z), hi16(w.z), lo16(w.w), hi16(w.w));
      }
    asm volatile("" ::: "memory");
    float ss0 = 0.f, ss1 = 0.f;
#pragma unroll
    for (int i = 0; i < 4; ++i) {
      ss0 += v[0][i].x * v[0][i].x + v[0][i].y * v[0][i].y + v[0][i].z * v[0][i].z + v[0][i].w * v[0][i].w;
      ss1 += v[1][i].x * v[1][i].x + v[1][i].y * v[1][i].y + v[1][i].z * v[1][i].z + v[1][i].w * v[1][i].w;
    }
    ss0 = wave_sum(ss0);
    ss1 = wave_sum(ss1);
    const float rs[2] = {rsqrtf(ss0 * (1.f / 1024.f) + 1e-6f), rsqrtf(ss1 * (1.f / 1024.f) + 1e-6f)};
#pragma unroll
    for (int k = 0; k < 2; ++k)
#pragma unroll
      for (int i = 0; i < 4; ++i) {
        const int c = (i >> 1) * 512 + lane * 8 + (i & 1) * 4;
        float4 o;
        o.x = v[k][i].x * rs[k] * gg[i].x; o.y = v[k][i].y * rs[k] * gg[i].y;
        o.z = v[k][i].z * rs[k] * gg[i].z; o.w = v[k][i].w * rs[k] * gg[i].w;
        *(float4*)(orow + k * 1024 + c) = o;
      }
  }
}

struct EpiG1Nat {
  unsigned char* ws;
  DEVI bool operator()(f32x4 (&acc)[2][2][4][2], const g8::Unit& u, int wr, int wc, int fr, int fq) const {
    const int t0 = u.pm * 256, pn = u.pn;
    int seq, pos0, T;
    tokinfo(t0, seq, pos0, T);
    if (pn < 2) {
      const float* rope = (const float*)(ws + OFF_ROPE);
      u16* dst = (u16*)(ws + (pn == 0 ? OFF_RQ : OFF_RK));
      const float scale = pn == 0 ? 0.125f : 1.f;
      const int d1 = (wc & 1) * 16 + fq * 4;
      const float* rp0 = rope + (size_t)(pos0 + wr * 64 + fr) * 64 + d1;
      u16* o0 = dst + (size_t)(t0 + wr * 64 + fr) * 256 + (wc >> 1) * 64 + d1;
#pragma unroll
      for (int ai = 0; ai < 2; ++ai) {
        float4 cc[4], ss[4];
#pragma unroll
        for (int m = 0; m < 4; ++m) {
          const float* rp = rp0 + (ai * 128 + m * 16) * 64;
          cc[m] = *(const float4*)rp;
          ss[m] = *(const float4*)(rp + 32);
        }
        asm volatile("" ::: "memory");
#pragma unroll
        for (int m = 0; m < 4; ++m) {
          const float4 c = cc[m], sn = ss[m];
#pragma unroll
          for (int bj = 0; bj < 2; ++bj) {
            const f32x4 x1 = acc[ai][bj][m][0], x2 = acc[ai][bj][m][1];
            u16* o = o0 + (ai * 128 + m * 16) * 256 + bj * 128;
            *(uint2*)o = pack4((x1[0] * c.x - x2[0] * sn.x) * scale, (x1[1] * c.y - x2[1] * sn.y) * scale,
                               (x1[2] * c.z - x2[2] * sn.z) * scale, (x1[3] * c.w - x2[3] * sn.w) * scale);
            *(uint2*)(o + 32) = pack4((x1[0] * sn.x + x2[0] * c.x) * scale, (x1[1] * sn.y + x2[1] * c.y) * scale,
                                      (x1[2] * sn.z + x2[2] * c.z) * scale, (x1[3] * sn.w + x2[3] * c.w) * scale);
          }
        }
        asm volatile("" ::: "memory");
      }
    } else {
      size_t off; int width = 256, op = 0; float scale = 1.f;
      if (pn == 2) { off = OFF_RG; op = 2; }
      else if (pn == 3) { off = OFF_CA; }
      else if (pn == 4) { off = OFF_CB; op = 3; }
      else if (pn == 5) { off = OFF_NQ; scale = 0.125f; }
      else if (pn == 6) { off = OFF_NK; }
      else if (pn == 7) { off = OFF_SQ; scale = 0.125f; }
      else { off = OFF_SK; width = 128; }
      u16* o0 = (u16*)(ws + off) + (size_t)(t0 + wr * 64 + fr) * width + wc * 32 + fq * 4;
#pragma unroll
      for (int ai = 0; ai < 2; ++ai)
#pragma unroll
        for (int m = 0; m < 4; ++m) {
          u16* orow = o0 + (size_t)((ai * 128 + m * 16) * width);
#pragma unroll
          for (int bj = 0; bj < 2; ++bj) {
            if (pn == 8 && bj == 1) continue;
#pragma unroll
            for (int n = 0; n < 2; ++n) {
              const f32x4 v = acc[ai][bj][m][n];
              float q0, q1, q2, q3;
              if (op == 2) { q0 = v[0] * sigmoidf_(v[0]); q1 = v[1] * sigmoidf_(v[1]); q2 = v[2] * sigmoidf_(v[2]); q3 = v[3] * sigmoidf_(v[3]); }
              else if (op == 3) { q0 = sigmoidf_(v[0]); q1 = sigmoidf_(v[1]); q2 = sigmoidf_(v[2]); q3 = sigmoidf_(v[3]); }
              else { q0 = v[0] * scale; q1 = v[1] * scale; q2 = v[2] * scale; q3 = v[3] * scale; }
              *(uint2*)(orow + bj * 128 + n * 16) = pack4(q0, q1, q2, q3);
            }
          }
          asm volatile("" ::: "memory");
        }
    }
    return true;
  }
};
struct EpiG1Tr {
  unsigned char* ws;
  DEVI bool operator()(f32x4 (&acc)[2][2][4][2], const g8::Unit& u, int wr, int wc, int fr, int fq) const {
    const int pm = u.pm, tb = u.pn * 256;
    int seq, pos0, T;
    tokinfo(tb, seq, pos0, T);
    if (pm == 2) {
      const float* rope = (const float*)(ws + OFF_ROPE);
      u16* dst = (u16*)(ws + OFF_RKT);
      const float* rp0 = rope + (size_t)(pos0 + wc * 32 + fq * 4) * 64 + fr;
      u16* o0 = dst + (size_t)(wr * 64 + fr) * M + tb + wc * 32 + fq * 4;
#pragma unroll
      for (int ai = 0; ai < 2; ++ai)
#pragma unroll
        for (int m = 0; m < 2; ++m) {
          float cv[2][2][4], sv[2][2][4];
#pragma unroll
          for (int bj = 0; bj < 2; ++bj)
#pragma unroll
            for (int n = 0; n < 2; ++n) {
              const float* rp = rp0 + (bj * 128 + n * 16) * 64 + m * 16;
#pragma unroll
              for (int j = 0; j < 4; ++j) { cv[bj][n][j] = rp[j * 64]; sv[bj][n][j] = rp[j * 64 + 32]; }
            }
          asm volatile("" ::: "memory");
#pragma unroll
          for (int bj = 0; bj < 2; ++bj)
#pragma unroll
            for (int n = 0; n < 2; ++n) {
              const f32x4 x1 = acc[ai][bj][m][n], x2 = acc[ai][bj][m + 2][n];
              float o1[4], o2[4];
#pragma unroll
              for (int j = 0; j < 4; ++j) {
                const float c = cv[bj][n][j], sn = sv[bj][n][j];
                o1[j] = x1[j] * c - x2[j] * sn;
                o2[j] = x1[j] * sn + x2[j] * c;
              }
              u16* o = o0 + (size_t)(ai * 128 + m * 16) * M + bj * 128 + n * 16;
              *(uint2*)o = pack4(o1[0], o1[1], o1[2], o1[3]);
              *(uint2*)(o + (size_t)32 * M) = pack4(o2[0], o2[1], o2[2], o2[3]);
            }
          asm volatile("" ::: "memory");
        }
    } else {
      u16* dst = (u16*)(ws + (pm == 0 ? OFF_RVT : (pm == 1 ? OFF_NVT : OFF_SVT)));
      u16* o0 = dst + (size_t)(wr * 64 + fr) * M + tb + wc * 32 + fq * 4;
      const long half1 = pm == 3 ? ((long)(OFF_SK - OFF_SVT) / 2 - (long)128 * M) : 0;
#pragma unroll
      for (int ai = 0; ai < 2; ++ai) {
#pragma unroll
        for (int m = 0; m < 4; ++m) {
          u16* orow = o0 + (size_t)(ai * 128 + m * 16) * M + (ai ? half1 : 0);
#pragma unroll
          for (int bj = 0; bj < 2; ++bj)
#pragma unroll
            for (int n = 0; n < 2; ++n) {
              const f32x4 v = acc[ai][bj][m][n];
              *(uint2*)(orow + bj * 128 + n * 16) = pack4(v[0], v[1], v[2], v[3]);
            }
          asm volatile("" ::: "memory");
        }
      }
    }
    return true;
  }
};
DEVI void phase_gemm1(const Params& p, int layer, unsigned char* smem) {
  const u16* H = hbuf(p);
  const u16* W = (const u16*)(p.ws + OFF_WIN) + (size_t)layer * SZ_WIN;
  g8::Order S;
  S.init(M / 256, 8, gridDim.x, obid(), 1024);
  EpiG1Nat e1{p.ws};
  g8::gemm_phase<false>((LAS unsigned char*)smem, H, W, 1024, S, e1);
  g8::Order S2;
  S2.init(4, M / 256, gridDim.x, obid(), 1024);
  EpiG1Tr e2{p.ws};
  g8::gemm_phase<false>((LAS unsigned char*)smem, W + (size_t)2048 * 1024, H, 1024, S2, e2);
}

DEVI void phase_ret_u(const Params& p, int layer) {
  const int lane = otid() & 63, wid = otid() >> 6, fr = lane & 15, fq = lane >> 4;
  const u16* RKT = (const u16*)(p.ws + OFF_RKT);
  const u16* RVT = (const u16*)(p.ws + OFF_RVT);
  float* U = (float*)(p.ws + OFF_U);
  for (int u = obid() * 8 + wid; u < 2560; u += gridDim.x * 8) {
    const int h = u & 3, cgi = u >> 2, tok0 = cgi * 128;
    const float l2f = log_sigmoid(p.in[8][(layer * 2 + 0) * 4 + h]) * 1.4426950408889634f;
    const float l2b = log_sigmoid(p.in[8][(layer * 2 + 1) * 4 + h]) * 1.4426950408889634f;
#pragma unroll 1
    for (int hf = 0; hf < 2; ++hf) {
      f32x4 aF[4][2], aB[4][2];
      zero_acc<4, 2>(aF);
      zero_acc<4, 2>(aB);
#pragma unroll 1
      for (int ks = 0; ks < 4; ++ks) {
        const int m0 = ks * 32 + fq * 8;
        bf16x8 av[4];
#pragma unroll
        for (int dvt = 0; dvt < 4; ++dvt)
          av[dvt] = *(const bf16x8*)(RVT + (size_t)(h * 64 + dvt * 16 + fr) * M + tok0 + m0);
#pragma unroll
        for (int d2 = 0; d2 < 2; ++d2) {
          const int dkt = hf * 2 + d2;
          uint4 kr = *(const uint4*)(RKT + (size_t)(h * 64 + dkt * 16 + fr) * M + tok0 + m0);
          const unsigned kw[4] = {kr.x, kr.y, kr.z, kr.w};
          V8 kf, kb;
          unsigned of_[4], ob_[4];
#pragma unroll
          for (int e2 = 0; e2 < 4; ++e2) {
            const int m = m0 + e2 * 2;
            const float zf0 = exp2f(l2f * (float)(127 - m)), zf1 = exp2f(l2f * (float)(126 - m));
            const float zb0 = exp2f(l2b * (float)m), zb1 = exp2f(l2b * (float)(m + 1));
            of_[e2] = pack2(lo16(kw[e2]) * zf0, hi16(kw[e2]) * zf1);
            ob_[e2] = pack2(lo16(kw[e2]) * zb0, hi16(kw[e2]) * zb1);
          }
          kf.u = make_uint4(of_[0], of_[1], of_[2], of_[3]);
          kb.u = make_uint4(ob_[0], ob_[1], ob_[2], ob_[3]);
#pragma unroll
          for (int dvt = 0; dvt < 4; ++dvt) {
            aF[dvt][d2] = mfma16(av[dvt], kf.v, aF[dvt][d2]);
            aB[dvt][d2] = mfma16(av[dvt], kb.v, aB[dvt][d2]);
          }
        }
      }
      float* uf = U + (size_t)(u * 2 + 0) * 4096;
      float* ub = U + (size_t)(u * 2 + 1) * 4096;
#pragma unroll
      for (int dvt = 0; dvt < 4; ++dvt)
#pragma unroll
        for (int d2 = 0; d2 < 2; ++d2)
#pragma unroll
          for (int j = 0; j < 4; ++j) {
            const int idx = (dvt * 16 + fq * 4 + j) * 64 + (hf * 2 + d2) * 16 + fr;
            uf[idx] = aF[dvt][d2][j];
            ub[idx] = aB[dvt][d2][j];
          }
    }
  }
}

DEVI void phase_ret_scan(const Params& p, int layer) {
  const float* U = (const float*)(p.ws + OFF_U);
  u16* R = (u16*)(p.ws + OFF_R);
  const int total = 72 * 2 * 4096;
  for (int g = obid() * NTHR + otid(); g < total; g += gridDim.x * NTHR) {
    const int e = g & 4095, dir = (g >> 12) & 1, bh = g >> 13, h = bh & 3, b = bh >> 2;
    int base, N;
    if (b < 16) { base = b * 32; N = 32; } else { base = 512 + (b - 16) * 64; N = 64; }
    const float gC = expf(128.f * log_sigmoid(p.in[8][(layer * 2 + dir) * 4 + h]));
    float run = 0.f;
    const int nb = N >> 4;
#pragma unroll 1
    for (int bb = 0; bb < nb; ++bb) {
      float uv[16];
#pragma unroll
      for (int k = 0; k < 16; ++k) {
        const int n = dir == 0 ? (bb * 16 + k) : (N - 1 - (bb * 16 + k));
        uv[k] = U[((size_t)((base + n) * 4 + h) * 2 + dir) * 4096 + e];
      }
      asm volatile("" ::: "memory");
#pragma unroll
      for (int k = 0; k < 16; ++k) {
        const int n = dir == 0 ? (bb * 16 + k) : (N - 1 - (bb * 16 + k));
        R[((size_t)((base + n) * 4 + h) * 2 + dir) * 4096 + e] = f2bf(run);
        run = gC * run + uv[k];
      }
    }
  }
}

DEVI void phase_ret_out(const Params& p, int layer, unsigned char* smem) {
  constexpr int KLD = 68, VLD = 136, RLD = 72;
  u16* Ks = (u16*)smem;
  u16* Vs = (u16*)(smem + 17408);
  u16* Rfs = (u16*)(smem + 34816);
  u16* Rbs = (u16*)(smem + 44032);
  const int tid = otid(), lane = tid & 63, wid = tid >> 6, fr = lane & 15, fq = lane >> 4;
  const u16* RQ = (const u16*)(p.ws + OFF_RQ);
  const u16* RK = (const u16*)(p.ws + OFF_RK);
  const u16* RVT = (const u16*)(p.ws + OFF_RVT);
  const u16* RG = (const u16*)(p.ws + OFF_RG);
  const u16* R = (const u16*)(p.ws + OFF_R);
  u16* BR = brbuf(p);
  const float* gn = p.in[9] + layer * 256;
  for (int it = obid(); it < 2560; it += gridDim.x) {
    const int h = it & 3, cgi = it >> 2, ctok0 = cgi * 128, c0 = wid * 16, tok0 = ctok0 + c0;
    for (int c = tid; c < 3072; c += NTHR) {
      if (c < 1024) {
        const int k = c >> 3, part = c & 7;
        const uint4 v = *(const uint4*)(RK + (size_t)(ctok0 + k) * 256 + h * 64 + part * 8);
        uint2* d = (uint2*)(Ks + k * KLD + part * 8);
        d[0] = make_uint2(v.x, v.y);
        d[1] = make_uint2(v.z, v.w);
      } else if (c < 2048) {
        const int c2 = c - 1024, d = c2 >> 4, part = c2 & 15;
        *(uint4*)(Vs + d * VLD + part * 8) = *(const uint4*)(RVT + (size_t)(h * 64 + d) * M + ctok0 + part * 8);
      } else {
        const int c2 = c - 2048, dir = c2 >> 9, c3 = c2 & 511, dv = c3 >> 3, part = c3 & 7;
        *(uint4*)((dir ? Rbs : Rfs) + dv * RLD + part * 8) =
            *(const uint4*)(R + (size_t)((cgi * 4 + h) * 2 + dir) * 4096 + dv * 64 + part * 8);
      }
    }
    __syncthreads();
    const float l2f = log_sigmoid(p.in[8][(layer * 2 + 0) * 4 + h]) * 1.4426950408889634f;
    const float l2b = log_sigmoid(p.in[8][(layer * 2 + 1) * 4 + h]) * 1.4426950408889634f;
    const u16* qp = RQ + (size_t)(tok0 + fr) * 256 + h * 64 + fq * 8;
    const bf16x8 q0 = *(const bf16x8*)qp, q1 = *(const bf16x8*)(qp + 32);
    const int c = c0 + fr;
    f32x4 s[8];
    const u16* kl0 = Ks + (8 * (fr >> 2) + (fr & 3)) * KLD + fq * 8;
#pragma unroll
    for (int t = 0; t < 8; ++t) {
      const u16* kp = kl0 + ((t >> 1) * 32 + (t & 1) * 4) * KLD;
      V8 k0, k1;
      k0.h[0] = *(const uint2*)kp;        k0.h[1] = *(const uint2*)(kp + 4);
      k1.h[0] = *(const uint2*)(kp + 32); k1.h[1] = *(const uint2*)(kp + 36);
      f32x4 a = {0.f, 0.f, 0.f, 0.f};
      a = mfma16(k0.v, q0, a);
      a = mfma16(k1.v, q1, a);
#pragma unroll
      for (int j = 0; j < 4; ++j) {
        const int m = (t >> 1) * 32 + 8 * fq + 4 * (t & 1) + j;
        const int diff = c - m;
        const float dec = diff >= 0 ? __builtin_amdgcn_exp2f(l2f * (float)diff) : __builtin_amdgcn_exp2f(l2b * (float)(-diff));
        a[j] *= dec;
      }
      s[t] = a;
      asm volatile("" ::: "memory");
    }
    f32x4 o[4], iF[4], iB[4];
#pragma unroll
    for (int dt = 0; dt < 4; ++dt) { o[dt] = f32x4{0.f, 0.f, 0.f, 0.f}; iF[dt] = o[dt]; iB[dt] = o[dt]; }
    const u16* vl0 = Vs + fr * VLD + fq * 8;
#pragma unroll
    for (int ks = 0; ks < 4; ++ks) {
      V8 pb;
      pb.h[0] = pack4(s[2 * ks][0], s[2 * ks][1], s[2 * ks][2], s[2 * ks][3]);
      pb.h[1] = pack4(s[2 * ks + 1][0], s[2 * ks + 1][1], s[2 * ks + 1][2], s[2 * ks + 1][3]);
#pragma unroll
      for (int dt = 0; dt < 4; ++dt) {
        V8 va;
        va.u = *(const uint4*)(vl0 + dt * 16 * VLD + ks * 32);
        o[dt] = mfma16(va.v, pb.v, o[dt]);
      }
      asm volatile("" ::: "memory");
    }
    {
      const u16* rf = Rfs + fr * RLD + fq * 8;
      const u16* rb = Rbs + fr * RLD + fq * 8;
#pragma unroll
      for (int dt = 0; dt < 4; ++dt) {
        iF[dt] = mfma16(*(const bf16x8*)(rf + dt * 16 * RLD), q0, iF[dt]);
        iF[dt] = mfma16(*(const bf16x8*)(rf + dt * 16 * RLD + 32), q1, iF[dt]);
        iB[dt] = mfma16(*(const bf16x8*)(rb + dt * 16 * RLD), q0, iB[dt]);
        iB[dt] = mfma16(*(const bf16x8*)(rb + dt * 16 * RLD + 32), q1, iB[dt]);
      }
    }
    const float xif = exp2f(l2f * (float)(c + 1)), xib = exp2f(l2b * (float)(128 - c));
    float sum = 0.f;
#pragma unroll
    for (int dt = 0; dt < 4; ++dt)
#pragma unroll
      for (int j = 0; j < 4; ++j) {
        o[dt][j] += xif * iF[dt][j] + xib * iB[dt][j];
        sum += o[dt][j];
      }
    sum += __shfl_xor(sum, 16);
    sum += __shfl_xor(sum, 32);
    const float mu = sum * (1.f / 64.f);
    float vs = 0.f;
#pragma unroll
    for (int dt = 0; dt < 4; ++dt)
#pragma unroll
      for (int j = 0; j < 4; ++j) { float d = o[dt][j] - mu; vs += d * d; }
    vs += __shfl_xor(vs, 16);
    vs += __shfl_xor(vs, 32);
    const float rstd = rsqrtf(vs * (1.f / 64.f) + 1e-6f);
#pragma unroll
    for (int dt = 0; dt < 4; ++dt) {
      const int ch = h * 64 + dt * 16 + fq * 4;
      float4 g = *(const float4*)(gn + ch);
      uint2 sg = *(const uint2*)(RG + (size_t)(tok0 + fr) * 256 + ch);
      float r0 = (o[dt][0] - mu) * rstd * g.x * lo16(sg.x);
      float r1 = (o[dt][1] - mu) * rstd * g.y * hi16(sg.x);
      float r2 = (o[dt][2] - mu) * rstd * g.z * lo16(sg.y);
      float r3 = (o[dt][3] - mu) * rstd * g.w * hi16(sg.y);
      *(uint2*)(BR + (size_t)(tok0 + fr) * 1024 + ch) = pack4(r0, r1, r2, r3);
    }
    __syncthreads();
  }
}

DEVI void phase_conv(const Params& p, int layer, unsigned char* smem) {
  const int tid = otid(), lane = tid & 63, wid = tid >> 6, half = tid >> 8, ct = tid & 255;
  float* su = (float*)smem + half * (62 * 256);
  const u16* CA = (const u16*)(p.ws + OFF_CA);
  const u16* CB = (const u16*)(p.ws + OFF_CB);
  u16* BR = brbuf(p) + 256;
  float w[31];
#pragma unroll
  for (int j = 0; j < 31; ++j) w[j] = p.in[10][(layer * 31 + j) * 256 + ct];
  const float bias = p.in[11][layer * 256 + ct];
  const float4 lg = *(const float4*)(p.in[12] + layer * 256 + lane * 4);
  const float4 lbb = *(const float4*)(p.in[13] + layer * 256 + lane * 4);
  for (int it = obid(); it < 1280; it += gridDim.x) {
    const int t0 = (it * 2 + half) * 32;
    int seq, pos0, T;
    tokinfo(t0, seq, pos0, T);
    const int sb = t0 - pos0;
    {
      const int ch = ct & 31, rr = ct >> 5;
#pragma unroll
      for (int ps = 0; ps < 8; ++ps) {
        const int row = ps * 8 + rr;
        if (row < 62) {
          const int pos = pos0 - 15 + row;
          float u[8];
          if (pos >= 0 && pos < T) {
            uint4 a = *(const uint4*)(CA + (size_t)(sb + pos) * 256 + ch * 8);
            uint4 b = *(const uint4*)(CB + (size_t)(sb + pos) * 256 + ch * 8);
            u[0] = lo16(a.x) * lo16(b.x); u[1] = hi16(a.x) * hi16(b.x);
            u[2] = lo16(a.y) * lo16(b.y); u[3] = hi16(a.y) * hi16(b.y);
            u[4] = lo16(a.z) * lo16(b.z); u[5] = hi16(a.z) * hi16(b.z);
            u[6] = lo16(a.w) * lo16(b.w); u[7] = hi16(a.w) * hi16(b.w);
          } else {
#pragma unroll
            for (int e = 0; e < 8; ++e) u[e] = 0.f;
          }
          float* d = su + row * 256 + ch * 8;
          *(float4*)d = make_float4(u[0], u[1], u[2], u[3]);
          *(float4*)(d + 4) = make_float4(u[4], u[5], u[6], u[7]);
        }
      }
    }
    __syncthreads();
    float y[32];
#pragma unroll
    for (int t = 0; t < 32; ++t) y[t] = bias;
#pragma unroll
    for (int r = 0; r < 62; ++r) {
      const float uv = su[r * 256 + ct];
#pragma unroll
      for (int t = 0; t < 32; ++t) {
        const int j = r - t;
        if (j >= 0 && j < 31) y[t] += uv * w[j];
      }
    }
    __syncthreads();
#pragma unroll
    for (int t = 0; t < 32; ++t) su[t * 256 + ct] = y[t];
    __syncthreads();
#pragma unroll 1
    for (int tt = 0; tt < 8; ++tt) {
      const int t = (wid & 3) * 8 + tt;
      float4 v = *(const float4*)(su + t * 256 + lane * 4);
      float sm = wave_sum(v.x + v.y + v.z + v.w);
      const float mu = sm * (1.f / 256.f);
      float d0 = v.x - mu, d1 = v.y - mu, d2 = v.z - mu, d3 = v.w - mu;
      float vs = wave_sum(d0 * d0 + d1 * d1 + d2 * d2 + d3 * d3);
      const float rstd = rsqrtf(vs * (1.f / 256.f) + 1e-6f);
      float z0 = d0 * rstd * lg.x + lbb.x, z1 = d1 * rstd * lg.y + lbb.y, z2 = d2 * rstd * lg.z + lbb.z,
            z3 = d3 * rstd * lg.w + lbb.w;
      z0 *= sigmoidf_(z0); z1 *= sigmoidf_(z1); z2 *= sigmoidf_(z2); z3 *= sigmoidf_(z3);
      *(uint2*)(BR + (size_t)(t0 + t) * 1024 + lane * 4) = pack4(z0, z1, z2, z3);
    }
    __syncthreads();
  }
}

DEVI void phase_na(const Params& p, int layer, unsigned char* smem) {
  constexpr int KLD = 68, VLD = 488;
  u16* Ks = (u16*)smem;
  u16* Vs = (u16*)(smem + 65280);
  float* rpb = (float*)(smem + 65280 + 62464);
  const int tid = otid(), lane = tid & 63, wid = tid >> 6, fr = lane & 15, fq = lane >> 4;
  const u16* NQ = (const u16*)(p.ws + OFF_NQ);
  const u16* NK = (const u16*)(p.ws + OFF_NK);
  const u16* NVT = (const u16*)(p.ws + OFF_NVT);
  u16* BR = brbuf(p);
  for (int it = obid(); it < 2560; it += gridDim.x) {
    const int h = it & 3, jb = (it >> 2) & 3, rgi = it >> 4;
    int sb, T, rg;
    if (rgi < 128) { sb = (rgi >> 3) * 4096; T = 4096; rg = rgi & 7; }
    else { const int q = rgi - 128; sb = MP + (q >> 4) * 8192; T = 8192; rg = q & 15; }
    const int rows = T >> 6;
    const int r0 = rg * 8;
    int lo = r0 - 4; lo = lo < 0 ? 0 : (lo > rows - 8 ? rows - 8 : lo);
    int hi = r0 + 7 - 4; hi = hi < 0 ? 0 : (hi > rows - 8 ? rows - 8 : hi); hi += 7;
    const int nrow = hi - lo + 1;
    const int kb = jb == 0 ? 0 : (jb == 1 ? 8 : (jb == 2 ? 24 : 32));
    for (int i = tid; i < 465; i += NTHR) rpb[i] = p.in[14][(layer * 4 + h) * 465 + i];
    {
      const int nk = nrow * 32 * 8;
      for (int c = tid; c < nk; c += NTHR) {
        const int k = c >> 3, part = c & 7;
        const uint4 v = *(const uint4*)(NK + (size_t)(sb + (lo + (k >> 5)) * 64 + kb + (k & 31)) * 256 + h * 64 + part * 8);
        uint2* d = (uint2*)(Ks + k * KLD + part * 8);
        d[0] = make_uint2(v.x, v.y);
        d[1] = make_uint2(v.z, v.w);
      }
      const int nv = 64 * nrow * 4;
      for (int c = tid; c < nv; c += NTHR) {
        const int d = c / (nrow * 4), rem = c - d * (nrow * 4), seg = rem >> 2, part = rem & 3;
        const uint4 v = *(const uint4*)(NVT + (size_t)(h * 64 + d) * M + sb + (lo + seg) * 64 + kb + part * 8);
        *(uint4*)(Vs + d * VLD + seg * 32 + part * 8) = v;
      }
    }
    __syncthreads();
    {
      const int r = r0 + wid;
      const int pos0 = r * 64 + jb * 16, tok0 = sb + pos0, qc0 = jb * 16;
      int start = r - 4;
      start = start < 0 ? 0 : (start > rows - 8 ? rows - 8 : start);
      const int rel0 = start - lo;
      const u16* qp = NQ + (size_t)(tok0 + fr) * 256 + h * 64 + fq * 8;
      const bf16x8 q0 = *(const bf16x8*)qp, q1 = *(const bf16x8*)(qp + 32);
      const int qcol = qc0 + fr;
      int wst = qcol - 8;
      wst = wst < 0 ? 0 : (wst > 48 ? 48 : wst);
      f32x4 s[16];
      float mx = -3e38f;
      const u16* kl0 = Ks + (rel0 * 32 + 8 * (fr >> 2) + (fr & 3)) * KLD + fq * 8;
#pragma unroll
      for (int t = 0; t < 16; ++t) {
        const int i = t >> 1, pp = t & 1;
        const u16* kp = kl0 + (i * 32 + pp * 4) * KLD;
        V8 k0, k1;
        k0.h[0] = *(const uint2*)kp;        k0.h[1] = *(const uint2*)(kp + 4);
        k1.h[0] = *(const uint2*)(kp + 32); k1.h[1] = *(const uint2*)(kp + 36);
        f32x4 a = {0.f, 0.f, 0.f, 0.f};
        a = mfma16(k0.v, q0, a);
        a = mfma16(k1.v, q1, a);
        const int dr = start + i - r + 7;
#pragma unroll
        for (int j = 0; j < 4; ++j) {
          const int kcol = kb + 8 * fq + 4 * pp + j;
          const int rel = kcol - wst;
          int dc = kcol - qcol + 15;
          dc = dc < 0 ? 0 : (dc > 30 ? 30 : dc);
          const bool ok = (rel >= 0) && (rel < 16);
          const float v = ok ? a[j] + rpb[dr * 31 + dc] : -1e30f;
          a[j] = v;
          mx = fmaxf(mx, v);
        }
        s[t] = a;
      }
      mx = fmaxf(mx, __shfl_xor(mx, 16));
      mx = fmaxf(mx, __shfl_xor(mx, 32));
      float sum = 0.f;
#pragma unroll
      for (int t = 0; t < 16; ++t)
#pragma unroll
        for (int j = 0; j < 4; ++j) { float e = fast_exp(s[t][j] - mx); s[t][j] = e; sum += e; }
      sum += __shfl_xor(sum, 16);
      sum += __shfl_xor(sum, 32);
      const float inv = fast_rcp(sum);
      f32x4 o[4];
#pragma unroll
      for (int dt = 0; dt < 4; ++dt) o[dt] = f32x4{0.f, 0.f, 0.f, 0.f};
      const u16* vl0 = Vs + fr * VLD + rel0 * 32 + fq * 8;
#pragma unroll
      for (int ks = 0; ks < 8; ++ks) {
        V8 pb;
        pb.h[0] = pack4(s[2 * ks][0] * inv, s[2 * ks][1] * inv, s[2 * ks][2] * inv, s[2 * ks][3] * inv);
        pb.h[1] = pack4(s[2 * ks + 1][0] * inv, s[2 * ks + 1][1] * inv, s[2 * ks + 1][2] * inv, s[2 * ks + 1][3] * inv);
#pragma unroll
        for (int dt = 0; dt < 4; ++dt) {
          V8 va;
          va.u = *(const uint4*)(vl0 + dt * 16 * VLD + ks * 32);
          o[dt] = mfma16(va.v, pb.v, o[dt]);
        }
      }
#pragma unroll
      for (int dt = 0; dt < 4; ++dt)
        *(uint2*)(BR + (size_t)(tok0 + fr) * 1024 + 512 + h * 64 + dt * 16 + fq * 4) =
            pack4(o[dt][0], o[dt][1], o[dt][2], o[dt][3]);
    }
    __syncthreads();
  }
}

DEVI int t5_bucket_dev(int rel) {
  int n = rel < 0 ? -rel : rel;
  int b;
  if (n < 8) b = n;
  else b = 8 + (n >= 12) + (n >= 16) + (n >= 23) + (n >= 32) + (n >= 46) + (n >= 64) + (n >= 91);
  return (rel > 0 ? 16 : 0) + b;
}

DEVI void phase_swa(const Params& p, int layer, unsigned char* smem) {
  constexpr int KLD = 68, VLD = 392;
  u16* Ks = (u16*)smem;
  u16* Vs = (u16*)(smem + 52224);
  float* lut = (float*)(smem + 52224 + 50176);
  const int tid = otid(), lane = tid & 63, wid = tid >> 6, fr = lane & 15, fq = lane >> 4;
  const u16* SQ = (const u16*)(p.ws + OFF_SQ);
  const u16* SK = (const u16*)(p.ws + OFF_SK);
  const u16* SVT = (const u16*)(p.ws + OFF_SVT);
  u16* BR = brbuf(p);
  for (int it = obid(); it < 1280; it += gridDim.x) {
    const int hkv = it & 1, blk = it >> 1, tokb = blk * 128;
    int seq, posb, T;
    tokinfo(tokb, seq, posb, T);
    const int sb = tokb - posb;
    const int wlo = posb - 128;
    for (int i = tid; i < 2 * 257; i += NTHR) {
      const int g = i / 257, rel = (i % 257) - 128;
      lut[i] = p.in[16][t5_bucket_dev(rel) * 4 + hkv * 2 + g];
    }
    for (int c = tid; c < 64 * 48; c += NTHR) {
      const int d = c / 48, rem = c - d * 48, kofs = (rem >> 2) * 32 + (rem & 3) * 8, kpos = wlo + kofs;
      uint4 v = make_uint4(0u, 0u, 0u, 0u);
      if (kpos >= 0 && kpos < T) v = *(const uint4*)(SK + (size_t)(hkv * 64 + d) * M + sb + kpos);
      u16* kd = Ks + kofs * KLD + d;
      kd[0 * KLD] = (u16)(v.x & 0xffffu); kd[1 * KLD] = (u16)(v.x >> 16);
      kd[2 * KLD] = (u16)(v.y & 0xffffu); kd[3 * KLD] = (u16)(v.y >> 16);
      kd[4 * KLD] = (u16)(v.z & 0xffffu); kd[5 * KLD] = (u16)(v.z >> 16);
      kd[6 * KLD] = (u16)(v.w & 0xffffu); kd[7 * KLD] = (u16)(v.w >> 16);
    }
    for (int c = tid; c < 64 * 48; c += NTHR) {
      const int d = c / 48, rem = c - d * 48, kofs = (rem >> 2) * 32 + (rem & 3) * 8, kpos = wlo + kofs;
      uint4 v = make_uint4(0u, 0u, 0u, 0u);
      if (kpos >= 0 && kpos < T) v = *(const uint4*)(SVT + (size_t)(hkv * 64 + d) * M + sb + kpos);
      *(uint4*)(Vs + d * VLD + kofs) = v;
    }
    __syncthreads();
    const int pos0 = posb + wid * 16, tok0 = sb + pos0;
    const int b0 = wid >> 1;
    const int qoff = 128 + (wid & 1) * 16;
    const u16* kl0 = Ks + (b0 * 32 + 8 * (fr >> 2) + (fr & 3)) * KLD + fq * 8;
    const u16* vl0 = Vs + fr * VLD + b0 * 32 + fq * 8;
#pragma unroll 1
    for (int g = 0; g < 2; ++g) {
      const int hq = hkv * 2 + g;
      const float sink = p.in[15][layer * 4 + hq];
      const u16* qp = SQ + (size_t)(tok0 + fr) * 256 + hq * 64 + fq * 8;
      const bf16x8 q0 = *(const bf16x8*)qp, q1 = *(const bf16x8*)(qp + 32);
      f32x4 s[18];
      float mx = sink;
#pragma unroll
      for (int t = 0; t < 18; ++t) {
        const int bs = wlo + (b0 + (t >> 1)) * 32;
        const bool bv = (bs >= 0) && (bs < T);
        const u16* kp = kl0 + ((t >> 1) * 32 + (t & 1) * 4) * KLD;
        V8 k0, k1;
        k0.h[0] = *(const uint2*)kp;        k0.h[1] = *(const uint2*)(kp + 4);
        k1.h[0] = *(const uint2*)(kp + 32); k1.h[1] = *(const uint2*)(kp + 36);
        f32x4 a = {0.f, 0.f, 0.f, 0.f};
        a = mfma16(k0.v, q0, a);
        a = mfma16(k1.v, q1, a);
#pragma unroll
        for (int j = 0; j < 4; ++j) {
          const int rel = (t >> 1) * 32 + 8 * fq + 4 * (t & 1) + j - qoff - fr;
          const bool ok = bv && rel >= -128 && rel <= 128;
          int li = rel + 128;
          li = li < 0 ? 0 : (li > 256 ? 256 : li);
          const float v = ok ? a[j] + lut[g * 257 + li] : -1e30f;
          a[j] = v;
          mx = fmaxf(mx, v);
        }
        s[t] = a;
        asm volatile("" ::: "memory");
      }
      mx = fmaxf(mx, __shfl_xor(mx, 16));
      mx = fmaxf(mx, __shfl_xor(mx, 32));
      float sum = 0.f;
#pragma unroll
      for (int t = 0; t < 18; ++t)
#pragma unroll
        for (int j = 0; j < 4; ++j) { float e = fast_exp(s[t][j] - mx); s[t][j] = e; sum += e; }
      sum += __shfl_xor(sum, 16);
      sum += __shfl_xor(sum, 32);
      const float inv = fast_rcp(sum + fast_exp(sink - mx));
      f32x4 o[4];
#pragma unroll
      for (int dt = 0; dt < 4; ++dt) o[dt] = f32x4{0.f, 0.f, 0.f, 0.f};
#pragma unroll
      for (int ks = 0; ks < 9; ++ks) {
        V8 pb;
        pb.h[0] = pack4(s[2 * ks][0] * inv, s[2 * ks][1] * inv, s[2 * ks][2] * inv, s[2 * ks][3] * inv);
        pb.h[1] = pack4(s[2 * ks + 1][0] * inv, s[2 * ks + 1][1] * inv, s[2 * ks + 1][2] * inv, s[2 * ks + 1][3] * inv);
#pragma unroll
        for (int dt = 0; dt < 4; ++dt) {
          V8 va;
          va.u = *(const uint4*)(vl0 + dt * 16 * VLD + ks * 32);
          o[dt] = mfma16(va.v, pb.v, o[dt]);
        }
        asm volatile("" ::: "memory");
      }
#pragma unroll
      for (int dt = 0; dt < 4; ++dt)
        *(uint2*)(BR + (size_t)(tok0 + fr) * 1024 + 768 + hq * 64 + dt * 16 + fq * 4) =
            pack4(o[dt][0], o[dt][1], o[dt][2], o[dt][3]);
    }
    __syncthreads();
  }
}

struct TileOrder {
  int pm, pn; bool gate; size_t a0, b0;
  DEVI bool next(int ui, g8::Unit& u) const {
    if (ui >= 4) return false;
    u.pm = pm; u.pn = pn; u.aux = ui;
    if (gate) {
      u.nt = 16;
      u.aoff = a0 + (size_t)pm * 256 * 1024 * 2;
      u.boff = b0 + ((size_t)ui * 1024 + pn * 256) * 1024 * 2;
    } else {
      u.nt = 4;
      u.aoff = a0 + ((size_t)pm * 256 * 1024 + ui * 256) * 2;
      u.boff = b0 + ((size_t)pn * 256 * 1024 + ui * 256) * 2;
    }
    return true;
  }
};
struct EpiGateTile {
  u16* scr;
  DEVI bool operator()(f32x4 (&acc)[2][2][4][2], const g8::Unit& u, int wr, int wc, int fr, int fq) const {
    u16* o0 = scr + u.aux * 65536 + (wr * 64 + fr) * 256 + wc * 32 + fq * 8;
#pragma unroll
    for (int ai = 0; ai < 2; ++ai)
#pragma unroll
      for (int m = 0; m < 4; ++m) {
        u16* orow = o0 + (ai * 128 + m * 16) * 256;
#pragma unroll
        for (int bj = 0; bj < 2; ++bj) {
          const f32x4 v0 = acc[ai][bj][m][0], v1 = acc[ai][bj][m][1];
          uint4 w;
          w.x = pack2(sigmoidf_(v0[0]), sigmoidf_(v0[1])); w.y = pack2(sigmoidf_(v0[2]), sigmoidf_(v0[3]));
          w.z = pack2(sigmoidf_(v1[0]), sigmoidf_(v1[1])); w.w = pack2(sigmoidf_(v1[2]), sigmoidf_(v1[3]));
          *(uint4*)(orow + bj * 128) = w;
        }
        asm volatile("" ::: "memory");
      }
    return true;
  }
};
struct EpiMergeTile {
  const u16* scr; u16* MG;
  DEVI bool operator()(f32x4 (&acc)[2][2][4][2], const g8::Unit& u, int wr, int wc, int fr, int fq) const {
    const int i = u.aux;
    const bool last = (i == 3);
    const int gbo = last ? 0 : 65536;
    const u16* g0 = scr + i * 65536 + (wr * 64 + fr) * 256 + wc * 32 + fq * 8;
    u16* o0 = MG + (size_t)(u.pm * 256 + wr * 64 + fr) * 1024 + u.pn * 256 + wc * 32 + fq * 8;
#pragma unroll
    for (int ai = 0; ai < 2; ++ai) {
      uint4 ga[4][2], gb[4][2];
#pragma unroll
      for (int m = 0; m < 4; ++m) {
        const u16* gr = g0 + (ai * 128 + m * 16) * 256;
#pragma unroll
        for (int bj = 0; bj < 2; ++bj) {
          ga[m][bj] = *(const uint4*)(gr + bj * 128);
          gb[m][bj] = *(const uint4*)(gr + gbo + bj * 128);
        }
      }
      asm volatile("" ::: "memory");
#pragma unroll
      for (int m = 0; m < 4; ++m) {
        u16* orow = o0 + (size_t)(ai * 128 + m * 16) * 1024;
#pragma unroll
        for (int bj = 0; bj < 2; ++bj) {
          const uint4 a4 = ga[m][bj], b4 = gb[m][bj];
          f32x4 v0 = acc[ai][bj][m][0], v1 = acc[ai][bj][m][1];
          v0[0] *= lo16(a4.x) * (last ? 1.f : fast_rcp(lo16(b4.x)));
          v0[1] *= hi16(a4.x) * (last ? 1.f : fast_rcp(hi16(b4.x)));
          v0[2] *= lo16(a4.y) * (last ? 1.f : fast_rcp(lo16(b4.y)));
          v0[3] *= hi16(a4.y) * (last ? 1.f : fast_rcp(hi16(b4.y)));
          v1[0] *= lo16(a4.z) * (last ? 1.f : fast_rcp(lo16(b4.z)));
          v1[1] *= hi16(a4.z) * (last ? 1.f : fast_rcp(hi16(b4.z)));
          v1[2] *= lo16(a4.w) * (last ? 1.f : fast_rcp(lo16(b4.w)));
          v1[3] *= hi16(a4.w) * (last ? 1.f : fast_rcp(hi16(b4.w)));
          acc[ai][bj][m][0] = v0;
          acc[ai][bj][m][1] = v1;
          if (last) {
            uint4 w;
            w.x = pack2(v0[0], v0[1]); w.y = pack2(v0[2], v0[3]); w.z = pack2(v1[0], v1[1]); w.w = pack2(v1[2], v1[3]);
            *(uint4*)(orow + bj * 128) = w;
          }
        }
      }
      asm volatile("" ::: "memory");
    }
    return last;
  }
};
DEVI void phase_gm(const Params& p, int layer, unsigned char* smem) {
  g8::Order tiles;
  tiles.init(M / 256, 4, gridDim.x, obid(), 1024);
  u16* scr = (u16*)(p.ws + OFF_GSCR) + (size_t)obid() * 4 * 65536;
#pragma unroll 1
  for (int r = 0;; ++r) {
    g8::Unit tu;
    if (!tiles.next(r, tu)) break;
    {
      TileOrder S{tu.pm, tu.pn, true, 0, OFF_WMERGE + (size_t)layer * SZ_WMERGE * 2};
      EpiGateTile e{scr};
      g8::gemm_phase<true>((LAS unsigned char*)smem, hbuf(p), (const u16*)p.ws, 1024, S, e);
    }
    {
      TileOrder S{tu.pm, tu.pn, false, (size_t)M * 1024 * 2, OFF_WBRANCH + (size_t)layer * SZ_WBRANCH * 2};
      EpiMergeTile e{scr, (u16*)(p.ws + OFF_MERGED)};
      g8::gemm_phase<true>((LAS unsigned char*)smem, hbuf(p), (const u16*)p.ws, 1024, S, e);
    }
  }
}

template <bool FIRST>
struct EpiResid {
  u16* xb; const float* mod; int layer, gsel;
  const float* xp; const float* xs;
  DEVI bool operator()(f32x4 (&acc)[2][2][4][2], const g8::Unit& u, int wr, int wc, int fr, int fq) const {
    const int t0 = u.pm * 256;
    int seq, pos0, T;
    tokinfo(t0, seq, pos0, T);
    const float* gp = mod + (size_t)(layer * 18 + seq) * 6144 + gsel * 1024 + u.pn * 256 + wc * 32 + fq * 8;
    float4 g[2][2];
#pragma unroll
    for (int bj = 0; bj < 2; ++bj)
#pragma unroll
      for (int n = 0; n < 2; ++n) g[bj][n] = *(const float4*)(gp + bj * 128 + n * 4);
    const size_t lo = (size_t)(wr * 64 + fr) * 1024 + u.pn * 256 + wc * 32 + fq * 8;
    u16* o0 = xb + (size_t)t0 * 1024 + lo;
    if (FIRST) {
      const float* i0 = (t0 < MP ? xp + (size_t)t0 * 1024 : xs + (size_t)(t0 - MP) * 1024) + lo;
#pragma unroll
      for (int ai = 0; ai < 2; ++ai)
#pragma unroll
        for (int mh = 0; mh < 2; ++mh) {
          float4 x[2][2][2];
#pragma unroll
          for (int m2 = 0; m2 < 2; ++m2)
#pragma unroll
            for (int bj = 0; bj < 2; ++bj) {
              const float* ip = i0 + (size_t)(ai * 128 + (mh * 2 + m2) * 16) * 1024 + bj * 128;
              x[m2][bj][0] = *(const float4*)ip;
              x[m2][bj][1] = *(const float4*)(ip + 4);
            }
          asm volatile("" ::: "memory");
#pragma unroll
          for (int m2 = 0; m2 < 2; ++m2) {
            const int m = mh * 2 + m2;
            u16* rowp = o0 + (size_t)(ai * 128 + m * 16) * 1024;
#pragma unroll
            for (int bj = 0; bj < 2; ++bj) {
              const float4 xa = x[m2][bj][0], xc = x[m2][bj][1];
              const f32x4 v0 = acc[ai][bj][m][0], v1 = acc[ai][bj][m][1];
              uint4 w;
              w.x = pack2(xa.x + g[bj][0].x * v0[0], xa.y + g[bj][0].y * v0[1]);
              w.y = pack2(xa.z + g[bj][0].z * v0[2], xa.w + g[bj][0].w * v0[3]);
              w.z = pack2(xc.x + g[bj][1].x * v1[0], xc.y + g[bj][1].y * v1[1]);
              w.w = pack2(xc.z + g[bj][1].z * v1[2], xc.w + g[bj][1].w * v1[3]);
              *(uint4*)(rowp + bj * 128) = w;
            }
          }
          asm volatile("" ::: "memory");
        }
    } else {
#pragma unroll
      for (int ai = 0; ai < 2; ++ai) {
        uint4 xw[4][2];
#pragma unroll
        for (int m = 0; m < 4; ++m)
#pragma unroll
          for (int bj = 0; bj < 2; ++bj) xw[m][bj] = *(const uint4*)(o0 + (size_t)(ai * 128 + m * 16) * 1024 + bj * 128);
        asm volatile("" ::: "memory");
#pragma unroll
        for (int m = 0; m < 4; ++m) {
          u16* rowp = o0 + (size_t)(ai * 128 + m * 16) * 1024;
#pragma unroll
          for (int bj = 0; bj < 2; ++bj) {
            const uint4 xv = xw[m][bj];
            const f32x4 v0 = acc[ai][bj][m][0], v1 = acc[ai][bj][m][1];
            uint4 w;
            w.x = pack2(lo16(xv.x) + g[bj][0].x * v0[0], hi16(xv.x) + g[bj][0].y * v0[1]);
            w.y = pack2(lo16(xv.y) + g[bj][0].z * v0[2], hi16(xv.y) + g[bj][0].w * v0[3]);
            w.z = pack2(lo16(xv.z) + g[bj][1].x * v1[0], hi16(xv.z) + g[bj][1].y * v1[1]);
            w.w = pack2(lo16(xv.w) + g[bj][1].z * v1[2], hi16(xv.w) + g[bj][1].w * v1[3]);
            *(uint4*)(rowp + bj * 128) = w;
          }
        }
        asm volatile("" ::: "memory");
      }
    }
    return true;
  }
};
DEVI void phase_resid(const Params& p, int layer, const u16* A, int K, const u16* Wt, int gsel, unsigned char* smem) {
  g8::Order S;
  S.init(M / 256, 4, gridDim.x, obid(), K);
  if (layer == 0 && gsel == 2) {
    EpiResid<true> e{xbuf(p), (const float*)(p.ws + OFF_MOD), layer, gsel, p.in[0], p.in[1]};
    g8::gemm_phase<true>((LAS unsigned char*)smem, A, Wt, K, S, e);
  } else {
    EpiResid<false> e{xbuf(p), (const float*)(p.ws + OFF_MOD), layer, gsel, nullptr, nullptr};
    g8::gemm_phase<true>((LAS unsigned char*)smem, A, Wt, K, S, e);
  }
}

struct EpiFF1 {
  u16* HID;
  DEVI bool operator()(f32x4 (&acc)[2][2][4][2], const g8::Unit& u, int wr, int wc, int fr, int fq) const {
    u16* o0 = HID + (size_t)(u.pm * 256 + wr * 64 + fr) * 4096 + u.pn * 256 + wc * 32 + fq * 8;
#pragma unroll
    for (int ai = 0; ai < 2; ++ai)
#pragma unroll
      for (int m = 0; m < 4; ++m) {
        u16* orow = o0 + (size_t)(ai * 128 + m * 16) * 4096;
#pragma unroll
        for (int bj = 0; bj < 2; ++bj) {
          const f32x4 v0 = acc[ai][bj][m][0], v1 = acc[ai][bj][m][1];
          const float a0 = fmaxf(v0[0], 0.f), a1 = fmaxf(v0[1], 0.f), a2 = fmaxf(v0[2], 0.f), a3 = fmaxf(v0[3], 0.f);
          const float b0 = fmaxf(v1[0], 0.f), b1 = fmaxf(v1[1], 0.f), b2 = fmaxf(v1[2], 0.f), b3 = fmaxf(v1[3], 0.f);
          uint4 w;
          w.x = pack2(a0 * a0, a1 * a1); w.y = pack2(a2 * a2, a3 * a3);
          w.z = pack2(b0 * b0, b1 * b1); w.w = pack2(b2 * b2, b3 * b3);
          *(uint4*)(orow + bj * 128) = w;
        }
        asm volatile("" ::: "memory");
      }
    return true;
  }
};
DEVI void phase_ff1(const Params& p, int layer, unsigned char* smem) {
  g8::Order S;
  S.init(M / 256, 16, gridDim.x, obid(), 1024);
  EpiFF1 e{(u16*)(p.ws + OFF_HID)};
  g8::gemm_phase<true>((LAS unsigned char*)smem, hbuf(p), (const u16*)(p.ws + OFF_WFF1) + (size_t)layer * SZ_WFF, 1024, S, e);
}

struct CtrBarrier { unsigned* ctr; unsigned target; };
DEVI void ctr_barrier(CtrBarrier& b) {
  asm volatile("s_waitcnt vmcnt(0)" ::: "memory");
  __syncthreads();
  b.target += gridDim.x;
  if (threadIdx.x == 0) {
    __builtin_amdgcn_fence(__ATOMIC_RELEASE, "agent");
    asm volatile("s_waitcnt vmcnt(0)" ::: "memory");
    __hip_atomic_fetch_add(b.ctr, 1u, __ATOMIC_RELAXED, __HIP_MEMORY_SCOPE_AGENT);
    unsigned spins = 0;
    while (__hip_atomic_load(b.ctr, __ATOMIC_RELAXED, __HIP_MEMORY_SCOPE_AGENT) < b.target) {
      __builtin_amdgcn_s_sleep(1);
      if (++spins > (1u << 22)) break;
    }
    __builtin_amdgcn_fence(__ATOMIC_ACQUIRE, "agent");
    asm volatile("s_waitcnt vmcnt(0)" ::: "memory");
  }
  __syncthreads();
}

DEVI void stage_signal(unsigned* cnt) {
  asm volatile("s_waitcnt vmcnt(0)" ::: "memory");
  __syncthreads();
  if (threadIdx.x == 0) {
    __builtin_amdgcn_fence(__ATOMIC_RELEASE, "agent");
    asm volatile("s_waitcnt vmcnt(0)" ::: "memory");
    __hip_atomic_fetch_add(cnt, 1u, __ATOMIC_RELAXED, __HIP_MEMORY_SCOPE_AGENT);
  }
}
DEVI void stage_wait(unsigned* cnt) {
  __syncthreads();
  if (threadIdx.x == 0) {
    unsigned spins = 0;
    while (__hip_atomic_load(cnt, __ATOMIC_RELAXED, __HIP_MEMORY_SCOPE_AGENT) < gridDim.x) {
      __builtin_amdgcn_s_sleep(1);
      if (++spins > (1u << 22)) break;
    }
    __builtin_amdgcn_fence(__ATOMIC_ACQUIRE, "agent");
    asm volatile("s_waitcnt vmcnt(0)" ::: "memory");
  }
  __syncthreads();
}

#define REP_GATES 1
#define REP_NA 1
#define REP_SWA 1
#define REP_C1 1
#define REP_C2 1
#define REP_C3 1
#define REP_FF1 1
#define REP_G1 1
#define REP_MERGE 1
#ifndef REP_MIX
#define REP_MIX 1
#endif
__global__ void __launch_bounds__(512, 2) trunk_megakernel(Params p) {
  cg::grid_group grid = cg::this_grid();
  __shared__ __attribute__((aligned(16))) unsigned char smem[SMEM_BYTES];
  CtrBarrier cb{(unsigned*)(p.ws + OFF_BAR), 0u};
  if (blockIdx.x == 0 && threadIdx.x < 8) cb.ctr[threadIdx.x * 16] = 0u;

  phase0(p, smem);
  grid.sync();
#pragma unroll 1
  for (int l = 0; l < 2; ++l) {
    phase_norm(p, l, 0);
    ctr_barrier(cb);
#pragma unroll 1
    for (int rep = 0; rep < REP_G1; ++rep) {
    phase_gemm1(p, l, smem);
    ctr_barrier(cb);
    }
    {
      unsigned* cntA = cb.ctr + 16 * (1 + 2 * l), * cntB = cb.ctr + 16 * (2 + 2 * l);
      phase_ret_u(p, l);
      stage_signal(cntA);
      phase_conv(p, l, smem);
      phase_na(p, l, smem);
      stage_wait(cntA);
      phase_ret_scan(p, l);
      stage_signal(cntB);
      phase_swa(p, l, smem);
      stage_wait(cntB);
      phase_ret_out(p, l, smem);
      ctr_barrier(cb);
    }
    phase_gm(p, l, smem);
    ctr_barrier(cb);
    phase_resid(p, l, (const u16*)(p.ws + OFF_MERGED), 1024, (const u16*)(p.ws + OFF_WOUT) + (size_t)l * SZ_WOUT, 2, smem);
    ctr_barrier(cb);
    phase_norm(p, l, 1);
    ctr_barrier(cb);
#pragma unroll 1
    for (int rep = 0; rep < REP_FF1; ++rep) {
    phase_ff1(p, l, smem);
    ctr_barrier(cb);
    }
    phase_resid(p, l, (const u16*)(p.ws + OFF_HID), 4096, (const u16*)(p.ws + OFF_WFF2) + (size_t)l * SZ_WFF, 5, smem);
    ctr_barrier(cb);
  }
  phase_final(p);
}

extern "C" void kernel_launch(void* const* d_in, const int* in_sizes, int n_in, void* d_out, int out_size, void* d_ws,
                              size_t ws_size, hipStream_t stream) {
  static int grid_blocks = 0;
  if (!grid_blocks) {
    int dev = 0, cus = 0, per_cu = 0;
    (void)hipGetDevice(&dev);
    (void)hipDeviceGetAttribute(&cus, hipDeviceAttributeMultiprocessorCount, dev);
    (void)hipOccupancyMaxActiveBlocksPerMultiprocessor(&per_cu, trunk_megakernel, NTHR, 0);
    if (per_cu > 1) per_cu = 1;
    grid_blocks = (cus * per_cu / 8) * 8;
  }
  Params p{};
  for (int i = 0; i < 23; ++i) p.in[i] = (const float*)d_in[i];
  p.out = (float*)d_out;
  p.ws = (unsigned char*)d_ws;
  if (ws_size < WS_NEED) fprintf(stderr, "workspace too small: %zu < %zu\n", ws_size, (size_t)WS_NEED);
  void* args[] = {&p};
  hipError_t e = hipLaunchCooperativeKernel((void*)trunk_megakernel, dim3(grid_blocks), dim3(NTHR), args, 0, stream);
  if (e != hipSuccess) fprintf(stderr, "cooperative launch failed: %s (grid %d)\n", hipGetErrorString(e), grid_blocks);
}
```

```cpp
#include <hip/hip_runtime.h>
#include <hip/hip_cooperative_groups.h>
#include <cstdio>
namespace cg = cooperative_groups;

typedef unsigned short u16;
typedef short bf16x8 __attribute__((ext_vector_type(8)));
typedef float f32x4 __attribute__((ext_vector_type(4)));
#define DEVI __device__ __forceinline__

constexpr int M = 81920;
constexpr int MP = 65536;
constexpr int SMEM_BYTES = 131072;
constexpr int NTHR = 512;
constexpr int MH = M;

struct Params {
  const float* in[23];
  float* out;
  unsigned char* ws;
};

constexpr size_t SZ_WIN = 3072ull * 1024, SZ_WMERGE = 4ull * 1024 * 1024, SZ_WBRANCH = 4ull * 1024 * 256,
                 SZ_WOUT = 1024ull * 1024, SZ_WFF = 4096ull * 1024;
constexpr size_t OFF_WIN = 0;
constexpr size_t OFF_WMERGE = OFF_WIN + 2 * SZ_WIN * 2;
constexpr size_t OFF_WBRANCH = OFF_WMERGE + 2 * SZ_WMERGE * 2;
constexpr size_t OFF_WOUT = OFF_WBRANCH + 2 * SZ_WBRANCH * 2;
constexpr size_t OFF_WFF1 = OFF_WOUT + 2 * SZ_WOUT * 2;
constexpr size_t OFF_WFF2 = OFF_WFF1 + 2 * SZ_WFF * 2;
constexpr size_t OFF_MOD = OFF_WFF2 + 2 * SZ_WFF * 2;
constexpr size_t OFF_ROPE = OFF_MOD + 2ull * 18 * 6144 * 4;
constexpr size_t OFF_H = OFF_ROPE + 8192ull * 64 * 4;
constexpr size_t OFF_X = OFF_H + (size_t)M * 1024 * 2;
constexpr size_t C256 = (size_t)M * 256 * 2, C128 = (size_t)M * 128 * 2;
constexpr size_t OFF_RQ = OFF_X;
constexpr size_t OFF_RK = OFF_RQ + C256;
constexpr size_t OFF_RKT = OFF_RK + C256;
constexpr size_t OFF_RVT = OFF_RKT + C256;
constexpr size_t OFF_RG = OFF_RVT + C256;
constexpr size_t OFF_CA = OFF_RG + C256;
constexpr size_t OFF_CB = OFF_CA + C256;
constexpr size_t OFF_NQ = OFF_CB + C256;
constexpr size_t OFF_NK = OFF_NQ + C256;
constexpr size_t OFF_NVT = OFF_NK + C256;
constexpr size_t OFF_SQ = OFF_NVT + C256;
constexpr size_t OFF_SK = OFF_SQ + C256;
constexpr size_t OFF_SVT = OFF_SK + C128;
constexpr size_t OFF_U = OFF_SVT + C128;
constexpr size_t OFF_R = OFF_U + 2560ull * 2 * 4096 * 4;
constexpr size_t OFF_BR = OFF_R + 2560ull * 2 * 4096 * 2;
constexpr size_t OFF_END = OFF_BR + (size_t)M * 1024 * 2;
constexpr size_t OFF_BAR = OFF_END;
constexpr size_t WS_NEED = OFF_END + 65536 + 16ull * 524288;
static_assert(WS_NEED <= (1ull << 30), "fits the guaranteed 1 GiB workspace");
static_assert(C256 == 80ull * 524288 && 2560ull * 2 * 4096 * 4 == 160ull * 524288, "gate scratch slots");
constexpr size_t OFF_MERGED = OFF_BR;
constexpr size_t OFF_GSCR = OFF_X;
constexpr size_t OFF_GATES = OFF_X;
static_assert(OFF_GATES + (size_t)MH * 4096 * 2 <= OFF_END, "gates fit");
constexpr size_t OFF_HID = OFF_X;
static_assert(OFF_HID + (size_t)M * 4096 * 2 <= OFF_END, "hid fits");

DEVI u16 f2bf(float f) {
  unsigned u = __float_as_uint(f);
  u += 0x7fffu + ((u >> 16) & 1u);
  return (u16)(u >> 16);
}
DEVI float bf2f(u16 h) { return __uint_as_float(((unsigned)h) << 16); }
typedef __bf16 bf16x2_t __attribute__((ext_vector_type(2)));
typedef float f32x2_t __attribute__((ext_vector_type(2)));
DEVI unsigned pack2(float a, float b) {
  f32x2_t v = {a, b};
  bf16x2_t r = __builtin_convertvector(v, bf16x2_t);
  return __builtin_bit_cast(unsigned, r);
}
DEVI uint2 pack4(float a, float b, float c, float d) { return make_uint2(pack2(a, b), pack2(c, d)); }
DEVI float lo16(unsigned u) { return __uint_as_float(u << 16); }
DEVI float hi16(unsigned u) { return __uint_as_float(u & 0xffff0000u); }
union V8 { bf16x8 v; uint4 u; uint2 h[2]; };
DEVI f32x4 mfma16(bf16x8 a, bf16x8 b, f32x4 c) { return __builtin_amdgcn_mfma_f32_16x16x32_bf16(a, b, c, 0, 0, 0); }
DEVI float wave_sum(float v) {
#pragma unroll
  for (int o = 32; o; o >>= 1) v += __shfl_xor(v, o);
  return v;
}
DEVI float fast_rcp(float x) { return __builtin_amdgcn_rcpf(x); }
DEVI float fast_exp(float x) { return __builtin_amdgcn_exp2f(x * 1.4426950408889634f); }
DEVI float sigmoidf_(float x) { return fast_rcp(1.f + fast_exp(-x)); }
DEVI void tokinfo(int tok, int& seq, int& pos, int& T) {
  if (tok < MP) { seq = tok >> 12; pos = tok & 4095; T = 4096; }
  else { int u = tok - MP; seq = 16 + (u >> 13); pos = u & 8191; T = 8192; }
}
DEVI float log_sigmoid(float x) { return -log1pf(expf(-x)); }

DEVI int otid() { int t = threadIdx.x; asm volatile("" : "+v"(t)); return t; }
DEVI int obid() { int t = blockIdx.x; asm volatile("" : "+s"(t)); return t; }
DEVI u16* hbuf(const Params& p) { return (u16*)p.out; }
DEVI u16* brbuf(const Params& p) { return (u16*)p.out + (size_t)M * 1024; }
DEVI u16* xbuf(const Params& p) { return (u16*)(p.ws + OFF_H); }
template <int MI, int NI>
DEVI void gemm_mainloop(const u16* __restrict__ X, int ldx, const u16* __restrict__ Y, int ldy, int K,
                        f32x4 (&acc)[MI][NI], u16* smem) {
  constexpr int XR = MI * 32, YR = NI * 64, LD = 72;
  constexpr int XP = XR / 64, YP = YR / 64;
  u16* sX = smem;
  u16* sY = smem + 2 * XR * LD;
  const int tid = otid(), lane = tid & 63, wid = tid >> 6, wr = wid >> 2, wc = wid & 3, fr = lane & 15,
            fq = lane >> 4;
  const int lrow = tid >> 3, lch = tid & 7;
  uint4 rx[XP], ry[YP];
  const u16* xp = X + (size_t)lrow * ldx + lch * 8;
  const u16* yp = Y + (size_t)lrow * ldy + lch * 8;
#pragma unroll
  for (int i = 0; i < XP; ++i) rx[i] = *(const uint4*)(xp + (size_t)i * 64 * ldx);
#pragma unroll
  for (int i = 0; i < YP; ++i) ry[i] = *(const uint4*)(yp + (size_t)i * 64 * ldy);
#pragma unroll
  for (int i = 0; i < XP; ++i) *(uint4*)(sX + (lrow + i * 64) * LD + lch * 8) = rx[i];
#pragma unroll
  for (int i = 0; i < YP; ++i) *(uint4*)(sY + (lrow + i * 64) * LD + lch * 8) = ry[i];
  __syncthreads();
  const int nk = K >> 6;
  for (int kt = 0; kt < nk; ++kt) {
    const int cur = kt & 1;
    const bool more = (kt + 1 < nk);
    if (more) {
#pragma unroll
      for (int i = 0; i < XP; ++i) rx[i] = *(const uint4*)(xp + (size_t)i * 64 * ldx + (kt + 1) * 64);
#pragma unroll
      for (int i = 0; i < YP; ++i) ry[i] = *(const uint4*)(yp + (size_t)i * 64 * ldy + (kt + 1) * 64);
    }
    const u16* cx = sX + cur * XR * LD + (wr * MI * 16 + fr) * LD + fq * 8;
    const u16* cy = sY + cur * YR * LD + (wc * NI * 16 + fr) * LD + fq * 8;
#pragma unroll
    for (int ks = 0; ks < 2; ++ks) {
      bf16x8 a[MI], b[NI];
#pragma unroll
      for (int mi = 0; mi < MI; ++mi) a[mi] = *(const bf16x8*)(cx + mi * 16 * LD + ks * 32);
#pragma unroll
      for (int ni = 0; ni < NI; ++ni) b[ni] = *(const bf16x8*)(cy + ni * 16 * LD + ks * 32);
#pragma unroll
      for (int mi = 0; mi < MI; ++mi)
#pragma unroll
        for (int ni = 0; ni < NI; ++ni) acc[mi][ni] = mfma16(a[mi], b[ni], acc[mi][ni]);
    }
    if (more) {
      u16* dx = sX + (cur ^ 1) * XR * LD;
      u16* dy = sY + (cur ^ 1) * YR * LD;
#pragma unroll
      for (int i = 0; i < XP; ++i) *(uint4*)(dx + (lrow + i * 64) * LD + lch * 8) = rx[i];
#pragma unroll
      for (int i = 0; i < YP; ++i) *(uint4*)(dy + (lrow + i * 64) * LD + lch * 8) = ry[i];
    }
    __syncthreads();
  }
}

#define LAS __attribute__((address_space(3)))
namespace g8 {
constexpr int BM = 256, BK = 64, HALF = 128, HTB = HALF * BK * 2, NXCD = 8, WGM = 8;
DEVI int lds_byte(int r, int c) {
  const int st = (r >> 4) * 2 + (c >> 5), rr = r & 15, cc = c & 31, ob = rr * 64 + cc * 2;
  return st * 1024 + (ob ^ (((ob >> 9) & 1) << 5));
}
DEVI void stage_rc(int b, int& R, int& C) {
  const int st = b / 1024, sb = b % 1024, swz = sb ^ (((sb >> 9) & 1) << 5);
  R = (st >> 1) * 16 + swz / 64;
  C = (st & 1) * 32 + (swz % 64) / 2;
}
struct Unit { int pm, pn, aux, nt; size_t aoff, boff; };
struct Order {
  int nM, nN, nwg, G, c, K;
  DEVI void init(int nM_, int nN_, int G_, int c_, int K_ = 1024) { nM = nM_; nN = nN_; nwg = nM * nN; G = G_; c = c_; K = K_; }
  DEVI bool next(int i, Unit& u) const {
    const long L = (long)i * G + c;
    if (L >= nwg) return false;
    int wgid = (int)L;
    {
      const int q = nwg / NXCD, r = nwg % NXCD, xcd = wgid % NXCD, off = wgid / NXCD;
      wgid = (xcd < r ? xcd * (q + 1) : r * (q + 1) + (xcd - r) * q) + off;
    }
    const int nig = WGM * nN, gid = wgid / nig, fm = gid * WGM, gsz = (nM - fm) < WGM ? (nM - fm) : WGM;
    u.pm = fm + ((wgid % nig) % gsz);
    u.pn = (wgid % nig) / gsz;
    u.aux = 0;
    u.nt = K >> 6;
    u.aoff = (size_t)u.pm * 512 * K;
    u.boff = (size_t)u.pn * 512 * K;
    return true;
  }
};

DEVI int perm32(int rho) { const int n = rho >> 4, i = rho & 15; return 8 * (i >> 2) + 4 * n + (i & 3); }
template <bool PERM, class Epi, class Sched>
DEVI void gemm_phase(LAS unsigned char* lds, const u16* gA, const u16* gBt, const int K, const Sched& S, const Epi& E) {
  const int tid = otid(), wid = __builtin_amdgcn_readfirstlane(tid >> 6), lane = tid & 63, wr = wid >> 2, wc = wid & 3,
            fr = lane & 15, fq = lane >> 4;
  unsigned voffA[2], voffB[2];
#pragma unroll
  for (int i = 0; i < 2; ++i) {
    int R, C;
    stage_rc(tid * 16 + i * 8192, R, C);
    voffA[i] = (unsigned)(R * K + C) * 2u;
    const int Rb = PERM ? ((R & ~31) + perm32(R & 31)) : R;
    voffB[i] = (unsigned)(Rb * K + C) * 2u;
  }
  const size_t kstep = (size_t)(BK * 2);
  const size_t hstep = (size_t)HALF * K * 2;
  const unsigned ldsw = (unsigned)wid * 1024u;
  const int aoff = lds_byte(wr * 64 + fr, fq * 8), boff = lds_byte(wc * 32 + fr, fq * 8);
#define G8_SA(b, h) (((b) * 2 + (h)) * HTB)
#define G8_SB(b, h) ((4 + (b) * 2 + (h)) * HTB)
#define G8_STAGEV(bufoff, gbase, voff) do { _Pragma("unroll") for (int _i = 0; _i < 2; ++_i) \
    __builtin_amdgcn_global_load_lds((const unsigned*)((const char*)(gbase) + (voff)[_i]), (LAS unsigned*)(lds + (bufoff) + ldsw + _i * 8192), 16, 0, 0); } while (0)
#define G8_LDA(dst, b, h) do { _Pragma("unroll") for (int m = 0; m < 4; ++m) _Pragma("unroll") for (int k = 0; k < 2; ++k) dst[m][k] = *(const LAS bf16x8*)(lds + G8_SA(b, h) + aoff + m * 2048 + k * 1024); } while (0)
#define G8_LDB(dst, b, h) do { _Pragma("unroll") for (int n = 0; n < 2; ++n) _Pragma("unroll") for (int k = 0; k < 2; ++k) dst[n][k] = *(const LAS bf16x8*)(lds + G8_SB(b, h) + boff + n * 2048 + k * 1024); } while (0)
#define G8_MMA(ai, bj, At, Bt) do { __builtin_amdgcn_s_setprio(1); _Pragma("unroll") for (int m = 0; m < 4; ++m) _Pragma("unroll") for (int n = 0; n < 2; ++n) _Pragma("unroll") for (int k = 0; k < 2; ++k) \
    acc[ai][bj][m][n] = __builtin_amdgcn_mfma_f32_16x16x32_bf16(Bt[n][k], At[m][k], acc[ai][bj][m][n], 0, 0, 0); __builtin_amdgcn_s_setprio(0); } while (0)
#define G8_WAIT_V(n) asm volatile("s_waitcnt vmcnt(" #n ")" ::: "memory")
#define G8_WAIT_L(n) asm volatile("s_waitcnt lgkmcnt(" #n ")" ::: "memory")
#define G8_BAR __builtin_amdgcn_s_barrier()
#define G8_SCHED __builtin_amdgcn_sched_barrier(0)
  Unit cur, nxt;
  int ui = 0;
  if (!S.next(0, cur)) return;
  f32x4 acc[2][2][4][2];
#pragma unroll
  for (int a = 0; a < 2; ++a)
#pragma unroll
    for (int b = 0; b < 2; ++b)
#pragma unroll
      for (int m = 0; m < 4; ++m)
#pragma unroll
        for (int n = 0; n < 2; ++n) acc[a][b][m][n] = f32x4{0.f, 0.f, 0.f, 0.f};
  bf16x8 At[4][2], B0[2][2], B1[2][2];
  const char* cA = (const char*)gA + cur.aoff;
  const char* cB = (const char*)gBt + cur.boff;
  G8_STAGEV(G8_SB(0, 0), cB, voffB); G8_STAGEV(G8_SA(0, 0), cA, voffA); G8_STAGEV(G8_SB(0, 1), cB + hstep, voffB); G8_STAGEV(G8_SA(0, 1), cA + hstep, voffA);
  if (wr == 1) G8_BAR;
  G8_WAIT_V(4); G8_BAR;
  G8_STAGEV(G8_SB(1, 0), cB + kstep, voffB); G8_STAGEV(G8_SA(1, 0), cA + kstep, voffA); G8_STAGEV(G8_SB(1, 1), cB + hstep + kstep, voffB);
  G8_WAIT_V(6); G8_BAR;
  for (;;) {
    const bool has_next = S.next(ui + 1, nxt);
    const char* nA = has_next ? (const char*)gA + nxt.aoff : cA;
    const char* nB = has_next ? (const char*)gBt + nxt.boff : cB;
    const int nt = cur.nt;
    for (int t = 0; t < nt; t += 2) {
      const bool last = (t == nt - 2);
      const char* a1 = cA + (size_t)(t + 1) * kstep;
      const char* a2 = last ? nA : cA + (size_t)(t + 2) * kstep;
      const char* b2 = last ? nB : cB + (size_t)(t + 2) * kstep;
      const char* a3 = a2 + kstep;
      const char* b3 = b2 + kstep;
      G8_LDB(B0, 0, 0); G8_SCHED; G8_LDA(At, 0, 0); G8_STAGEV(G8_SA(1, 1), a1 + hstep, voffA);
      G8_WAIT_L(8); G8_BAR; G8_WAIT_L(0); G8_MMA(0, 0, At, B0); G8_BAR; G8_SCHED;
      G8_LDB(B1, 0, 1); G8_STAGEV(G8_SB(0, 0), b2, voffB);
      G8_BAR; G8_WAIT_L(0); G8_MMA(0, 1, At, B1); G8_BAR;
      G8_LDA(At, 0, 1); G8_STAGEV(G8_SA(0, 0), a2, voffA);
      G8_BAR; G8_WAIT_L(0); G8_MMA(1, 0, At, B0); G8_BAR; G8_SCHED;
      G8_STAGEV(G8_SB(0, 1), b2 + hstep, voffB);
      G8_WAIT_V(6); G8_BAR; G8_MMA(1, 1, At, B1); G8_BAR;
      G8_LDB(B0, 1, 0); G8_SCHED; G8_LDA(At, 1, 0); G8_STAGEV(G8_SA(0, 1), a2 + hstep, voffA);
      G8_WAIT_L(8); G8_BAR; G8_WAIT_L(0); G8_MMA(0, 0, At, B0); G8_BAR; G8_SCHED;
      G8_LDB(B1, 1, 1); G8_STAGEV(G8_SB(1, 0), b3, voffB);
      G8_BAR; G8_WAIT_L(0); G8_MMA(0, 1, At, B1); G8_BAR;
      G8_LDA(At, 1, 1); G8_STAGEV(G8_SA(1, 0), a3, voffA);
      G8_BAR; G8_WAIT_L(0); G8_MMA(1, 0, At, B0); G8_BAR; G8_SCHED;
      G8_STAGEV(G8_SB(1, 1), b3 + hstep, voffB);
      G8_WAIT_V(6); G8_BAR; G8_MMA(1, 1, At, B1); G8_BAR;
    }
    const bool zr = E(acc, cur, wr, wc, fr, fq);
    if (!has_next) break;
    if (zr)
#pragma unroll
    for (int a = 0; a < 2; ++a)
#pragma unroll
      for (int b = 0; b < 2; ++b)
#pragma unroll
        for (int m = 0; m < 4; ++m)
#pragma unroll
          for (int n = 0; n < 2; ++n) acc[a][b][m][n] = f32x4{0.f, 0.f, 0.f, 0.f};
    cur = nxt; cA = nA; cB = nB; ++ui;
  }
  G8_WAIT_V(0);
  if (wr == 0) G8_BAR;
  G8_BAR;
#undef G8_SA
#undef G8_SB
#undef G8_STAGEV
#undef G8_LDA
#undef G8_LDB
#undef G8_MMA
#undef G8_WAIT_V
#undef G8_WAIT_L
#undef G8_BAR
#undef G8_SCHED
}
}

template <int MI, int NI>
DEVI void zero_acc(f32x4 (&acc)[MI][NI]) {
#pragma unroll
  for (int mi = 0; mi < MI; ++mi)
#pragma unroll
    for (int ni = 0; ni < NI; ++ni) acc[mi][ni] = f32x4{0.f, 0.f, 0.f, 0.f};
}

DEVI void mod_item(const Params& p, int item, float* smf) {
  const int l = item / 192, n0 = (item % 192) * 32;
  const int tid = otid();
  for (int i = tid; i < 18 * 1024; i += NTHR) {
    int s = i >> 10, k = i & 1023;
    float c = s < 16 ? p.in[2][s * 1024 + k] : p.in[3][(s - 16) * 1024 + k];
    smf[i] = c / (1.f + expf(-c));
  }
  __syncthreads();
  const int ks = tid >> 5, col = tid & 31;
  float acc[18];
#pragma unroll
  for (int s = 0; s < 18; ++s) acc[s] = 0.f;
  const float* w = p.in[4] + ((size_t)l * 1024 + ks * 64) * 6144 + n0 + col;
#pragma unroll 4
  for (int k = 0; k < 64; ++k) {
    float wv = w[(size_t)k * 6144];
#pragma unroll
    for (int s = 0; s < 18; ++s) acc[s] += smf[s * 1024 + ks * 64 + k] * wv;
  }
  __syncthreads();
#pragma unroll
  for (int s = 0; s < 18; ++s) smf[(ks * 18 + s) * 32 + col] = acc[s];
  __syncthreads();
  float* mod = (float*)(p.ws + OFF_MOD);
  for (int i = tid; i < 18 * 32; i += NTHR) {
    int s = i >> 5, c = i & 31;
    float v = p.in[5][l * 6144 + n0 + c];
#pragma unroll
    for (int k2 = 0; k2 < 16; ++k2) v += smf[(k2 * 18 + s) * 32 + c];
    mod[(size_t)(l * 18 + s) * 6144 + n0 + c] = v;
  }
  __syncthreads();
}

DEVI void rope_table(const Params& p) {
  float* rope = (float*)(p.ws + OFF_ROPE);
  const int g0 = obid() * NTHR + otid(), gs = gridDim.x * NTHR;
  for (int g = g0; g < 8192 * 32; g += gs) {
    int pos = g >> 5, i = g & 31;
    float inv = (float)pow(10000.0, -(double)i / 32.0);
    float angf = (float)pos * inv;
    double x = (double)angf;
    const double TWO_PI = 6.283185307179586476925286766559;
    const double PI = 3.14159265358979323846264338327950288;
    double n = rint(x / TWO_PI);
    double r = x - n * TWO_PI;
    double cs = 1.0;
    if (r > 0.5 * PI) { r = PI - r; cs = -1.0; }
    else if (r < -0.5 * PI) { r = -PI - r; cs = -1.0; }
    double r2 = r * r;
    double sp = 1.0 / 51090942171709440000.0;
    sp = sp * r2 - 1.0 / 121645100408832000.0;
    sp = sp * r2 + 1.0 / 355687428096000.0;
    sp = sp * r2 - 1.0 / 1307674368000.0;
    sp = sp * r2 + 1.0 / 6227020800.0;
    sp = sp * r2 - 1.0 / 39916800.0;
    sp = sp * r2 + 1.0 / 362880.0;
    sp = sp * r2 - 1.0 / 5040.0;
    sp = sp * r2 + 1.0 / 120.0;
    sp = sp * r2 - 1.0 / 6.0;
    sp = sp * r2 + 1.0;
    double sn = sp * r;
    double cp = 1.0 / 2432902008176640000.0;
    cp = cp * r2 - 1.0 / 6402373705728000.0;
    cp = cp * r2 + 1.0 / 20922789888000.0;
    cp = cp * r2 - 1.0 / 87178291200.0;
    cp = cp * r2 + 1.0 / 479001600.0;
    cp = cp * r2 - 1.0 / 3628800.0;
    cp = cp * r2 + 1.0 / 40320.0;
    cp = cp * r2 - 1.0 / 720.0;
    cp = cp * r2 + 1.0 / 24.0;
    cp = cp * r2 - 0.5;
    cp = cp * r2 + 1.0;
    rope[pos * 64 + i] = (float)(cs * cp);
    rope[pos * 64 + 32 + i] = (float)sn;
  }
}

struct MapPlain { DEVI void operator()(int db, int& srcc, bool& perm) const { srcc = db * 64; perm = false; } };
struct MapWin {
  DEVI void operator()(int db, int& srcc, bool& perm) const {
    if (db < 32) {
      const int tile = db >> 2, b = db & 3;
      const int base = tile < 2 ? tile * 256 : (tile < 7 ? (tile + 1) * 256 : (tile + 2) * 256);
      srcc = base + b * 64;
      perm = tile < 2;
    } else {
      const int d2 = db - 32, tile = d2 >> 2, b = d2 & 3;
      if (tile == 0) srcc = 512 + b * 64;
      else if (tile == 1) srcc = 2048 + b * 64;
      else if (tile == 2) srcc = 256 + b * 64;
      else srcc = b < 2 ? 2688 + b * 64 : 2560 + (b - 2) * 64;
      perm = false;
    }
  }
};
template <class MapF>
DEVI void xpose_convert(const float* __restrict__ src, int K, int N, int NB, u16* __restrict__ dst, int rot, float* smf, MapF map, int DK = 0, int koff = 0) {
  if (DK == 0) DK = K;
  const int tid = otid();
  const int ntile = (K >> 6) * NB;
  const int G = gridDim.x;
  int start = (int)obid() - (rot % G);
  if (start < 0) start += G;
  for (int t = start; t < ntile; t += G) {
    const int k0 = (t / NB) << 6, db = t % NB;
    int srcc; bool perm;
    map(db, srcc, perm);
    {
      const int ch = tid & 15, kr = tid >> 4;
#pragma unroll
      for (int ps = 0; ps < 2; ++ps) {
        int k = ps * 32 + kr;
        float4 v = *(const float4*)(src + (size_t)(k0 + k) * N + srcc + ch * 4);
        float* d = smf + k * 65 + ch * 4;
        d[0] = v.x; d[1] = v.y; d[2] = v.z; d[3] = v.w;
      }
    }
    __syncthreads();
    {
      const int kc = tid & 7, n = tid >> 3;
      const int nc = perm ? ((n >> 5) * 16 + (n & 15) + ((n >> 4) & 1) * 32) : n;
      const float* sp = smf + (kc * 8) * 65 + nc;
      uint4 o;
      o.x = pack2(sp[0], sp[65]);
      o.y = pack2(sp[2 * 65], sp[3 * 65]);
      o.z = pack2(sp[4 * 65], sp[5 * 65]);
      o.w = pack2(sp[6 * 65], sp[7 * 65]);
      *(uint4*)(dst + (size_t)(db * 64 + n) * DK + koff + k0 + kc * 8) = o;
    }
    __syncthreads();
  }
}

DEVI void phase0(const Params& p, unsigned char* smem) {
  float* smf = (float*)smem;
  for (int it = obid(); it < 384; it += gridDim.x) mod_item(p, it, smf);
  rope_table(p);
  int rot = 384;
  for (int l = 0; l < 2; ++l) {
    xpose_convert(p.in[7] + (size_t)l * 2816 * 1024, 1024, 2816, 48, (u16*)(p.ws + OFF_WIN) + (size_t)l * SZ_WIN, rot, smf, MapWin());
    rot += 768;
    for (int i = 0; i < 4; ++i) {
      xpose_convert(p.in[18] + ((size_t)l * 4 + i) * 1024 * 1024, 1024, 1024, 16,
                    (u16*)(p.ws + OFF_WMERGE) + ((size_t)l * 4 + i) * 1024 * 1024, rot, smf, MapPlain());
      rot += 256;
    }
    for (int i = 0; i < 4; ++i) {
      xpose_convert(p.in[17] + ((size_t)l * 4 + i) * 256 * 1024, 256, 1024, 16,
                    (u16*)(p.ws + OFF_WBRANCH) + (size_t)l * SZ_WBRANCH, rot, smf, MapPlain(), 1024, i * 256);
      rot += 64;
    }
    xpose_convert(p.in[19] + (size_t)l * SZ_WOUT, 1024, 1024, 16, (u16*)(p.ws + OFF_WOUT) + (size_t)l * SZ_WOUT, rot, smf, MapPlain());
    rot += 256;
    xpose_convert(p.in[20] + (size_t)l * SZ_WFF, 1024, 4096, 64, (u16*)(p.ws + OFF_WFF1) + (size_t)l * SZ_WFF, rot, smf, MapPlain());
    rot += 1024;
    xpose_convert(p.in[21] + (size_t)l * SZ_WFF, 4096, 1024, 16, (u16*)(p.ws + OFF_WFF2) + (size_t)l * SZ_WFF, rot, smf, MapPlain());
    rot += 1024;
  }
}

DEVI void phase_norm(const Params& p, int layer, int which) {
  const int lane = otid() & 63, wid = otid() >> 6;
  const float* mod = (const float*)(p.ws + OFF_MOD);
  u16* H = hbuf(p);
  const u16* XB = xbuf(p);
  const float* gain = p.in[6] + (layer * 2 + which) * 1024;
  const bool first = (layer == 0 && which == 0);
  float4 g[4];
#pragma unroll
  for (int i = 0; i < 2; ++i) {
    g[2 * i] = *(const float4*)(gain + i * 512 + lane * 8);
    g[2 * i + 1] = *(const float4*)(gain + i * 512 + lane * 8 + 4);
  }
  for (int tp = obid() * 8 + wid; tp < M / 2; tp += gridDim.x * 8) {
    const int tok = tp * 2;
    int seq, pos, T;
    tokinfo(tok, seq, pos, T);
    float4 v[2][4];
    if (first) {
      const float* xr = tok < MP ? p.in[0] + (size_t)tok * 1024 : p.in[1] + (size_t)(tok - MP) * 1024;
#pragma unroll
      for (int k = 0; k < 2; ++k)
#pragma unroll
        for (int i = 0; i < 2; ++i) {
          v[k][2 * i] = *(const float4*)(xr + k * 1024 + i * 512 + lane * 8);
          v[k][2 * i + 1] = *(const float4*)(xr + k * 1024 + i * 512 + lane * 8 + 4);
        }
    } else {
      const u16* xr = XB + (size_t)tok * 1024;
#pragma unroll
      for (int k = 0; k < 2; ++k)
#pragma unroll
        for (int i = 0; i < 2; ++i) {
          const uint4 w = *(const uint4*)(xr + k * 1024 + i * 512 + lane * 8);
          v[k][2 * i] = make_float4(lo16(w.x), hi16(w.x), lo16(w.y), hi16(w.y));
          v[k][2 * i + 1] = make_float4(lo16(w.z), hi16(w.z), lo16(w.w), hi16(w.w));
        }
    }
    const float* msh = mod + (size_t)(layer * 18 + seq) * 6144 + (which ? 3 : 0) * 1024;
    const float* msc = msh + 1024;
    float4 sh[4], sc[4];
#pragma unroll
    for (int i = 0; i < 2; ++i) {
      const int c = i * 512 + lane * 8;
      sh[2 * i] = *(const float4*)(msh + c); sh[2 * i + 1] = *(const float4*)(msh + c + 4);
      sc[2 * i] = *(const float4*)(msc + c); sc[2 * i + 1] = *(const float4*)(msc + c + 4);
    }
    asm volatile("" ::: "memory");
    float ss0 = 0.f, ss1 = 0.f;
#pragma unroll
    for (int i = 0; i < 4; ++i) {
      ss0 += v[0][i].x * v[0][i].x + v[0][i].y * v[0][i].y + v[0][i].z * v[0][i].z + v[0][i].w * v[0][i].w;
      ss1 += v[1][i].x * v[1][i].x + v[1][i].y * v[1][i].y + v[1][i].z * v[1][i].z + v[1][i].w * v[1][i].w;
    }
    ss0 = wave_sum(ss0);
    ss1 = wave_sum(ss1);
    const float rs[2] = {rsqrtf(ss0 * (1.f / 1024.f) + 1e-6f), rsqrtf(ss1 * (1.f / 1024.f) + 1e-6f)};
#pragma unroll
    for (int k = 0; k < 2; ++k)
#pragma unroll
      for (int i = 0; i < 2; ++i) {
        const float rstd = rs[k];
        const float4 xa = v[k][2 * i], xb = v[k][2 * i + 1];
        const float4 ga = g[2 * i], gb = g[2 * i + 1], sa = sc[2 * i], sb2 = sc[2 * i + 1], ha = sh[2 * i], hb = sh[2 * i + 1];
        uint4 w;
        w.x = pack2(xa.x * rstd * ga.x * (1.f + sa.x) + ha.x, xa.y * rstd * ga.y * (1.f + sa.y) + ha.y);
        w.y = pack2(xa.z * rstd * ga.z * (1.f + sa.z) + ha.z, xa.w * rstd * ga.w * (1.f + sa.w) + ha.w);
        w.z = pack2(xb.x * rstd * gb.x * (1.f + sb2.x) + hb.x, xb.y * rstd * gb.y * (1.f + sb2.y) + hb.y);
        w.w = pack2(xb.z * rstd * gb.z * (1.f + sb2.z) + hb.z, xb.w * rstd * gb.w * (1.f + sb2.w) + hb.w);
        *(uint4*)(H + (size_t)(tok + k) * 1024 + i * 512 + lane * 8) = w;
      }
  }
}

DEVI void phase_final(const Params& p) {
  const int lane = otid() & 63, wid = otid() >> 6;
  const float* gain = p.in[22];
  const u16* XB = xbuf(p);
  float4 gg[4];
#pragma unroll
  for (int i = 0; i < 2; ++i) {
    gg[2 * i] = *(const float4*)(gain + i * 512 + lane * 8);
    gg[2 * i + 1] = *(const float4*)(gain + i * 512 + lane * 8 + 4);
  }
  for (int tp = obid() * 8 + wid; tp < M / 2; tp += gridDim.x * 8) {
    const u16* xr = XB + (size_t)tp * 2048;
    float* orow = p.out + (size_t)tp * 2048;
    float4 v[2][4];
#pragma unroll
    for (int k = 0; k < 2; ++k)
#pragma unroll
      for (int i = 0; i < 2; ++i) {
        const uint4 w = *(const uint4*)(xr + k * 1024 + i * 512 + lane * 8);
        v[k][2 * i] = make_float4(lo16(w.x), hi16(w.x), lo16(w.y), hi16(w.y));
        v[k][2 * i + 1] = make_float4(lo16(w.z), hi16(w.z), lo16(w.w), hi16(w.w));
      }
    asm volatile("" ::: "memory");
    float ss0 = 0.f, ss1 = 0.f;
#pragma unroll
    for (int i = 0; i < 4; ++i) {
      ss0 += v[0][i].x * v[0][i].x + v[0][i].y * v[0][i].y + v[0][i].z * v[0][i].z + v[0][i].w * v[0][i].w;
      ss1 += v[1][i].x * v[1][i].x + v[1][i].y * v[1][i].y + v[1][i].z * v[1][i].z + v[1][i].w * v[1][i].w;
    }
    ss0 = wave_sum(ss0);
    ss1 = wave_sum(ss1);
    const float rs[2] = {rsqrtf(ss0 * (1.f / 1024.f) + 1e-6f), rsqrtf(ss1 * (1.f / 1024.f) + 1e-6f)};
#pragma unroll
    for (int k = 0; k < 2; ++k)
#pragma unroll
      for (int i = 0; i < 4; ++i) {
        const int c = (i >> 1) * 512 + lane * 8 + (i & 1) * 4;
        float4 o;
        o.x = v[k][i].x * rs[k] * gg[i].x; o.y = v[k][i].y * rs[k] * gg[i].y;
        o.z = v[k][i].z * rs[k] * gg[i].z; o.w = v[k][i].w * rs[k] * gg[i].w;
        *(float4*)(orow + k * 1024 + c) = o;
      }
  }
}

struct EpiG1Nat {
  unsigned char* ws;
  DEVI bool operator()(f32x4 (&acc)[2][2][4][2], const g8::Unit& u, int wr, int wc, int fr, int fq) const {
    const int t0 = u.pm * 256, pn = u.pn;
    int seq, pos0, T;
    tokinfo(t0, seq, pos0, T);
    if (pn < 2) {
      const float* rope = (const float*)(ws + OFF_ROPE);
      u16* dst = (u16*)(ws + (pn == 0 ? OFF_RQ : OFF_RK));
      const float scale = pn == 0 ? 0.125f : 1.f;
      const int d1 = (wc & 1) * 16 + fq * 4;
      const float* rp0 = rope + (size_t)(pos0 + wr * 64 + fr) * 64 + d1;
      u16* o0 = dst + (size_t)(t0 + wr * 64 + fr) * 256 + (wc >> 1) * 64 + d1;
#pragma unroll
      for (int ai = 0; ai < 2; ++ai) {
        float4 cc[4], ss[4];
#pragma unroll
        for (int m = 0; m < 4; ++m) {
          const float* rp = rp0 + (ai * 128 + m * 16) * 64;
          cc[m] = *(const float4*)rp;
          ss[m] = *(const float4*)(rp + 32);
        }
        asm volatile("" ::: "memory");
#pragma unroll
        for (int m = 0; m < 4; ++m) {
          const float4 c = cc[m], sn = ss[m];
#pragma unroll
          for (int bj = 0; bj < 2; ++bj) {
            const f32x4 x1 = acc[ai][bj][m][0], x2 = acc[ai][bj][m][1];
            u16* o = o0 + (ai * 128 + m * 16) * 256 + bj * 128;
            *(uint2*)o = pack4((x1[0] * c.x - x2[0] * sn.x) * scale, (x1[1] * c.y - x2[1] * sn.y) * scale,
                               (x1[2] * c.z - x2[2] * sn.z) * scale, (x1[3] * c.w - x2[3] * sn.w) * scale);
            *(uint2*)(o + 32) = pack4((x1[0] * sn.x + x2[0] * c.x) * scale, (x1[1] * sn.y + x2[1] * c.y) * scale,
                                      (x1[2] * sn.z + x2[2] * c.z) * scale, (x1[3] * sn.w + x2[3] * c.w) * scale);
          }
        }
        asm volatile("" ::: "memory");
      }
    } else {
      size_t off; int width = 256, op = 0; float scale = 1.f;
      if (pn == 2) { off = OFF_RG; op = 2; }
      else if (pn == 3) { off = OFF_CA; }
      else if (pn == 4) { off = OFF_CB; op = 3; }
      else if (pn == 5) { off = OFF_NQ; scale = 0.125f; }
      else if (pn == 6) { off = OFF_NK; }
      else if (pn == 7) { off = OFF_SQ; scale = 0.125f; }
      else { off = OFF_SK; width = 128; }
      u16* o0 = (u16*)(ws + off) + (size_t)(t0 + wr * 64 + fr) * width + wc * 32 + fq * 4;
#pragma unroll
      for (int ai = 0; ai < 2; ++ai)
#pragma unroll
        for (int m = 0; m < 4; ++m) {
          u16* orow = o0 + (size_t)((ai * 128 + m * 16) * width);
#pragma unroll
          for (int bj = 0; bj < 2; ++bj) {
            if (pn == 8 && bj == 1) continue;
#pragma unroll
            for (int n = 0; n < 2; ++n) {
              const f32x4 v = acc[ai][bj][m][n];
              float q0, q1, q2, q3;
              if (op == 2) { q0 = v[0] * sigmoidf_(v[0]); q1 = v[1] * sigmoidf_(v[1]); q2 = v[2] * sigmoidf_(v[2]); q3 = v[3] * sigmoidf_(v[3]); }
              else if (op == 3) { q0 = sigmoidf_(v[0]); q1 = sigmoidf_(v[1]); q2 = sigmoidf_(v[2]); q3 = sigmoidf_(v[3]); }
              else { q0 = v[0] * scale; q1 = v[1] * scale; q2 = v[2] * scale; q3 = v[3] * scale; }
              *(uint2*)(orow + bj * 128 + n * 16) = pack4(q0, q1, q2, q3);
            }
          }
          asm volatile("" ::: "memory");
        }
    }
    return true;
  }
};
struct EpiG1Tr {
  unsigned char* ws;
  DEVI bool operator()(f32x4 (&acc)[2][2][4][2], const g8::Unit& u, int wr, int wc, int fr, int fq) const {
    const int pm = u.pm, tb = u.pn * 256;
    int seq, pos0, T;
    tokinfo(tb, seq, pos0, T);
    if (pm == 2) {
      const float* rope = (const float*)(ws + OFF_ROPE);
      u16* dst = (u16*)(ws + OFF_RKT);
      const float* rp0 = rope + (size_t)(pos0 + wc * 32 + fq * 4) * 64 + fr;
      u16* o0 = dst + (size_t)(wr * 64 + fr) * M + tb + wc * 32 + fq * 4;
#pragma unroll
      for (int ai = 0; ai < 2; ++ai)
#pragma unroll
        for (int m = 0; m < 2; ++m) {
          float cv[2][2][4], sv[2][2][4];
#pragma unroll
          for (int bj = 0; bj < 2; ++bj)
#pragma unroll
            for (int n = 0; n < 2; ++n) {
              const float* rp = rp0 + (bj * 128 + n * 16) * 64 + m * 16;
#pragma unroll
              for (int j = 0; j < 4; ++j) { cv[bj][n][j] = rp[j * 64]; sv[bj][n][j] = rp[j * 64 + 32]; }
            }
          asm volatile("" ::: "memory");
#pragma unroll
          for (int bj = 0; bj < 2; ++bj)
#pragma unroll
            for (int n = 0; n < 2; ++n) {
              const f32x4 x1 = acc[ai][bj][m][n], x2 = acc[ai][bj][m + 2][n];
              float o1[4], o2[4];
#pragma unroll
              for (int j = 0; j < 4; ++j) {
                const float c = cv[bj][n][j], sn = sv[bj][n][j];
                o1[j] = x1[j] * c - x2[j] * sn;
                o2[j] = x1[j] * sn + x2[j] * c;
              }
              u16* o = o0 + (size_t)(ai * 128 + m * 16) * M + bj * 128 + n * 16;
              *(uint2*)o = pack4(o1[0], o1[1], o1[2], o1[3]);
              *(uint2*)(o + (size_t)32 * M) = pack4(o2[0], o2[1], o2[2], o2[3]);
            }
          asm volatile("" ::: "memory");
        }
    } else {
      u16* dst = (u16*)(ws + (pm == 0 ? OFF_RVT : (pm == 1 ? OFF_NVT : OFF_SVT)));
      u16* o0 = dst + (size_t)(wr * 64 + fr) * M + tb + wc * 32 + fq * 4;
      const long half1 = pm == 3 ? ((long)(OFF_SK - OFF_SVT) / 2 - (long)128 * M) : 0;
#pragma unroll
      for (int ai = 0; ai < 2; ++ai) {
#pragma unroll
        for (int m = 0; m < 4; ++m) {
          u16* orow = o0 + (size_t)(ai * 128 + m * 16) * M + (ai ? half1 : 0);
#pragma unroll
          for (int bj = 0; bj < 2; ++bj)
#pragma unroll
            for (int n = 0; n < 2; ++n) {
              const f32x4 v = acc[ai][bj][m][n];
              *(uint2*)(orow + bj * 128 + n * 16) = pack4(v[0], v[1], v[2], v[3]);
            }
          asm volatile("" ::: "memory");
        }
      }
    }
    return true;
  }
};
DEVI void phase_gemm1(const Params& p, int layer, unsigned char* smem) {
  const u16* H = hbuf(p);
  const u16* W = (const u16*)(p.ws + OFF_WIN) + (size_t)layer * SZ_WIN;
  g8::Order S;
  S.init(M / 256, 8, gridDim.x, obid(), 1024);
  EpiG1Nat e1{p.ws};
  g8::gemm_phase<false>((LAS unsigned char*)smem, H, W, 1024, S, e1);
  g8::Order S2;
  S2.init(4, M / 256, gridDim.x, obid(), 1024);
  EpiG1Tr e2{p.ws};
  g8::gemm_phase<false>((LAS unsigned char*)smem, W + (size_t)2048 * 1024, H, 1024, S2, e2);
}

DEVI void phase_ret_u(const Params& p, int layer) {
  const int lane = otid() & 63, wid = otid() >> 6, fr = lane & 15, fq = lane >> 4;
  const u16* RKT = (const u16*)(p.ws + OFF_RKT);
  const u16* RVT = (const u16*)(p.ws + OFF_RVT);
  float* U = (float*)(p.ws + OFF_U);
  for (int u = obid() * 8 + wid; u < 2560; u += gridDim.x * 8) {
    const int h = u & 3, cgi = u >> 2, tok0 = cgi * 128;
    const float l2f = log_sigmoid(p.in[8][(layer * 2 + 0) * 4 + h]) * 1.4426950408889634f;
    const float l2b = log_sigmoid(p.in[8][(layer * 2 + 1) * 4 + h]) * 1.4426950408889634f;
#pragma unroll 1
    for (int hf = 0; hf < 2; ++hf) {
      f32x4 aF[4][2], aB[4][2];
      zero_acc<4, 2>(aF);
      zero_acc<4, 2>(aB);
#pragma unroll 1
      for (int ks = 0; ks < 4; ++ks) {
        const int m0 = ks * 32 + fq * 8;
        bf16x8 av[4];
#pragma unroll
        for (int dvt = 0; dvt < 4; ++dvt)
          av[dvt] = *(const bf16x8*)(RVT + (size_t)(h * 64 + dvt * 16 + fr) * M + tok0 + m0);
#pragma unroll
        for (int d2 = 0; d2 < 2; ++d2) {
          const int dkt = hf * 2 + d2;
          uint4 kr = *(const uint4*)(RKT + (size_t)(h * 64 + dkt * 16 + fr) * M + tok0 + m0);
          const unsigned kw[4] = {kr.x, kr.y, kr.z, kr.w};
          V8 kf, kb;
          unsigned of_[4], ob_[4];
#pragma unroll
          for (int e2 = 0; e2 < 4; ++e2) {
            const int m = m0 + e2 * 2;
            const float zf0 = exp2f(l2f * (float)(127 - m)), zf1 = exp2f(l2f * (float)(126 - m));
            const float zb0 = exp2f(l2b * (float)m), zb1 = exp2f(l2b * (float)(m + 1));
            of_[e2] = pack2(lo16(kw[e2]) * zf0, hi16(kw[e2]) * zf1);
            ob_[e2] = pack2(lo16(kw[e2]) * zb0, hi16(kw[e2]) * zb1);
          }
          kf.u = make_uint4(of_[0], of_[1], of_[2], of_[3]);
          kb.u = make_uint4(ob_[0], ob_[1], ob_[2], ob_[3]);
#pragma unroll
          for (int dvt = 0; dvt < 4; ++dvt) {
            aF[dvt][d2] = mfma16(av[dvt], kf.v, aF[dvt][d2]);
            aB[dvt][d2] = mfma16(av[dvt], kb.v, aB[dvt][d2]);
          }
        }
      }
      float* uf = U + (size_t)(u * 2 + 0) * 4096;
      float* ub = U + (size_t)(u * 2 + 1) * 4096;
#pragma unroll
      for (int dvt = 0; dvt < 4; ++dvt)
#pragma unroll
        for (int d2 = 0; d2 < 2; ++d2)
#pragma unroll
          for (int j = 0; j < 4; ++j) {
            const int idx = (dvt * 16 + fq * 4 + j) * 64 + (hf * 2 + d2) * 16 + fr;
            uf[idx] = aF[dvt][d2][j];
            ub[idx] = aB[dvt][d2][j];
          }
    }
  }
}

DEVI void phase_ret_scan(const Params& p, int layer) {
  const float* U = (const float*)(p.ws + OFF_U);
  u16* R = (u16*)(p.ws + OFF_R);
  const int total = 72 * 2 * 4096;
  for (int g = obid() * NTHR + otid(); g < total; g += gridDim.x * NTHR) {
    const int e = g & 4095, dir = (g >> 12) & 1, bh = g >> 13, h = bh & 3, b = bh >> 2;
    int base, N;
    if (b < 16) { base = b * 32; N = 32; } else { base = 512 + (b - 16) * 64; N = 64; }
    const float gC = expf(128.f * log_sigmoid(p.in[8][(layer * 2 + dir) * 4 + h]));
    float run = 0.f;
    const int nb = N >> 4;
#pragma unroll 1
    for (int bb = 0; bb < nb; ++bb) {
      float uv[16];
#pragma unroll
      for (int k = 0; k < 16; ++k) {
        const int n = dir == 0 ? (bb * 16 + k) : (N - 1 - (bb * 16 + k));
        uv[k] = U[((size_t)((base + n) * 4 + h) * 2 + dir) * 4096 + e];
      }
      asm volatile("" ::: "memory");
#pragma unroll
      for (int k = 0; k < 16; ++k) {
        const int n = dir == 0 ? (bb * 16 + k) : (N - 1 - (bb * 16 + k));
        R[((size_t)((base + n) * 4 + h) * 2 + dir) * 4096 + e] = f2bf(run);
        run = gC * run + uv[k];
      }
    }
  }
}

DEVI void phase_ret_out(const Params& p, int layer, unsigned char* smem) {
  constexpr int KLD = 68, VLD = 136, RLD = 72;
  u16* Ks = (u16*)smem;
  u16* Vs = (u16*)(smem + 17408);
  u16* Rfs = (u16*)(smem + 34816);
  u16* Rbs = (u16*)(smem + 44032);
  const int tid = otid(), lane = tid & 63, wid = tid >> 6, fr = lane & 15, fq = lane >> 4;
  const u16* RQ = (const u16*)(p.ws + OFF_RQ);
  const u16* RK = (const u16*)(p.ws + OFF_RK);
  const u16* RVT = (const u16*)(p.ws + OFF_RVT);
  const u16* RG = (const u16*)(p.ws + OFF_RG);
  const u16* R = (const u16*)(p.ws + OFF_R);
  u16* BR = brbuf(p);
  const float* gn = p.in[9] + layer * 256;
  for (int it = obid(); it < 2560; it += gridDim.x) {
    const int h = it & 3, cgi = it >> 2, ctok0 = cgi * 128, c0 = wid * 16, tok0 = ctok0 + c0;
    for (int c = tid; c < 3072; c += NTHR) {
      if (c < 1024) {
        const int k = c >> 3, part = c & 7;
        const uint4 v = *(const uint4*)(RK + (size_t)(ctok0 + k) * 256 + h * 64 + part * 8);
        uint2* d = (uint2*)(Ks + k * KLD + part * 8);
        d[0] = make_uint2(v.x, v.y);
        d[1] = make_uint2(v.z, v.w);
      } else if (c < 2048) {
        const int c2 = c - 1024, d = c2 >> 4, part = c2 & 15;
        *(uint4*)(Vs + d * VLD + part * 8) = *(const uint4*)(RVT + (size_t)(h * 64 + d) * M + ctok0 + part * 8);
      } else {
        const int c2 = c - 2048, dir = c2 >> 9, c3 = c2 & 511, dv = c3 >> 3, part = c3 & 7;
        *(uint4*)((dir ? Rbs : Rfs) + dv * RLD + part * 8) =
            *(const uint4*)(R + (size_t)((cgi * 4 + h) * 2 + dir) * 4096 + dv * 64 + part * 8);
      }
    }
    __syncthreads();
    const float l2f = log_sigmoid(p.in[8][(layer * 2 + 0) * 4 + h]) * 1.4426950408889634f;
    const float l2b = log_sigmoid(p.in[8][(layer * 2 + 1) * 4 + h]) * 1.4426950408889634f;
    const u16* qp = RQ + (size_t)(tok0 + fr) * 256 + h * 64 + fq * 8;
    const bf16x8 q0 = *(const bf16x8*)qp, q1 = *(const bf16x8*)(qp + 32);
    const int c = c0 + fr;
    f32x4 s[8];
    const u16* kl0 = Ks + (8 * (fr >> 2) + (fr & 3)) * KLD + fq * 8;
#pragma unroll
    for (int t = 0; t < 8; ++t) {
      const u16* kp = kl0 + ((t >> 1) * 32 + (t & 1) * 4) * KLD;
      V8 k0, k1;
      k0.h[0] = *(const uint2*)kp;        k0.h[1] = *(const uint2*)(kp + 4);
      k1.h[0] = *(const uint2*)(kp + 32); k1.h[1] = *(const uint2*)(kp + 36);
      f32x4 a = {0.f, 0.f, 0.f, 0.f};
      a = mfma16(k0.v, q0, a);
      a = mfma16(k1.v, q1, a);
#pragma unroll
      for (int j = 0; j < 4; ++j) {
        const int m = (t >> 1) * 32 + 8 * fq + 4 * (t & 1) + j;
        const int diff = c - m;
        const float dec = diff >= 0 ? __builtin_amdgcn_exp2f(l2f * (float)diff) : __builtin_amdgcn_exp2f(l2b * (float)(-diff));
        a[j] *= dec;
      }
      s[t] = a;
      asm volatile("" ::: "memory");
    }
    f32x4 o[4], iF[4], iB[4];
#pragma unroll
    for (int dt = 0; dt < 4; ++dt) { o[dt] = f32x4{0.f, 0.f, 0.f, 0.f}; iF[dt] = o[dt]; iB[dt] = o[dt]; }
    const u16* vl0 = Vs + fr * VLD + fq * 8;
#pragma unroll
    for (int ks = 0; ks < 4; ++ks) {
      V8 pb;
      pb.h[0] = pack4(s[2 * ks][0], s[2 * ks][1], s[2 * ks][2], s[2 * ks][3]);
      pb.h[1] = pack4(s[2 * ks + 1][0], s[2 * ks + 1][1], s[2 * ks + 1][2], s[2 * ks + 1][3]);
#pragma unroll
      for (int dt = 0; dt < 4; ++dt) {
        V8 va;
        va.u = *(const uint4*)(vl0 + dt * 16 * VLD + ks * 32);
        o[dt] = mfma16(va.v, pb.v, o[dt]);
      }
      asm volatile("" ::: "memory");
    }
    {
      const u16* rf = Rfs + fr * RLD + fq * 8;
      const u16* rb = Rbs + fr * RLD + fq * 8;
#pragma unroll
      for (int dt = 0; dt < 4; ++dt) {
        iF[dt] = mfma16(*(const bf16x8*)(rf + dt * 16 * RLD), q0, iF[dt]);
        iF[dt] = mfma16(*(const bf16x8*)(rf + dt * 16 * RLD + 32), q1, iF[dt]);
        iB[dt] = mfma16(*(const bf16x8*)(rb + dt * 16 * RLD), q0, iB[dt]);
        iB[dt] = mfma16(*(const bf16x8*)(rb + dt * 16 * RLD + 32), q1, iB[dt]);
      }
    }
    const float xif = exp2f(l2f * (float)(c + 1)), xib = exp2f(l2b * (float)(128 - c));
    float sum = 0.f;
#pragma unroll
    for (int dt = 0; dt < 4; ++dt)
#pragma unroll
      for (int j = 0; j < 4; ++j) {
        o[dt][j] += xif * iF[dt][j] + xib * iB[dt][j];
        sum += o[dt][j];
      }
    sum += __shfl_xor(sum, 16);
    sum += __shfl_xor(sum, 32);
    const float mu = sum * (1.f / 64.f);
    float vs = 0.f;
#pragma unroll
    for (int dt = 0; dt < 4; ++dt)
#pragma unroll
      for (int j = 0; j < 4; ++j) { float d = o[dt][j] - mu; vs += d * d; }
    vs += __shfl_xor(vs, 16);
    vs += __shfl_xor(vs, 32);
    const float rstd = rsqrtf(vs * (1.f / 64.f) + 1e-6f);
#pragma unroll
    for (int dt = 0; dt < 4; ++dt) {
      const int ch = h * 64 + dt * 16 + fq * 4;
      float4 g = *(const float4*)(gn + ch);
      uint2 sg = *(const uint2*)(RG + (size_t)(tok0 + fr) * 256 + ch);
      float r0 = (o[dt][0] - mu) * rstd * g.x * lo16(sg.x);
      float r1 = (o[dt][1] - mu) * rstd * g.y * hi16(sg.x);
      float r2 = (o[dt][2] - mu) * rstd * g.z * lo16(sg.y);
      float r3 = (o[dt][3] - mu) * rstd * g.w * hi16(sg.y);
      *(uint2*)(BR + (size_t)(tok0 + fr) * 1024 + ch) = pack4(r0, r1, r2, r3);
    }
    __syncthreads();
  }
}

DEVI void phase_conv(const Params& p, int layer, unsigned char* smem) {
  const int tid = otid(), lane = tid & 63, wid = tid >> 6, half = tid >> 8, ct = tid & 255;
  float* su = (float*)smem + half * (62 * 256);
  const u16* CA = (const u16*)(p.ws + OFF_CA);
  const u16* CB = (const u16*)(p.ws + OFF_CB);
  u16* BR = brbuf(p) + 256;
  float w[31];
#pragma unroll
  for (int j = 0; j < 31; ++j) w[j] = p.in[10][(layer * 31 + j) * 256 + ct];
  const float bias = p.in[11][layer * 256 + ct];
  const float4 lg = *(const float4*)(p.in[12] + layer * 256 + lane * 4);
  const float4 lbb = *(const float4*)(p.in[13] + layer * 256 + lane * 4);
  for (int it = obid(); it < 1280; it += gridDim.x) {
    const int t0 = (it * 2 + half) * 32;
    int seq, pos0, T;
    tokinfo(t0, seq, pos0, T);
    const int sb = t0 - pos0;
    {
      const int ch = ct & 31, rr = ct >> 5;
#pragma unroll
      for (int ps = 0; ps < 8; ++ps) {
        const int row = ps * 8 + rr;
        if (row < 62) {
          const int pos = pos0 - 15 + row;
          float u[8];
          if (pos >= 0 && pos < T) {
            uint4 a = *(const uint4*)(CA + (size_t)(sb + pos) * 256 + ch * 8);
            uint4 b = *(const uint4*)(CB + (size_t)(sb + pos) * 256 + ch * 8);
            u[0] = lo16(a.x) * lo16(b.x); u[1] = hi16(a.x) * hi16(b.x);
            u[2] = lo16(a.y) * lo16(b.y); u[3] = hi16(a.y) * hi16(b.y);
            u[4] = lo16(a.z) * lo16(b.z); u[5] = hi16(a.z) * hi16(b.z);
            u[6] = lo16(a.w) * lo16(b.w); u[7] = hi16(a.w) * hi16(b.w);
          } else {
#pragma unroll
            for (int e = 0; e < 8; ++e) u[e] = 0.f;
          }
          float* d = su + row * 256 + ch * 8;
          *(float4*)d = make_float4(u[0], u[1], u[2], u[3]);
          *(float4*)(d + 4) = make_float4(u[4], u[5], u[6], u[7]);
        }
      }
    }
    __syncthreads();
    float y[32];
#pragma unroll
    for (int t = 0; t < 32; ++t) y[t] = bias;
#pragma unroll
    for (int r = 0; r < 62; ++r) {
      const float uv = su[r * 256 + ct];
#pragma unroll
      for (int t = 0; t < 32; ++t) {
        const int j = r - t;
        if (j >= 0 && j < 31) y[t] += uv * w[j];
      }
    }
    __syncthreads();
#pragma unroll
    for (int t = 0; t < 32; ++t) su[t * 256 + ct] = y[t];
    __syncthreads();
#pragma unroll 1
    for (int tt = 0; tt < 8; ++tt) {
      const int t = (wid & 3) * 8 + tt;
      float4 v = *(const float4*)(su + t * 256 + lane * 4);
      float sm = wave_sum(v.x + v.y + v.z + v.w);
      const float mu = sm * (1.f / 256.f);
      float d0 = v.x - mu, d1 = v.y - mu, d2 = v.z - mu, d3 = v.w - mu;
      float vs = wave_sum(d0 * d0 + d1 * d1 + d2 * d2 + d3 * d3);
      const float rstd = rsqrtf(vs * (1.f / 256.f) + 1e-6f);
      float z0 = d0 * rstd * lg.x + lbb.x, z1 = d1 * rstd * lg.y + lbb.y, z2 = d2 * rstd * lg.z + lbb.z,
            z3 = d3 * rstd * lg.w + lbb.w;
      z0 *= sigmoidf_(z0); z1 *= sigmoidf_(z1); z2 *= sigmoidf_(z2); z3 *= sigmoidf_(z3);
      *(uint2*)(BR + (size_t)(t0 + t) * 1024 + lane * 4) = pack4(z0, z1, z2, z3);
    }
    __syncthreads();
  }
}

DEVI void phase_na(const Params& p, int layer, unsigned char* smem) {
  constexpr int KLD = 68, VLD = 488;
  u16* Ks = (u16*)smem;
  u16* Vs = (u16*)(smem + 65280);
  float* rpb = (float*)(smem + 65280 + 62464);
  const int tid = otid(), lane = tid & 63, wid = tid >> 6, fr = lane & 15, fq = lane >> 4;
  const u16* NQ = (const u16*)(p.ws + OFF_NQ);
  const u16* NK = (const u16*)(p.ws + OFF_NK);
  const u16* NVT = (const u16*)(p.ws + OFF_NVT);
  u16* BR = brbuf(p);
  for (int it = obid(); it < 2560; it += gridDim.x) {
    const int h = it & 3, jb = (it >> 2) & 3, rgi = it >> 4;
    int sb, T, rg;
    if (rgi < 128) { sb = (rgi >> 3) * 4096; T = 4096; rg = rgi & 7; }
    else { const int q = rgi - 128; sb = MP + (q >> 4) * 8192; T = 8192; rg = q & 15; }
    const int rows = T >> 6;
    const int r0 = rg * 8;
    int lo = r0 - 4; lo = lo < 0 ? 0 : (lo > rows - 8 ? rows - 8 : lo);
    int hi = r0 + 7 - 4; hi = hi < 0 ? 0 : (hi > rows - 8 ? rows - 8 : hi); hi += 7;
    const int nrow = hi - lo + 1;
    const int kb = jb == 0 ? 0 : (jb == 1 ? 8 : (jb == 2 ? 24 : 32));
    for (int i = tid; i < 465; i += NTHR) rpb[i] = p.in[14][(layer * 4 + h) * 465 + i];
    {
      const int nk = nrow * 32 * 8;
      for (int c = tid; c < nk; c += NTHR) {
        const int k = c >> 3, part = c & 7;
        const uint4 v = *(const uint4*)(NK + (size_t)(sb + (lo + (k >> 5)) * 64 + kb + (k & 31)) * 256 + h * 64 + part * 8);
        uint2* d = (uint2*)(Ks + k * KLD + part * 8);
        d[0] = make_uint2(v.x, v.y);
        d[1] = make_uint2(v.z, v.w);
      }
      const int nv = 64 * nrow * 4;
      for (int c = tid; c < nv; c += NTHR) {
        const int d = c / (nrow * 4), rem = c - d * (nrow * 4), seg = rem >> 2, part = rem & 3;
        const uint4 v = *(const uint4*)(NVT + (size_t)(h * 64 + d) * M + sb + (lo + seg) * 64 + kb + part * 8);
        *(uint4*)(Vs + d * VLD + seg * 32 + part * 8) = v;
      }
    }
    __syncthreads();
    {
      const int r = r0 + wid;
      const int pos0 = r * 64 + jb * 16, tok0 = sb + pos0, qc0 = jb * 16;
      int start = r - 4;
      start = start < 0 ? 0 : (start > rows - 8 ? rows - 8 : start);
      const int rel0 = start - lo;
      const u16* qp = NQ + (size_t)(tok0 + fr) * 256 + h * 64 + fq * 8;
      const bf16x8 q0 = *(const bf16x8*)qp, q1 = *(const bf16x8*)(qp + 32);
      const int qcol = qc0 + fr;
      int wst = qcol - 8;
      wst = wst < 0 ? 0 : (wst > 48 ? 48 : wst);
      f32x4 s[16];
      float mx = -3e38f;
      const u16* kl0 = Ks + (rel0 * 32 + 8 * (fr >> 2) + (fr & 3)) * KLD + fq * 8;
#pragma unroll
      for (int t = 0; t < 16; ++t) {
        const int i = t >> 1, pp = t & 1;
        const u16* kp = kl0 + (i * 32 + pp * 4) * KLD;
        V8 k0, k1;
        k0.h[0] = *(const uint2*)kp;        k0.h[1] = *(const uint2*)(kp + 4);
        k1.h[0] = *(const uint2*)(kp + 32); k1.h[1] = *(const uint2*)(kp + 36);
        f32x4 a = {0.f, 0.f, 0.f, 0.f};
        a = mfma16(k0.v, q0, a);
        a = mfma16(k1.v, q1, a);
        const int dr = start + i - r + 7;
#pragma unroll
        for (int j = 0; j < 4; ++j) {
          const int kcol = kb + 8 * fq + 4 * pp + j;
          const int rel = kcol - wst;
          int dc = kcol - qcol + 15;
          dc = dc < 0 ? 0 : (dc > 30 ? 30 : dc);
          const bool ok = (rel >= 0) && (rel < 16);
          const float v = ok ? a[j] + rpb[dr * 31 + dc] : -1e30f;
          a[j] = v;
          mx = fmaxf(mx, v);
        }
        s[t] = a;
      }
      mx = fmaxf(mx, __shfl_xor(mx, 16));
      mx = fmaxf(mx, __shfl_xor(mx, 32));
      float sum = 0.f;
#pragma unroll
      for (int t = 0; t < 16; ++t)
#pragma unroll
        for (int j = 0; j < 4; ++j) { float e = fast_exp(s[t][j] - mx); s[t][j] = e; sum += e; }
      sum += __shfl_xor(sum, 16);
      sum += __shfl_xor(sum, 32);
      const float inv = fast_rcp(sum);
      f32x4 o[4];
#pragma unroll
      for (int dt = 0; dt < 4; ++dt) o[dt] = f32x4{0.f, 0.f, 0.f, 0.f};
      const u16* vl0 = Vs + fr * VLD + rel0 * 32 + fq * 8;
#pragma unroll
      for (int ks = 0; ks < 8; ++ks) {
        V8 pb;
        pb.h[0] = pack4(s[2 * ks][0] * inv, s[2 * ks][1] * inv, s[2 * ks][2] * inv, s[2 * ks][3] * inv);
        pb.h[1] = pack4(s[2 * ks + 1][0] * inv, s[2 * ks + 1][1] * inv, s[2 * ks + 1][2] * inv, s[2 * ks + 1][3] * inv);
#pragma unroll
        for (int dt = 0; dt < 4; ++dt) {
          V8 va;
          va.u = *(const uint4*)(vl0 + dt * 16 * VLD + ks * 32);
          o[dt] = mfma16(va.v, pb.v, o[dt]);
        }
      }
#pragma unroll
      for (int dt = 0; dt < 4; ++dt)
        *(uint2*)(BR + (size_t)(tok0 + fr) * 1024 + 512 + h * 64 + dt * 16 + fq * 4) =
            pack4(o[dt][0], o[dt][1], o[dt][2], o[dt][3]);
    }
    __syncthreads();
  }
}

DEVI int t5_bucket_dev(int rel) {
  int n = rel < 0 ? -rel : rel;
  int b;
  if (n < 8) b = n;
  else b = 8 + (n >= 12) + (n >= 16) + (n >= 23) + (n >= 32) + (n >= 46) + (n >= 64) + (n >= 91);
  return (rel > 0 ? 16 : 0) + b;
}

DEVI void phase_swa(const Params& p, int layer, unsigned char* smem) {
  constexpr int KLD = 68, VLD = 392;
  u16* Ks = (u16*)smem;
  u16* Vs = (u16*)(smem + 52224);
  float* lut = (float*)(smem + 52224 + 50176);
  const int tid = otid(), lane = tid & 63, wid = tid >> 6, fr = lane & 15, fq = lane >> 4;
  const u16* SQ = (const u16*)(p.ws + OFF_SQ);
  const u16* SK = (const u16*)(p.ws + OFF_SK);
  const u16* SVT = (const u16*)(p.ws + OFF_SVT);
  u16* BR = brbuf(p);
  for (int it = obid(); it < 1280; it += gridDim.x) {
    const int hkv = it & 1, blk = it >> 1, tokb = blk * 128;
    int seq, posb, T;
    tokinfo(tokb, seq, posb, T);
    const int sb = tokb - posb;
    const int wlo = posb - 128;
    for (int i = tid; i < 2 * 257; i += NTHR) {
      const int g = i / 257, rel = (i % 257) - 128;
      lut[i] = p.in[16][t5_bucket_dev(rel) * 4 + hkv * 2 + g];
    }
    for (int c = tid; c < 64 * 48; c += NTHR) {
      const int d = c / 48, rem = c - d * 48, kofs = (rem >> 2) * 32 + (rem & 3) * 8, kpos = wlo + kofs;
      uint4 v = make_uint4(0u, 0u, 0u, 0u);
      if (kpos >= 0 && kpos < T) v = *(const uint4*)(SK + (size_t)(hkv * 64 + d) * M + sb + kpos);
      u16* kd = Ks + kofs * KLD + d;
      kd[0 * KLD] = (u16)(v.x & 0xffffu); kd[1 * KLD] = (u16)(v.x >> 16);
      kd[2 * KLD] = (u16)(v.y & 0xffffu); kd[3 * KLD] = (u16)(v.y >> 16);
      kd[4 * KLD] = (u16)(v.z & 0xffffu); kd[5 * KLD] = (u16)(v.z >> 16);
      kd[6 * KLD] = (u16)(v.w & 0xffffu); kd[7 * KLD] = (u16)(v.w >> 16);
    }
    for (int c = tid; c < 64 * 48; c += NTHR) {
      const int d = c / 48, rem = c - d * 48, kofs = (rem >> 2) * 32 + (rem & 3) * 8, kpos = wlo + kofs;
      uint4 v = make_uint4(0u, 0u, 0u, 0u);
      if (kpos >= 0 && kpos < T) v = *(const uint4*)(SVT + (size_t)(hkv * 64 + d) * M + sb + kpos);
      *(uint4*)(Vs + d * VLD + kofs) = v;
    }
    __syncthreads();
    const int pos0 = posb + wid * 16, tok0 = sb + pos0;
    const int b0 = wid >> 1;
    const int qoff = 128 + (wid & 1) * 16;
    const u16* kl0 = Ks + (b0 * 32 + 8 * (fr >> 2) + (fr & 3)) * KLD + fq * 8;
    const u16* vl0 = Vs + fr * VLD + b0 * 32 + fq * 8;
#pragma unroll 1
    for (int g = 0; g < 2; ++g) {
      const int hq = hkv * 2 + g;
      const float sink = p.in[15][layer * 4 + hq];
      const u16* qp = SQ + (size_t)(tok0 + fr) * 256 + hq * 64 + fq * 8;
      const bf16x8 q0 = *(const bf16x8*)qp, q1 = *(const bf16x8*)(qp + 32);
      f32x4 s[18];
      float mx = sink;
#pragma unroll
      for (int t = 0; t < 18; ++t) {
        const int bs = wlo + (b0 + (t >> 1)) * 32;
        const bool bv = (bs >= 0) && (bs < T);
        const u16* kp = kl0 + ((t >> 1) * 32 + (t & 1) * 4) * KLD;
        V8 k0, k1;
        k0.h[0] = *(const uint2*)kp;        k0.h[1] = *(const uint2*)(kp + 4);
        k1.h[0] = *(const uint2*)(kp + 32); k1.h[1] = *(const uint2*)(kp + 36);
        f32x4 a = {0.f, 0.f, 0.f, 0.f};
        a = mfma16(k0.v, q0, a);
        a = mfma16(k1.v, q1, a);
#pragma unroll
        for (int j = 0; j < 4; ++j) {
          const int rel = (t >> 1) * 32 + 8 * fq + 4 * (t & 1) + j - qoff - fr;
          const bool ok = bv && rel >= -128 && rel <= 128;
          int li = rel + 128;
          li = li < 0 ? 0 : (li > 256 ? 256 : li);
          const float v = ok ? a[j] + lut[g * 257 + li] : -1e30f;
          a[j] = v;
          mx = fmaxf(mx, v);
        }
        s[t] = a;
        asm volatile("" ::: "memory");
      }
      mx = fmaxf(mx, __shfl_xor(mx, 16));
      mx = fmaxf(mx, __shfl_xor(mx, 32));
      float sum = 0.f;
#pragma unroll
      for (int t = 0; t < 18; ++t)
#pragma unroll
        for (int j = 0; j < 4; ++j) { float e = fast_exp(s[t][j] - mx); s[t][j] = e; sum += e; }
      sum += __shfl_xor(sum, 16);
      sum += __shfl_xor(sum, 32);
      const float inv = fast_rcp(sum + fast_exp(sink - mx));
      f32x4 o[4];
#pragma unroll
      for (int dt = 0; dt < 4; ++dt) o[dt] = f32x4{0.f, 0.f, 0.f, 0.f};
#pragma unroll
      for (int ks = 0; ks < 9; ++ks) {
        V8 pb;
        pb.h[0] = pack4(s[2 * ks][0] * inv, s[2 * ks][1] * inv, s[2 * ks][2] * inv, s[2 * ks][3] * inv);
        pb.h[1] = pack4(s[2 * ks + 1][0] * inv, s[2 * ks + 1][1] * inv, s[2 * ks + 1][2] * inv, s[2 * ks + 1][3] * inv);
#pragma unroll
        for (int dt = 0; dt < 4; ++dt) {
          V8 va;
          va.u = *(const uint4*)(vl0 + dt * 16 * VLD + ks * 32);
          o[dt] = mfma16(va.v, pb.v, o[dt]);
        }
        asm volatile("" ::: "memory");
      }
#pragma unroll
      for (int dt = 0; dt < 4; ++dt)
        *(uint2*)(BR + (size_t)(tok0 + fr) * 1024 + 768 + hq * 64 + dt * 16 + fq * 4) =
            pack4(o[dt][0], o[dt][1], o[dt][2], o[dt][3]);
    }
    __syncthreads();
  }
}

struct TileOrder {
  int pm, pn; bool gate; size_t a0, b0;
  DEVI bool next(int ui, g8::Unit& u) const {
    if (ui >= 4) return false;
    u.pm = pm; u.pn = pn; u.aux = ui;
    if (gate) {
      u.nt = 16;
      u.aoff = a0 + (size_t)pm * 256 * 1024 * 2;
      u.boff = b0 + ((size_t)ui * 1024 + pn * 256) * 1024 * 2;
    } else {
      u.nt = 4;
      u.aoff = a0 + ((size_t)pm * 256 * 1024 + ui * 256) * 2;
      u.boff = b0 + ((size_t)pn * 256 * 1024 + ui * 256) * 2;
    }
    return true;
  }
};
struct EpiGateTile {
  u16* scr;
  DEVI bool operator()(f32x4 (&acc)[2][2][4][2], const g8::Unit& u, int wr, int wc, int fr, int fq) const {
    u16* o0 = scr + u.aux * 65536 + (wr * 64 + fr) * 256 + wc * 32 + fq * 8;
#pragma unroll
    for (int ai = 0; ai < 2; ++ai)
#pragma unroll
      for (int m = 0; m < 4; ++m) {
        u16* orow = o0 + (ai * 128 + m * 16) * 256;
#pragma unroll
        for (int bj = 0; bj < 2; ++bj) {
          const f32x4 v0 = acc[ai][bj][m][0], v1 = acc[ai][bj][m][1];
          uint4 w;
          w.x = pack2(sigmoidf_(v0[0]), sigmoidf_(v0[1])); w.y = pack2(sigmoidf_(v0[2]), sigmoidf_(v0[3]));
          w.z = pack2(sigmoidf_(v1[0]), sigmoidf_(v1[1])); w.w = pack2(sigmoidf_(v1[2]), sigmoidf_(v1[3]));
          *(uint4*)(orow + bj * 128) = w;
        }
        asm volatile("" ::: "memory");
      }
    return true;
  }
};
struct EpiMergeTile {
  const u16* scr; u16* MG;
  DEVI bool operator()(f32x4 (&acc)[2][2][4][2], const g8::Unit& u, int wr, int wc, int fr, int fq) const {
    const int i = u.aux;
    const bool last = (i == 3);
    const int gbo = last ? 0 : 65536;
    const u16* g0 = scr + i * 65536 + (wr * 64 + fr) * 256 + wc * 32 + fq * 8;
    u16* o0 = MG + (size_t)(u.pm * 256 + wr * 64 + fr) * 1024 + u.pn * 256 + wc * 32 + fq * 8;
#pragma unroll
    for (int ai = 0; ai < 2; ++ai) {
      uint4 ga[4][2], gb[4][2];
#pragma unroll
      for (int m = 0; m < 4; ++m) {
        const u16* gr = g0 + (ai * 128 + m * 16) * 256;
#pragma unroll
        for (int bj = 0; bj < 2; ++bj) {
          ga[m][bj] = *(const uint4*)(gr + bj * 128);
          gb[m][bj] = *(const uint4*)(gr + gbo + bj * 128);
        }
      }
      asm volatile("" ::: "memory");
#pragma unroll
      for (int m = 0; m < 4; ++m) {
        u16* orow = o0 + (size_t)(ai * 128 + m * 16) * 1024;
#pragma unroll
        for (int bj = 0; bj < 2; ++bj) {
          const uint4 a4 = ga[m][bj], b4 = gb[m][bj];
          f32x4 v0 = acc[ai][bj][m][0], v1 = acc[ai][bj][m][1];
          v0[0] *= lo16(a4.x) * (last ? 1.f : fast_rcp(lo16(b4.x)));
          v0[1] *= hi16(a4.x) * (last ? 1.f : fast_rcp(hi16(b4.x)));
          v0[2] *= lo16(a4.y) * (last ? 1.f : fast_rcp(lo16(b4.y)));
          v0[3] *= hi16(a4.y) * (last ? 1.f : fast_rcp(hi16(b4.y)));
          v1[0] *= lo16(a4.z) * (last ? 1.f : fast_rcp(lo16(b4.z)));
          v1[1] *= hi16(a4.z) * (last ? 1.f : fast_rcp(hi16(b4.z)));
          v1[2] *= lo16(a4.w) * (last ? 1.f : fast_rcp(lo16(b4.w)));
          v1[3] *= hi16(a4.w) * (last ? 1.f : fast_rcp(hi16(b4.w)));
          acc[ai][bj][m][0] = v0;
          acc[ai][bj][m][1] = v1;
          if (last) {
            uint4 w;
            w.x = pack2(v0[0], v0[1]); w.y = pack2(v0[2], v0[3]); w.z = pack2(v1[0], v1[1]); w.w = pack2(v1[2], v1[3]);
            *(uint4*)(orow + bj * 128) = w;
          }
        }
      }
      asm volatile("" ::: "memory");
    }
    return last;
  }
};
DEVI void stage_wait(unsigned* cnt);
DEVI void phase_gm(const Params& p, int layer, unsigned char* smem, unsigned* mixers_done) {
  g8::Order tiles;
  tiles.init(M / 256, 4, gridDim.x, obid(), 1024);
  const int bid = obid();
  u16* scr = bid < 80 ? (u16*)(p.ws + OFF_RKT) + (size_t)bid * 4 * 65536
           : (bid < 240 ? (u16*)(p.ws + OFF_U) + (size_t)(bid - 80) * 4 * 65536
                        : (u16*)(p.ws + OFF_END + 65536) + (size_t)(bid - 240) * 4 * 65536);
#pragma unroll 1
  for (int r = 0;; ++r) {
    g8::Unit tu;
    if (!tiles.next(r, tu)) break;
    {
      TileOrder S{tu.pm, tu.pn, true, 0, OFF_WMERGE + (size_t)layer * SZ_WMERGE * 2};
      EpiGateTile e{scr};
      g8::gemm_phase<true>((LAS unsigned char*)smem, hbuf(p), (const u16*)p.ws, 1024, S, e);
    }
    if (r == 0) stage_wait(mixers_done);
    {
      TileOrder S{tu.pm, tu.pn, false, (size_t)M * 1024 * 2, OFF_WBRANCH + (size_t)layer * SZ_WBRANCH * 2};
      EpiMergeTile e{scr, (u16*)(p.ws + OFF_MERGED)};
      g8::gemm_phase<true>((LAS unsigned char*)smem, hbuf(p), (const u16*)p.ws, 1024, S, e);
    }
  }
}

template <bool FIRST>
struct EpiResid {
  u16* xb; const float* mod; int layer, gsel;
  const float* xp; const float* xs;
  DEVI bool operator()(f32x4 (&acc)[2][2][4][2], const g8::Unit& u, int wr, int wc, int fr, int fq) const {
    const int t0 = u.pm * 256;
    int seq, pos0, T;
    tokinfo(t0, seq, pos0, T);
    const float* gp = mod + (size_t)(layer * 18 + seq) * 6144 + gsel * 1024 + u.pn * 256 + wc * 32 + fq * 8;
    float4 g[2][2];
#pragma unroll
    for (int bj = 0; bj < 2; ++bj)
#pragma unroll
      for (int n = 0; n < 2; ++n) g[bj][n] = *(const float4*)(gp + bj * 128 + n * 4);
    const size_t lo = (size_t)(wr * 64 + fr) * 1024 + u.pn * 256 + wc * 32 + fq * 8;
    u16* o0 = xb + (size_t)t0 * 1024 + lo;
    if (FIRST) {
      const float* i0 = (t0 < MP ? xp + (size_t)t0 * 1024 : xs + (size_t)(t0 - MP) * 1024) + lo;
#pragma unroll
      for (int ai = 0; ai < 2; ++ai)
#pragma unroll
        for (int mh = 0; mh < 2; ++mh) {
          float4 x[2][2][2];
#pragma unroll
          for (int m2 = 0; m2 < 2; ++m2)
#pragma unroll
            for (int bj = 0; bj < 2; ++bj) {
              const float* ip = i0 + (size_t)(ai * 128 + (mh * 2 + m2) * 16) * 1024 + bj * 128;
              x[m2][bj][0] = *(const float4*)ip;
              x[m2][bj][1] = *(const float4*)(ip + 4);
            }
          asm volatile("" ::: "memory");
#pragma unroll
          for (int m2 = 0; m2 < 2; ++m2) {
            const int m = mh * 2 + m2;
            u16* rowp = o0 + (size_t)(ai * 128 + m * 16) * 1024;
#pragma unroll
            for (int bj = 0; bj < 2; ++bj) {
              const float4 xa = x[m2][bj][0], xc = x[m2][bj][1];
              const f32x4 v0 = acc[ai][bj][m][0], v1 = acc[ai][bj][m][1];
              uint4 w;
              w.x = pack2(xa.x + g[bj][0].x * v0[0], xa.y + g[bj][0].y * v0[1]);
              w.y = pack2(xa.z + g[bj][0].z * v0[2], xa.w + g[bj][0].w * v0[3]);
              w.z = pack2(xc.x + g[bj][1].x * v1[0], xc.y + g[bj][1].y * v1[1]);
              w.w = pack2(xc.z + g[bj][1].z * v1[2], xc.w + g[bj][1].w * v1[3]);
              *(uint4*)(rowp + bj * 128) = w;
            }
          }
          asm volatile("" ::: "memory");
        }
    } else {
#pragma unroll
      for (int ai = 0; ai < 2; ++ai) {
        uint4 xw[4][2];
#pragma unroll
        for (int m = 0; m < 4; ++m)
#pragma unroll
          for (int bj = 0; bj < 2; ++bj) xw[m][bj] = *(const uint4*)(o0 + (size_t)(ai * 128 + m * 16) * 1024 + bj * 128);
        asm volatile("" ::: "memory");
#pragma unroll
        for (int m = 0; m < 4; ++m) {
          u16* rowp = o0 + (size_t)(ai * 128 + m * 16) * 1024;
#pragma unroll
          for (int bj = 0; bj < 2; ++bj) {
            const uint4 xv = xw[m][bj];
            const f32x4 v0 = acc[ai][bj][m][0], v1 = acc[ai][bj][m][1];
            uint4 w;
            w.x = pack2(lo16(xv.x) + g[bj][0].x * v0[0], hi16(xv.x) + g[bj][0].y * v0[1]);
            w.y = pack2(lo16(xv.y) + g[bj][0].z * v0[2], hi16(xv.y) + g[bj][0].w * v0[3]);
            w.z = pack2(lo16(xv.z) + g[bj][1].x * v1[0], hi16(xv.z) + g[bj][1].y * v1[1]);
            w.w = pack2(lo16(xv.w) + g[bj][1].z * v1[2], hi16(xv.w) + g[bj][1].w * v1[3]);
            *(uint4*)(rowp + bj * 128) = w;
          }
        }
        asm volatile("" ::: "memory");
      }
    }
    return true;
  }
};
DEVI void phase_resid(const Params& p, int layer, const u16* A, int K, const u16* Wt, int gsel, unsigned char* smem) {
  g8::Order S;
  S.init(M / 256, 4, gridDim.x, obid(), K);
  if (layer == 0 && gsel == 2) {
    EpiResid<true> e{xbuf(p), (const float*)(p.ws + OFF_MOD), layer, gsel, p.in[0], p.in[1]};
    g8::gemm_phase<true>((LAS unsigned char*)smem, A, Wt, K, S, e);
  } else {
    EpiResid<false> e{xbuf(p), (const float*)(p.ws + OFF_MOD), layer, gsel, nullptr, nullptr};
    g8::gemm_phase<true>((LAS unsigned char*)smem, A, Wt, K, S, e);
  }
}

struct EpiFF1 {
  u16* HID;
  DEVI bool operator()(f32x4 (&acc)[2][2][4][2], const g8::Unit& u, int wr, int wc, int fr, int fq) const {
    u16* o0 = HID + (size_t)(u.pm * 256 + wr * 64 + fr) * 4096 + u.pn * 256 + wc * 32 + fq * 8;
#pragma unroll
    for (int ai = 0; ai < 2; ++ai)
#pragma unroll
      for (int m = 0; m < 4; ++m) {
        u16* orow = o0 + (size_t)(ai * 128 + m * 16) * 4096;
#pragma unroll
        for (int bj = 0; bj < 2; ++bj) {
          const f32x4 v0 = acc[ai][bj][m][0], v1 = acc[ai][bj][m][1];
          const float a0 = fmaxf(v0[0], 0.f), a1 = fmaxf(v0[1], 0.f), a2 = fmaxf(v0[2], 0.f), a3 = fmaxf(v0[3], 0.f);
          const float b0 = fmaxf(v1[0], 0.f), b1 = fmaxf(v1[1], 0.f), b2 = fmaxf(v1[2], 0.f), b3 = fmaxf(v1[3], 0.f);
          uint4 w;
          w.x = pack2(a0 * a0, a1 * a1); w.y = pack2(a2 * a2, a3 * a3);
          w.z = pack2(b0 * b0, b1 * b1); w.w = pack2(b2 * b2, b3 * b3);
          *(uint4*)(orow + bj * 128) = w;
        }
        asm volatile("" ::: "memory");
      }
    return true;
  }
};
DEVI void phase_ff1(const Params& p, int layer, unsigned char* smem) {
  g8::Order S;
  S.init(M / 256, 16, gridDim.x, obid(), 1024);
  EpiFF1 e{(u16*)(p.ws + OFF_HID)};
  g8::gemm_phase<true>((LAS unsigned char*)smem, hbuf(p), (const u16*)(p.ws + OFF_WFF1) + (size_t)layer * SZ_WFF, 1024, S, e);
}

struct CtrBarrier { unsigned* ctr; unsigned target; };
DEVI void ctr_barrier(CtrBarrier& b) {
  asm volatile("s_waitcnt vmcnt(0)" ::: "memory");
  __syncthreads();
  b.target += gridDim.x;
  if (threadIdx.x == 0) {
    __builtin_amdgcn_fence(__ATOMIC_RELEASE, "agent");
    asm volatile("s_waitcnt vmcnt(0)" ::: "memory");
    __hip_atomic_fetch_add(b.ctr, 1u, __ATOMIC_RELAXED, __HIP_MEMORY_SCOPE_AGENT);
    unsigned spins = 0;
    while (__hip_atomic_load(b.ctr, __ATOMIC_RELAXED, __HIP_MEMORY_SCOPE_AGENT) < b.target) {
      __builtin_amdgcn_s_sleep(1);
      if (++spins > (1u << 22)) break;
    }
    __builtin_amdgcn_fence(__ATOMIC_ACQUIRE, "agent");
    asm volatile("s_waitcnt vmcnt(0)" ::: "memory");
  }
  __syncthreads();
}

DEVI void stage_signal(unsigned* cnt) {
  asm volatile("s_waitcnt vmcnt(0)" ::: "memory");
  __syncthreads();
  if (threadIdx.x == 0) {
    __builtin_amdgcn_fence(__ATOMIC_RELEASE, "agent");
    asm volatile("s_waitcnt vmcnt(0)" ::: "memory");
    __hip_atomic_fetch_add(cnt, 1u, __ATOMIC_RELAXED, __HIP_MEMORY_SCOPE_AGENT);
  }
}
DEVI void stage_wait(unsigned* cnt) {
  __syncthreads();
  if (threadIdx.x == 0) {
    unsigned spins = 0;
    while (__hip_atomic_load(cnt, __ATOMIC_RELAXED, __HIP_MEMORY_SCOPE_AGENT) < gridDim.x) {
      __builtin_amdgcn_s_sleep(1);
      if (++spins > (1u << 22)) break;
    }
    __builtin_amdgcn_fence(__ATOMIC_ACQUIRE, "agent");
    asm volatile("s_waitcnt vmcnt(0)" ::: "memory");
  }
  __syncthreads();
}

#define REP_GATES 1
#define REP_NA 1
#define REP_SWA 1
#define REP_C1 1
#define REP_C2 1
#define REP_C3 1
#define REP_FF1 1
#define REP_G1 1
#define REP_MERGE 1
#ifndef REP_MIX
#define REP_MIX 1
#endif
__global__ void __launch_bounds__(512, 2) trunk_megakernel(Params p) {
  cg::grid_group grid = cg::this_grid();
  __shared__ __attribute__((aligned(16))) unsigned char smem[SMEM_BYTES];
  CtrBarrier cb{(unsigned*)(p.ws + OFF_BAR), 0u};
  if (blockIdx.x == 0 && threadIdx.x < 8) cb.ctr[threadIdx.x * 16] = 0u;

  phase0(p, smem);
  grid.sync();
#pragma unroll 1
  for (int l = 0; l < 2; ++l) {
    phase_norm(p, l, 0);
    ctr_barrier(cb);
#pragma unroll 1
    for (int rep = 0; rep < REP_G1; ++rep) {
    phase_gemm1(p, l, smem);
    ctr_barrier(cb);
    }
    {
      unsigned* cntA = cb.ctr + 16 * (1 + 2 * l), * cntB = cb.ctr + 16 * (2 + 2 * l);
      phase_ret_u(p, l);
      stage_signal(cntA);
      phase_conv(p, l, smem);
      phase_na(p, l, smem);
      stage_wait(cntA);
      phase_ret_scan(p, l);
      stage_signal(cntB);
      phase_swa(p, l, smem);
      stage_wait(cntB);
      phase_ret_out(p, l, smem);
      stage_signal(cb.ctr + 16 * (5 + l));
    }
    phase_gm(p, l, smem, cb.ctr + 16 * (5 + l));
    ctr_barrier(cb);
    phase_resid(p, l, (const u16*)(p.ws + OFF_MERGED), 1024, (const u16*)(p.ws + OFF_WOUT) + (size_t)l * SZ_WOUT, 2, smem);
    ctr_barrier(cb);
    phase_norm(p, l, 1);
    ctr_barrier(cb);
#pragma unroll 1
    for (int rep = 0; rep < REP_FF1; ++rep) {
    phase_ff1(p, l, smem);
    ctr_barrier(cb);
    }
    phase_resid(p, l, (const u16*)(p.ws + OFF_HID), 4096, (const u16*)(p.ws + OFF_WFF2) + (size_t)l * SZ_WFF, 5, smem);
    ctr_barrier(cb);
  }
  phase_final(p);
}

extern "C" void kernel_launch(void* const* d_in, const int* in_sizes, int n_in, void* d_out, int out_size, void* d_ws,
                              size_t ws_size, hipStream_t stream) {
  static int grid_blocks = 0;
  if (!grid_blocks) {
    int dev = 0, cus = 0, per_cu = 0;
    (void)hipGetDevice(&dev);
    (void)hipDeviceGetAttribute(&cus, hipDeviceAttributeMultiprocessorCount, dev);
    (void)hipOccupancyMaxActiveBlocksPerMultiprocessor(&per_cu, trunk_megakernel, NTHR, 0);
    if (per_cu > 1) per_cu = 1;
    grid_blocks = (cus * per_cu / 8) * 8;
  }
  Params p{};
  for (int i = 0; i < 23; ++i) p.in[i] = (const float*)d_in[i];
  p.out = (float*)d_out;
  p.ws = (unsigned char*)d_ws;
  if (ws_size < WS_NEED) fprintf(stderr, "workspace too small: %zu < %zu\n", ws_size, (size_t)WS_NEED);
  void* args[] = {&p};
  hipError_t e = hipLaunchCooperativeKernel((void*)trunk_megakernel, dim3(grid_blocks), dim3(NTHR), args, 0, stream);
  if (e != hipSuccess) fprintf(stderr, "cooperative launch failed: %s (grid %d)\n", hipGetErrorString(e), grid_blocks);
}
```

```cpp
#include <hip/hip_runtime.h>
#include <hip/hip_cooperative_groups.h>
#include <cstdio>
namespace cg = cooperative_groups;

typedef unsigned short u16;
typedef short bf16x8 __attribute__((ext_vector_type(8)));
typedef float f32x4 __attribute__((ext_vector_type(4)));
#define DEVI __device__ __forceinline__

constexpr int M = 81920;
constexpr int MP = 65536;
constexpr int SMEM_BYTES = 131072;
constexpr int NTHR = 512;
constexpr int MH = M;

struct Params {
  const float* in[23];
  float* out;
  unsigned char* ws;
};

constexpr size_t SZ_WIN = 3072ull * 1024, SZ_WMERGE = 4ull * 1024 * 1024, SZ_WBRANCH = 4ull * 1024 * 256,
                 SZ_WOUT = 1024ull * 1024, SZ_WFF = 4096ull * 1024;
constexpr size_t OFF_WIN = 0;
constexpr size_t OFF_WMERGE = OFF_WIN + 2 * SZ_WIN * 2;
constexpr size_t OFF_WBRANCH = OFF_WMERGE + 2 * SZ_WMERGE * 2;
constexpr size_t OFF_WOUT = OFF_WBRANCH + 2 * SZ_WBRANCH * 2;
constexpr size_t OFF_WFF1 = OFF_WOUT + 2 * SZ_WOUT * 2;
constexpr size_t OFF_WFF2 = OFF_WFF1 + 2 * SZ_WFF * 2;
constexpr size_t OFF_MOD = OFF_WFF2 + 2 * SZ_WFF * 2;
constexpr size_t OFF_ROPE = OFF_MOD + 2ull * 18 * 6144 * 4;
constexpr size_t OFF_H = OFF_ROPE + 8192ull * 64 * 4;
constexpr size_t OFF_X = OFF_H + (size_t)M * 1024 * 2;
constexpr size_t C256 = (size_t)M * 256 * 2, C128 = (size_t)M * 128 * 2;
constexpr size_t OFF_RQ = OFF_X;
constexpr size_t OFF_RK = OFF_RQ + C256;
constexpr size_t OFF_RKT = OFF_RK + C256;
constexpr size_t OFF_RVT = OFF_RKT + C256;
constexpr size_t OFF_RG = OFF_RVT + C256;
constexpr size_t OFF_CA = OFF_RG + C256;
constexpr size_t OFF_CB = OFF_CA + C256;
constexpr size_t OFF_NQ = OFF_CB + C256;
constexpr size_t OFF_NK = OFF_NQ + C256;
constexpr size_t OFF_NVT = OFF_NK + C256;
constexpr size_t OFF_SQ = OFF_NVT + C256;
constexpr size_t OFF_SK = OFF_SQ + C256;
constexpr size_t OFF_SVT = OFF_SK + C128;
constexpr size_t OFF_U = OFF_SVT + C128;
constexpr size_t OFF_R = OFF_U + 2560ull * 2 * 4096 * 4;
constexpr size_t OFF_BR = OFF_R + 2560ull * 2 * 4096 * 2;
constexpr size_t OFF_END = OFF_BR + (size_t)M * 1024 * 2;
constexpr size_t OFF_BAR = OFF_END;
constexpr size_t WS_NEED = OFF_END + 65536 + 16ull * 524288;
static_assert(WS_NEED <= (1ull << 30), "fits the guaranteed 1 GiB workspace");
static_assert(C256 == 80ull * 524288 && 2560ull * 2 * 4096 * 4 == 160ull * 524288, "gate scratch slots");
constexpr size_t OFF_MERGED = OFF_BR;
constexpr size_t OFF_GSCR = OFF_X;
constexpr size_t OFF_GATES = OFF_X;
static_assert(OFF_GATES + (size_t)MH * 4096 * 2 <= OFF_END, "gates fit");
constexpr size_t OFF_HID = OFF_X;
static_assert(OFF_HID + (size_t)M * 4096 * 2 <= OFF_END, "hid fits");

DEVI u16 f2bf(float f) {
  unsigned u = __float_as_uint(f);
  u += 0x7fffu + ((u >> 16) & 1u);
  return (u16)(u >> 16);
}
DEVI float bf2f(u16 h) { return __uint_as_float(((unsigned)h) << 16); }
typedef __bf16 bf16x2_t __attribute__((ext_vector_type(2)));
typedef float f32x2_t __attribute__((ext_vector_type(2)));
DEVI unsigned pack2(float a, float b) {
  f32x2_t v = {a, b};
  bf16x2_t r = __builtin_convertvector(v, bf16x2_t);
  return __builtin_bit_cast(unsigned, r);
}
DEVI uint2 pack4(float a, float b, float c, float d) { return make_uint2(pack2(a, b), pack2(c, d)); }
DEVI float lo16(unsigned u) { return __uint_as_float(u << 16); }
DEVI float hi16(unsigned u) { return __uint_as_float(u & 0xffff0000u); }
union V8 { bf16x8 v; uint4 u; uint2 h[2]; };
DEVI f32x4 mfma16(bf16x8 a, bf16x8 b, f32x4 c) { return __builtin_amdgcn_mfma_f32_16x16x32_bf16(a, b, c, 0, 0, 0); }
DEVI float wave_sum(float v) {
#pragma unroll
  for (int o = 32; o; o >>= 1) v += __shfl_xor(v, o);
  return v;
}
DEVI float fast_rcp(float x) { return __builtin_amdgcn_rcpf(x); }
DEVI float fast_exp(float x) { return __builtin_amdgcn_exp2f(x * 1.4426950408889634f); }
DEVI float sigmoidf_(float x) { return fast_rcp(1.f + fast_exp(-x)); }
DEVI void tokinfo(int tok, int& seq, int& pos, int& T) {
  if (tok < MP) { seq = tok >> 12; pos = tok & 4095; T = 4096; }
  else { int u = tok - MP; seq = 16 + (u >> 13); pos = u & 8191; T = 8192; }
}
DEVI float log_sigmoid(float x) { return -log1pf(expf(-x)); }

DEVI int otid() { int t = threadIdx.x; asm volatile("" : "+v"(t)); return t; }
DEVI int obid() { int t = blockIdx.x; asm volatile("" : "+s"(t)); return t; }
DEVI u16* hbuf(const Params& p) { return (u16*)p.out; }
DEVI u16* brbuf(const Params& p) { return (u16*)p.out + (size_t)M * 1024; }
DEVI u16* xbuf(const Params& p) { return (u16*)(p.ws + OFF_H); }
template <int MI, int NI>
DEVI void gemm_mainloop(const u16* __restrict__ X, int ldx, const u16* __restrict__ Y, int ldy, int K,
                        f32x4 (&acc)[MI][NI], u16* smem) {
  constexpr int XR = MI * 32, YR = NI * 64, LD = 72;
  constexpr int XP = XR / 64, YP = YR / 64;
  u16* sX = smem;
  u16* sY = smem + 2 * XR * LD;
  const int tid = otid(), lane = tid & 63, wid = tid >> 6, wr = wid >> 2, wc = wid & 3, fr = lane & 15,
            fq = lane >> 4;
  const int lrow = tid >> 3, lch = tid & 7;
  uint4 rx[XP], ry[YP];
  const u16* xp = X + (size_t)lrow * ldx + lch * 8;
  const u16* yp = Y + (size_t)lrow * ldy + lch * 8;
#pragma unroll
  for (int i = 0; i < XP; ++i) rx[i] = *(const uint4*)(xp + (size_t)i * 64 * ldx);
#pragma unroll
  for (int i = 0; i < YP; ++i) ry[i] = *(const uint4*)(yp + (size_t)i * 64 * ldy);
#pragma unroll
  for (int i = 0; i < XP; ++i) *(uint4*)(sX + (lrow + i * 64) * LD + lch * 8) = rx[i];
#pragma unroll
  for (int i = 0; i < YP; ++i) *(uint4*)(sY + (lrow + i * 64) * LD + lch * 8) = ry[i];
  __syncthreads();
  const int nk = K >> 6;
  for (int kt = 0; kt < nk; ++kt) {
    const int cur = kt & 1;
    const bool more = (kt + 1 < nk);
    if (more) {
#pragma unroll
      for (int i = 0; i < XP; ++i) rx[i] = *(const uint4*)(xp + (size_t)i * 64 * ldx + (kt + 1) * 64);
#pragma unroll
      for (int i = 0; i < YP; ++i) ry[i] = *(const uint4*)(yp + (size_t)i * 64 * ldy + (kt + 1) * 64);
    }
    const u16* cx = sX + cur * XR * LD + (wr * MI * 16 + fr) * LD + fq * 8;
    const u16* cy = sY + cur * YR * LD + (wc * NI * 16 + fr) * LD + fq * 8;
#pragma unroll
    for (int ks = 0; ks < 2; ++ks) {
      bf16x8 a[MI], b[NI];
#pragma unroll
      for (int mi = 0; mi < MI; ++mi) a[mi] = *(const bf16x8*)(cx + mi * 16 * LD + ks * 32);
#pragma unroll
      for (int ni = 0; ni < NI; ++ni) b[ni] = *(const bf16x8*)(cy + ni * 16 * LD + ks * 32);
#pragma unroll
      for (int mi = 0; mi < MI; ++mi)
#pragma unroll
        for (int ni = 0; ni < NI; ++ni) acc[mi][ni] = mfma16(a[mi], b[ni], acc[mi][ni]);
    }
    if (more) {
      u16* dx = sX + (cur ^ 1) * XR * LD;
      u16* dy = sY + (cur ^ 1) * YR * LD;
#pragma unroll
      for (int i = 0; i < XP; ++i) *(uint4*)(dx + (lrow + i * 64) * LD + lch * 8) = rx[i];
#pragma unroll
      for (int i = 0; i < YP; ++i) *(uint4*)(dy + (lrow + i * 64) * LD + lch * 8) = ry[i];
    }
    __syncthreads();
  }
}

#define LAS __attribute__((address_space(3)))
namespace g8 {
constexpr int BM = 256, BK = 64, HALF = 128, HTB = HALF * BK * 2, NXCD = 8, WGM = 8;
DEVI int lds_byte(int r, int c) {
  const int st = (r >> 4) * 2 + (c >> 5), rr = r & 15, cc = c & 31, ob = rr * 64 + cc * 2;
  return st * 1024 + (ob ^ (((ob >> 9) & 1) << 5));
}
DEVI void stage_rc(int b, int& R, int& C) {
  const int st = b / 1024, sb = b % 1024, swz = sb ^ (((sb >> 9) & 1) << 5);
  R = (st >> 1) * 16 + swz / 64;
  C = (st & 1) * 32 + (swz % 64) / 2;
}
struct Unit { int pm, pn, aux, nt; size_t aoff, boff; };
struct Order {
  int nM, nN, nwg, G, c, K;
  DEVI void init(int nM_, int nN_, int G_, int c_, int K_ = 1024) { nM = nM_; nN = nN_; nwg = nM * nN; G = G_; c = c_; K = K_; }
  DEVI bool next(int i, Unit& u) const {
    const long L = (long)i * G + c;
    if (L >= nwg) return false;
    int wgid = (int)L;
    {
      const int q = nwg / NXCD, r = nwg % NXCD, xcd = wgid % NXCD, off = wgid / NXCD;
      wgid = (xcd < r ? xcd * (q + 1) : r * (q + 1) + (xcd - r) * q) + off;
    }
    const int nig = WGM * nN, gid = wgid / nig, fm = gid * WGM, gsz = (nM - fm) < WGM ? (nM - fm) : WGM;
    u.pm = fm + ((wgid % nig) % gsz);
    u.pn = (wgid % nig) / gsz;
    u.aux = 0;
    u.nt = K >> 6;
    u.aoff = (size_t)u.pm * 512 * K;
    u.boff = (size_t)u.pn * 512 * K;
    return true;
  }
};

DEVI int perm32(int rho) { const int n = rho >> 4, i = rho & 15; return 8 * (i >> 2) + 4 * n + (i & 3); }
template <bool PERM, class Epi, class Sched>
DEVI void gemm_phase(LAS unsigned char* lds, const u16* gA, const u16* gBt, const int K, const Sched& S, const Epi& E) {
  const int tid = otid(), wid = __builtin_amdgcn_readfirstlane(tid >> 6), lane = tid & 63, wr = wid >> 2, wc = wid & 3,
            fr = lane & 15, fq = lane >> 4;
  unsigned voffA[2], voffB[2];
#pragma unroll
  for (int i = 0; i < 2; ++i) {
    int R, C;
    stage_rc(tid * 16 + i * 8192, R, C);
    voffA[i] = (unsigned)(R * K + C) * 2u;
    const int Rb = PERM ? ((R & ~31) + perm32(R & 31)) : R;
    voffB[i] = (unsigned)(Rb * K + C) * 2u;
  }
  const size_t kstep = (size_t)(BK * 2);
  const size_t hstep = (size_t)HALF * K * 2;
  const unsigned ldsw = (unsigned)wid * 1024u;
  const int aoff = lds_byte(wr * 64 + fr, fq * 8), boff = lds_byte(wc * 32 + fr, fq * 8);
#define G8_SA(b, h) (((b) * 2 + (h)) * HTB)
#define G8_SB(b, h) ((4 + (b) * 2 + (h)) * HTB)
#define G8_STAGEV(bufoff, gbase, voff) do { _Pragma("unroll") for (int _i = 0; _i < 2; ++_i) \
    __builtin_amdgcn_global_load_lds((const unsigned*)((const char*)(gbase) + (voff)[_i]), (LAS unsigned*)(lds + (bufoff) + ldsw + _i * 8192), 16, 0, 0); } while (0)
#define G8_LDA(dst, b, h) do { _Pragma("unroll") for (int m = 0; m < 4; ++m) _Pragma("unroll") for (int k = 0; k < 2; ++k) dst[m][k] = *(const LAS bf16x8*)(lds + G8_SA(b, h) + aoff + m * 2048 + k * 1024); } while (0)
#define G8_LDB(dst, b, h) do { _Pragma("unroll") for (int n = 0; n < 2; ++n) _Pragma("unroll") for (int k = 0; k < 2; ++k) dst[n][k] = *(const LAS bf16x8*)(lds + G8_SB(b, h) + boff + n * 2048 + k * 1024); } while (0)
#define G8_MMA(ai, bj, At, Bt) do { __builtin_amdgcn_s_setprio(1); _Pragma("unroll") for (int m = 0; m < 4; ++m) _Pragma("unroll") for (int n = 0; n < 2; ++n) _Pragma("unroll") for (int k = 0; k < 2; ++k) \
    acc[ai][bj][m][n] = __builtin_amdgcn_mfma_f32_16x16x32_bf16(Bt[n][k], At[m][k], acc[ai][bj][m][n], 0, 0, 0); __builtin_amdgcn_s_setprio(0); } while (0)
#define G8_WAIT_V(n) asm volatile("s_waitcnt vmcnt(" #n ")" ::: "memory")
#define G8_WAIT_L(n) asm volatile("s_waitcnt lgkmcnt(" #n ")" ::: "memory")
#define G8_BAR __builtin_amdgcn_s_barrier()
#define G8_SCHED __builtin_amdgcn_sched_barrier(0)
  Unit cur, nxt;
  int ui = 0;
  if (!S.next(0, cur)) return;
  f32x4 acc[2][2][4][2];
#pragma unroll
  for (int a = 0; a < 2; ++a)
#pragma unroll
    for (int b = 0; b < 2; ++b)
#pragma unroll
      for (int m = 0; m < 4; ++m)
#pragma unroll
        for (int n = 0; n < 2; ++n) acc[a][b][m][n] = f32x4{0.f, 0.f, 0.f, 0.f};
  bf16x8 At[4][2], B0[2][2], B1[2][2];
  const char* cA = (const char*)gA + cur.aoff;
  const char* cB = (const char*)gBt + cur.boff;
  G8_STAGEV(G8_SB(0, 0), cB, voffB); G8_STAGEV(G8_SA(0, 0), cA, voffA); G8_STAGEV(G8_SB(0, 1), cB + hstep, voffB); G8_STAGEV(G8_SA(0, 1), cA + hstep, voffA);
  if (wr == 1) G8_BAR;
  G8_WAIT_V(4); G8_BAR;
  G8_STAGEV(G8_SB(1, 0), cB + kstep, voffB); G8_STAGEV(G8_SA(1, 0), cA + kstep, voffA); G8_STAGEV(G8_SB(1, 1), cB + hstep + kstep, voffB);
  G8_WAIT_V(6); G8_BAR;
  for (;;) {
    const bool has_next = S.next(ui + 1, nxt);
    const char* nA = has_next ? (const char*)gA + nxt.aoff : cA;
    const char* nB = has_next ? (const char*)gBt + nxt.boff : cB;
    const int nt = cur.nt;
    for (int t = 0; t < nt; t += 2) {
      const bool last = (t == nt - 2);
      const char* a1 = cA + (size_t)(t + 1) * kstep;
      const char* a2 = last ? nA : cA + (size_t)(t + 2) * kstep;
      const char* b2 = last ? nB : cB + (size_t)(t + 2) * kstep;
      const char* a3 = a2 + kstep;
      const char* b3 = b2 + kstep;
      G8_LDB(B0, 0, 0); G8_SCHED; G8_LDA(At, 0, 0); G8_STAGEV(G8_SA(1, 1), a1 + hstep, voffA);
      G8_WAIT_L(8); G8_BAR; G8_WAIT_L(0); G8_MMA(0, 0, At, B0); G8_BAR; G8_SCHED;
      G8_LDB(B1, 0, 1); G8_STAGEV(G8_SB(0, 0), b2, voffB);
      G8_BAR; G8_WAIT_L(0); G8_MMA(0, 1, At, B1); G8_BAR;
      G8_LDA(At, 0, 1); G8_STAGEV(G8_SA(0, 0), a2, voffA);
      G8_BAR; G8_WAIT_L(0); G8_MMA(1, 0, At, B0); G8_BAR; G8_SCHED;
      G8_STAGEV(G8_SB(0, 1), b2 + hstep, voffB);
      G8_WAIT_V(6); G8_BAR; G8_MMA(1, 1, At, B1); G8_BAR;
      G8_LDB(B0, 1, 0); G8_SCHED; G8_LDA(At, 1, 0); G8_STAGEV(G8_SA(0, 1), a2 + hstep, voffA);
      G8_WAIT_L(8); G8_BAR; G8_WAIT_L(0); G8_MMA(0, 0, At, B0); G8_BAR; G8_SCHED;
      G8_LDB(B1, 1, 1); G8_STAGEV(G8_SB(1, 0), b3, voffB);
      G8_BAR; G8_WAIT_L(0); G8_MMA(0, 1, At, B1); G8_BAR;
      G8_LDA(At, 1, 1); G8_STAGEV(G8_SA(1, 0), a3, voffA);
      G8_BAR; G8_WAIT_L(0); G8_MMA(1, 0, At, B0); G8_BAR; G8_SCHED;
      G8_STAGEV(G8_SB(1, 1), b3 + hstep, voffB);
      G8_WAIT_V(6); G8_BAR; G8_MMA(1, 1, At, B1); G8_BAR;
    }
    const bool zr = E(acc, cur, wr, wc, fr, fq);
    if (!has_next) break;
    if (zr)
#pragma unroll
    for (int a = 0; a < 2; ++a)
#pragma unroll
      for (int b = 0; b < 2; ++b)
#pragma unroll
        for (int m = 0; m < 4; ++m)
#pragma unroll
          for (int n = 0; n < 2; ++n) acc[a][b][m][n] = f32x4{0.f, 0.f, 0.f, 0.f};
    cur = nxt; cA = nA; cB = nB; ++ui;
  }
  G8_WAIT_V(0);
  if (wr == 0) G8_BAR;
  G8_BAR;
#undef G8_SA
#undef G8_SB
#undef G8_STAGEV
#undef G8_LDA
#undef G8_LDB
#undef G8_MMA
#undef G8_WAIT_V
#undef G8_WAIT_L
#undef G8_BAR
#undef G8_SCHED
}
}

template <int MI, int NI>
DEVI void zero_acc(f32x4 (&acc)[MI][NI]) {
#pragma unroll
  for (int mi = 0; mi < MI; ++mi)
#pragma unroll
    for (int ni = 0; ni < NI; ++ni) acc[mi][ni] = f32x4{0.f, 0.f, 0.f, 0.f};
}

DEVI void mod_item(const Params& p, int item, float* smf) {
  const int l = item / 192, n0 = (item % 192) * 32;
  const int tid = otid();
  for (int i = tid; i < 18 * 1024; i += NTHR) {
    int s = i >> 10, k = i & 1023;
    float c = s < 16 ? p.in[2][s * 1024 + k] : p.in[3][(s - 16) * 1024 + k];
    smf[i] = c / (1.f + expf(-c));
  }
  __syncthreads();
  const int ks = tid >> 5, col = tid & 31;
  float acc[18];
#pragma unroll
  for (int s = 0; s < 18; ++s) acc[s] = 0.f;
  const float* w = p.in[4] + ((size_t)l * 1024 + ks * 64) * 6144 + n0 + col;
#pragma unroll 4
  for (int k = 0; k < 64; ++k) {
    float wv = w[(size_t)k * 6144];
#pragma unroll
    for (int s = 0; s < 18; ++s) acc[s] += smf[s * 1024 + ks * 64 + k] * wv;
  }
  __syncthreads();
#pragma unroll
  for (int s = 0; s < 18; ++s) smf[(ks * 18 + s) * 32 + col] = acc[s];
  __syncthreads();
  float* mod = (float*)(p.ws + OFF_MOD);
  for (int i = tid; i < 18 * 32; i += NTHR) {
    int s = i >> 5, c = i & 31;
    float v = p.in[5][l * 6144 + n0 + c];
#pragma unroll
    for (int k2 = 0; k2 < 16; ++k2) v += smf[(k2 * 18 + s) * 32 + c];
    mod[(size_t)(l * 18 + s) * 6144 + n0 + c] = v;
  }
  __syncthreads();
}

DEVI void rope_table(const Params& p) {
  float* rope = (float*)(p.ws + OFF_ROPE);
  const int g0 = obid() * NTHR + otid(), gs = gridDim.x * NTHR;
  for (int g = g0; g < 8192 * 32; g += gs) {
    int pos = g >> 5, i = g & 31;
    float inv = (float)pow(10000.0, -(double)i / 32.0);
    float angf = (float)pos * inv;
    double x = (double)angf;
    const double TWO_PI = 6.283185307179586476925286766559;
    const double PI = 3.14159265358979323846264338327950288;
    double n = rint(x / TWO_PI);
    double r = x - n * TWO_PI;
    double cs = 1.0;
    if (r > 0.5 * PI) { r = PI - r; cs = -1.0; }
    else if (r < -0.5 * PI) { r = -PI - r; cs = -1.0; }
    double r2 = r * r;
    double sp = 1.0 / 51090942171709440000.0;
    sp = sp * r2 - 1.0 / 121645100408832000.0;
    sp = sp * r2 + 1.0 / 355687428096000.0;
    sp = sp * r2 - 1.0 / 1307674368000.0;
    sp = sp * r2 + 1.0 / 6227020800.0;
    sp = sp * r2 - 1.0 / 39916800.0;
    sp = sp * r2 + 1.0 / 362880.0;
    sp = sp * r2 - 1.0 / 5040.0;
    sp = sp * r2 + 1.0 / 120.0;
    sp = sp * r2 - 1.0 / 6.0;
    sp = sp * r2 + 1.0;
    double sn = sp * r;
    double cp = 1.0 / 2432902008176640000.0;
    cp = cp * r2 - 1.0 / 6402373705728000.0;
    cp = cp * r2 + 1.0 / 20922789888000.0;
    cp = cp * r2 - 1.0 / 87178291200.0;
    cp = cp * r2 + 1.0 / 479001600.0;
    cp = cp * r2 - 1.0 / 3628800.0;
    cp = cp * r2 + 1.0 / 40320.0;
    cp = cp * r2 - 1.0 / 720.0;
    cp = cp * r2 + 1.0 / 24.0;
    cp = cp * r2 - 0.5;
    cp = cp * r2 + 1.0;
    rope[pos * 64 + i] = (float)(cs * cp);
    rope[pos * 64 + 32 + i] = (float)sn;
  }
}

struct MapPlain { DEVI void operator()(int db, int& srcc, bool& perm) const { srcc = db * 64; perm = false; } };
struct MapWin {
  DEVI void operator()(int db, int& srcc, bool& perm) const {
    if (db < 32) {
      const int tile = db >> 2, b = db & 3;
      const int base = tile < 2 ? tile * 256 : (tile < 7 ? (tile + 1) * 256 : (tile + 2) * 256);
      srcc = base + b * 64;
      perm = tile < 2;
    } else {
      const int d2 = db - 32, tile = d2 >> 2, b = d2 & 3;
      if (tile == 0) srcc = 512 + b * 64;
      else if (tile == 1) srcc = 2048 + b * 64;
      else if (tile == 2) srcc = 256 + b * 64;
      else srcc = b < 2 ? 2688 + b * 64 : 2560 + (b - 2) * 64;
      perm = false;
    }
  }
};
template <class MapF>
DEVI void xpose_convert(const float* __restrict__ src, int K, int N, int NB, u16* __restrict__ dst, int rot, float* smf, MapF map, int DK = 0, int koff = 0) {
  if (DK == 0) DK = K;
  const int tid = otid();
  const int ntile = (K >> 6) * NB;
  const int G = gridDim.x;
  int start = (int)obid() - (rot % G);
  if (start < 0) start += G;
  for (int t = start; t < ntile; t += G) {
    const int k0 = (t / NB) << 6, db = t % NB;
    int srcc; bool perm;
    map(db, srcc, perm);
    {
      const int ch = tid & 15, kr = tid >> 4;
#pragma unroll
      for (int ps = 0; ps < 2; ++ps) {
        int k = ps * 32 + kr;
        float4 v = *(const float4*)(src + (size_t)(k0 + k) * N + srcc + ch * 4);
        float* d = smf + k * 65 + ch * 4;
        d[0] = v.x; d[1] = v.y; d[2] = v.z; d[3] = v.w;
      }
    }
    __syncthreads();
    {
      const int kc = tid & 7, n = tid >> 3;
      const int nc = perm ? ((n >> 5) * 16 + (n & 15) + ((n >> 4) & 1) * 32) : n;
      const float* sp = smf + (kc * 8) * 65 + nc;
      uint4 o;
      o.x = pack2(sp[0], sp[65]);
      o.y = pack2(sp[2 * 65], sp[3 * 65]);
      o.z = pack2(sp[4 * 65], sp[5 * 65]);
      o.w = pack2(sp[6 * 65], sp[7 * 65]);
      *(uint4*)(dst + (size_t)(db * 64 + n) * DK + koff + k0 + kc * 8) = o;
    }
    __syncthreads();
  }
}

DEVI void phase0(const Params& p, unsigned char* smem) {
  float* smf = (float*)smem;
  for (int it = obid(); it < 384; it += gridDim.x) mod_item(p, it, smf);
  rope_table(p);
  int rot = 384;
  for (int l = 0; l < 2; ++l) {
    xpose_convert(p.in[7] + (size_t)l * 2816 * 1024, 1024, 2816, 48, (u16*)(p.ws + OFF_WIN) + (size_t)l * SZ_WIN, rot, smf, MapWin());
    rot += 768;
    for (int i = 0; i < 4; ++i) {
      xpose_convert(p.in[18] + ((size_t)l * 4 + i) * 1024 * 1024, 1024, 1024, 16,
                    (u16*)(p.ws + OFF_WMERGE) + ((size_t)l * 4 + i) * 1024 * 1024, rot, smf, MapPlain());
      rot += 256;
    }
    for (int i = 0; i < 4; ++i) {
      xpose_convert(p.in[17] + ((size_t)l * 4 + i) * 256 * 1024, 256, 1024, 16,
                    (u16*)(p.ws + OFF_WBRANCH) + (size_t)l * SZ_WBRANCH, rot, smf, MapPlain(), 1024, i * 256);
      rot += 64;
    }
    xpose_convert(p.in[19] + (size_t)l * SZ_WOUT, 1024, 1024, 16, (u16*)(p.ws + OFF_WOUT) + (size_t)l * SZ_WOUT, rot, smf, MapPlain());
    rot += 256;
    xpose_convert(p.in[20] + (size_t)l * SZ_WFF, 1024, 4096, 64, (u16*)(p.ws + OFF_WFF1) + (size_t)l * SZ_WFF, rot, smf, MapPlain());
    rot += 1024;
    xpose_convert(p.in[21] + (size_t)l * SZ_WFF, 4096, 1024, 16, (u16*)(p.ws + OFF_WFF2) + (size_t)l * SZ_WFF, rot, smf, MapPlain());
    rot += 1024;
  }
}

DEVI void phase_norm(const Params& p, int layer, int which) {
  const int lane = otid() & 63, wid = otid() >> 6;
  const float* mod = (const float*)(p.ws + OFF_MOD);
  u16* H = hbuf(p);
  const u16* XB = xbuf(p);
  const float* gain = p.in[6] + (layer * 2 + which) * 1024;
  const bool first = (layer == 0 && which == 0);
  float4 g[4];
#pragma unroll
  for (int i = 0; i < 2; ++i) {
    g[2 * i] = *(const float4*)(gain + i * 512 + lane * 8);
    g[2 * i + 1] = *(const float4*)(gain + i * 512 + lane * 8 + 4);
  }
  for (int tp = obid() * 8 + wid; tp < M / 2; tp += gridDim.x * 8) {
    const int tok = tp * 2;
    int seq, pos, T;
    tokinfo(tok, seq, pos, T);
    float4 v[2][4];
    if (first) {
      const float* xr = tok < MP ? p.in[0] + (size_t)tok * 1024 : p.in[1] + (size_t)(tok - MP) * 1024;
#pragma unroll
      for (int k = 0; k < 2; ++k)
#pragma unroll
        for (int i = 0; i < 2; ++i) {
          v[k][2 * i] = *(const float4*)(xr + k * 1024 + i * 512 + lane * 8);
          v[k][2 * i + 1] = *(const float4*)(xr + k * 1024 + i * 512 + lane * 8 + 4);
        }
    } else {
      const u16* xr = XB + (size_t)tok * 1024;
#pragma unroll
      for (int k = 0; k < 2; ++k)
#pragma unroll
        for (int i = 0; i < 2; ++i) {
          const uint4 w = *(const uint4*)(xr + k * 1024 + i * 512 + lane * 8);
          v[k][2 * i] = make_float4(lo16(w.x), hi16(w.x), lo16(w.y), hi16(w.y));
          v[k][2 * i + 1] = make_float4(lo16(w.z), hi16(w.z), lo16(w.w), hi16(w.w));
        }
    }
    const float* msh = mod + (size_t)(layer * 18 + seq) * 6144 + (which ? 3 : 0) * 1024;
    const float* msc = msh + 1024;
    float4 sh[4], sc[4];
#pragma unroll
    for (int i = 0; i < 2; ++i) {
      const int c = i * 512 + lane * 8;
      sh[2 * i] = *(const float4*)(msh + c); sh[2 * i + 1] = *(const float4*)(msh + c + 4);
      sc[2 * i] = *(const float4*)(msc + c); sc[2 * i + 1] = *(const float4*)(msc + c + 4);
    }
    asm volatile("" ::: "memory");
    float ss0 = 0.f, ss1 = 0.f;
#pragma unroll
    for (int i = 0; i < 4; ++i) {
      ss0 += v[0][i].x * v[0][i].x + v[0][i].y * v[0][i].y + v[0][i].z * v[0][i].z + v[0][i].w * v[0][i].w;
      ss1 += v[1][i].x * v[1][i].x + v[1][i].y * v[1][i].y + v[1][i].z * v[1][i].z + v[1][i].w * v[1][i].w;
    }
    ss0 = wave_sum(ss0);
    ss1 = wave_sum(ss1);
    const float rs[2] = {rsqrtf(ss0 * (1.f / 1024.f) + 1e-6f), rsqrtf(ss1 * (1.f / 1024.f) + 1e-6f)};
#pragma unroll
    for (int k = 0; k < 2; ++k)
#pragma unroll
      for (int i = 0; i < 2; ++i) {
        const float rstd = rs[k];
        const float4 xa = v[k][2 * i], xb = v[k][2 * i + 1];
        const float4 ga = g[2 * i], gb = g[2 * i + 1], sa = sc[2 * i], sb2 = sc[2 * i + 1], ha = sh[2 * i], hb = sh[2 * i + 1];
        uint4 w;
        w.x = pack2(xa.x * rstd * ga.x * (1.f + sa.x) + ha.x, xa.y * rstd * ga.y * (1.f + sa.y) + ha.y);
        w.y = pack2(xa.z * rstd * ga.z * (1.f + sa.z) + ha.z, xa.w * rstd * ga.w * (1.f + sa.w) + ha.w);
        w.z = pack2(xb.x * rstd * gb.x * (1.f + sb2.x) + hb.x, xb.y * rstd * gb.y * (1.f + sb2.y) + hb.y);
        w.w = pack2(xb.z * rstd * gb.z * (1.f + sb2.z) + hb.z, xb.w * rstd * gb.w * (1.f + sb2.w) + hb.w);
        *(uint4*)(H + (size_t)(tok + k) * 1024 + i * 512 + lane * 8) = w;
      }
  }
}

DEVI void phase_final(const Params& p) {
  const int lane = otid() & 63, wid = otid() >> 6;
  const float* gain = p.in[22];
  const u16* XB = xbuf(p);
  float4 gg[4];
#pragma unroll
  for (int i = 0; i < 2; ++i) {
    gg[2 * i] = *(const float4*)(gain + i * 512 + lane * 8);
    gg[2 * i + 1] = *(const float4*)(gain + i * 512 + lane * 8 + 4);
  }
  for (int tp = obid() * 8 + wid; tp < M / 2; tp += gridDim.x * 8) {
    const u16* xr = XB + (size_t)tp * 2048;
    float* orow = p.out + (size_t)tp * 2048;
    float4 v[2][4];
#pragma unroll
    for (int k = 0; k < 2; ++k)
#pragma unroll
      for (int i = 0; i < 2; ++i) {
        const uint4 w = *(const uint4*)(xr + k * 1024 + i * 512 + lane * 8);
        v[k][2 * i] = make_float4(lo16(w.x), hi16(w.x), lo16(w.y), hi16(w.y));
        v[k][2 * i + 1] = make_float4(lo16(w.z), hi16(w.z), lo16(w.w), hi16(w.w));
      }
    asm volatile("" ::: "memory");
    float ss0 = 0.f, ss1 = 0.f;
#pragma unroll
    for (int i = 0; i < 4; ++i) {
      ss0 += v[0][i].x * v[0][i].x + v[0][i].y * v[0][i].y + v[0][i].z * v[0][i].z + v[0][i].w * v[0][i].w;
      ss1 += v[1][i].x * v[1][i].x + v[1][i].y * v[1][i].y + v[1][i].z * v[1][i].z + v[1][i].w * v[1][i].w;
    }
    ss0 = wave_sum(ss0);
    ss1 = wave_sum(ss1);
    const float rs[2] = {rsqrtf(ss0 * (1.f / 1024.f) + 1e-6f), rsqrtf(ss1 * (1.f / 1024.f) + 1e-6f)};
#pragma unroll
    for (int k = 0; k < 2; ++k)
#pragma unroll
      for (int i = 0; i < 4; ++i) {
        const int c = (i >> 1) * 512 + lane * 8 + (i & 1) * 4;
        float4 o;
        o.x = v[k][i].x * rs[k] * gg[i].x; o.y = v[k][i].y * rs[k] * gg[i].y;
        o.z = v[k][i].z * rs[k] * gg[i].z; o.w = v[k][i].w * rs[k] * gg[i].w;
        *(float4*)(orow + k * 1024 + c) = o;
      }
  }
}

struct EpiG1Nat {
  unsigned char* ws;
  DEVI bool operator()(f32x4 (&acc)[2][2][4][2], const g8::Unit& u, int wr, int wc, int fr, int fq) const {
    const int t0 = u.pm * 256, pn = u.pn;
    int seq, pos0, T;
    tokinfo(t0, seq, pos0, T);
    if (pn < 2) {
      const float* rope = (const float*)(ws + OFF_ROPE);
      u16* dst = (u16*)(ws + (pn == 0 ? OFF_RQ : OFF_RK));
      const float scale = pn == 0 ? 0.125f : 1.f;
      const int d1 = (wc & 1) * 16 + fq * 4;
      const float* rp0 = rope + (size_t)(pos0 + wr * 64 + fr) * 64 + d1;
      u16* o0 = dst + (size_t)(t0 + wr * 64 + fr) * 256 + (wc >> 1) * 64 + d1;
#pragma unroll
      for (int ai = 0; ai < 2; ++ai) {
        float4 cc[4], ss[4];
#pragma unroll
        for (int m = 0; m < 4; ++m) {
          const float* rp = rp0 + (ai * 128 + m * 16) * 64;
          cc[m] = *(const float4*)rp;
          ss[m] = *(const float4*)(rp + 32);
        }
        asm volatile("" ::: "memory");
#pragma unroll
        for (int m = 0; m < 4; ++m) {
          const float4 c = cc[m], sn = ss[m];
#pragma unroll
          for (int bj = 0; bj < 2; ++bj) {
            const f32x4 x1 = acc[ai][bj][m][0], x2 = acc[ai][bj][m][1];
            u16* o = o0 + (ai * 128 + m * 16) * 256 + bj * 128;
            *(uint2*)o = pack4((x1[0] * c.x - x2[0] * sn.x) * scale, (x1[1] * c.y - x2[1] * sn.y) * scale,
                               (x1[2] * c.z - x2[2] * sn.z) * scale, (x1[3] * c.w - x2[3] * sn.w) * scale);
            *(uint2*)(o + 32) = pack4((x1[0] * sn.x + x2[0] * c.x) * scale, (x1[1] * sn.y + x2[1] * c.y) * scale,
                                      (x1[2] * sn.z + x2[2] * c.z) * scale, (x1[3] * sn.w + x2[3] * c.w) * scale);
          }
        }
        asm volatile("" ::: "memory");
      }
    } else {
      size_t off; int width = 256, op = 0; float scale = 1.f;
      if (pn == 2) { off = OFF_RG; op = 2; }
      else if (pn == 3) { off = OFF_CA; }
      else if (pn == 4) { off = OFF_CB; op = 3; }
      else if (pn == 5) { off = OFF_NQ; scale = 0.125f; }
      else if (pn == 6) { off = OFF_NK; }
      else if (pn == 7) { off = OFF_SQ; scale = 0.125f; }
      else { off = OFF_SK; width = 128; }
      u16* o0 = (u16*)(ws + off) + (size_t)(t0 + wr * 64 + fr) * width + wc * 32 + fq * 4;
#pragma unroll
      for (int ai = 0; ai < 2; ++ai)
#pragma unroll
        for (int m = 0; m < 4; ++m) {
          u16* orow = o0 + (size_t)((ai * 128 + m * 16) * width);
#pragma unroll
          for (int bj = 0; bj < 2; ++bj) {
            if (pn == 8 && bj == 1) continue;
#pragma unroll
            for (int n = 0; n < 2; ++n) {
              const f32x4 v = acc[ai][bj][m][n];
              float q0, q1, q2, q3;
              if (op == 2) { q0 = v[0] * sigmoidf_(v[0]); q1 = v[1] * sigmoidf_(v[1]); q2 = v[2] * sigmoidf_(v[2]); q3 = v[3] * sigmoidf_(v[3]); }
              else if (op == 3) { q0 = sigmoidf_(v[0]); q1 = sigmoidf_(v[1]); q2 = sigmoidf_(v[2]); q3 = sigmoidf_(v[3]); }
              else { q0 = v[0] * scale; q1 = v[1] * scale; q2 = v[2] * scale; q3 = v[3] * scale; }
              *(uint2*)(orow + bj * 128 + n * 16) = pack4(q0, q1, q2, q3);
            }
          }
          asm volatile("" ::: "memory");
        }
    }
    return true;
  }
};
struct EpiG1Tr {
  unsigned char* ws;
  DEVI bool operator()(f32x4 (&acc)[2][2][4][2], const g8::Unit& u, int wr, int wc, int fr, int fq) const {
    const int pm = u.pm, tb = u.pn * 256;
    int seq, pos0, T;
    tokinfo(tb, seq, pos0, T);
    if (pm == 2) {
      const float* rope = (const float*)(ws + OFF_ROPE);
      u16* dst = (u16*)(ws + OFF_RKT);
      const float* rp0 = rope + (size_t)(pos0 + wc * 32 + fq * 8) * 64 + fr;
      u16* o0 = dst + (size_t)(wr * 64 + fr) * M + tb + wc * 32 + fq * 8;
#pragma unroll
      for (int ai = 0; ai < 2; ++ai)
#pragma unroll
        for (int m = 0; m < 2; ++m) {
          float cv[2][2][4], sv[2][2][4];
#pragma unroll
          for (int bj = 0; bj < 2; ++bj)
#pragma unroll
            for (int n = 0; n < 2; ++n) {
              const float* rp = rp0 + (bj * 128 + n * 4) * 64 + m * 16;
#pragma unroll
              for (int j = 0; j < 4; ++j) { cv[bj][n][j] = rp[j * 64]; sv[bj][n][j] = rp[j * 64 + 32]; }
            }
          asm volatile("" ::: "memory");
#pragma unroll
          for (int bj = 0; bj < 2; ++bj) {
            float o1[2][4], o2[2][4];
#pragma unroll
            for (int n = 0; n < 2; ++n) {
              const f32x4 x1 = acc[ai][bj][m][n], x2 = acc[ai][bj][m + 2][n];
#pragma unroll
              for (int j = 0; j < 4; ++j) {
                const float c = cv[bj][n][j], sn = sv[bj][n][j];
                o1[n][j] = x1[j] * c - x2[j] * sn;
                o2[n][j] = x1[j] * sn + x2[j] * c;
              }
            }
            u16* o = o0 + (size_t)(ai * 128 + m * 16) * M + bj * 128;
            uint4 w1, w2;
            w1.x = pack2(o1[0][0], o1[0][1]); w1.y = pack2(o1[0][2], o1[0][3]); w1.z = pack2(o1[1][0], o1[1][1]); w1.w = pack2(o1[1][2], o1[1][3]);
            w2.x = pack2(o2[0][0], o2[0][1]); w2.y = pack2(o2[0][2], o2[0][3]); w2.z = pack2(o2[1][0], o2[1][1]); w2.w = pack2(o2[1][2], o2[1][3]);
            *(uint4*)o = w1;
            *(uint4*)(o + (size_t)32 * M) = w2;
          }
          asm volatile("" ::: "memory");
        }
    } else {
      u16* dst = (u16*)(ws + (pm == 0 ? OFF_RVT : (pm == 1 ? OFF_NVT : OFF_SVT)));
      u16* o0 = dst + (size_t)(wr * 64 + fr) * M + tb + wc * 32 + fq * 8;
      const long half1 = pm == 3 ? ((long)(OFF_SK - OFF_SVT) / 2 - (long)128 * M) : 0;
#pragma unroll
      for (int ai = 0; ai < 2; ++ai) {
#pragma unroll
        for (int m = 0; m < 4; ++m) {
          u16* orow = o0 + (size_t)(ai * 128 + m * 16) * M + (ai ? half1 : 0);
#pragma unroll
          for (int bj = 0; bj < 2; ++bj) {
            const f32x4 v0 = acc[ai][bj][m][0], v1 = acc[ai][bj][m][1];
            uint4 w;
            w.x = pack2(v0[0], v0[1]); w.y = pack2(v0[2], v0[3]); w.z = pack2(v1[0], v1[1]); w.w = pack2(v1[2], v1[3]);
            *(uint4*)(orow + bj * 128) = w;
          }
          asm volatile("" ::: "memory");
        }
      }
    }
    return true;
  }
};
DEVI void phase_gemm1(const Params& p, int layer, unsigned char* smem) {
  const u16* H = hbuf(p);
  const u16* W = (const u16*)(p.ws + OFF_WIN) + (size_t)layer * SZ_WIN;
  g8::Order S;
  S.init(M / 256, 8, gridDim.x, obid(), 1024);
  EpiG1Nat e1{p.ws};
  g8::gemm_phase<false>((LAS unsigned char*)smem, H, W, 1024, S, e1);
  g8::Order S2;
  S2.init(4, M / 256, gridDim.x, obid(), 1024);
  EpiG1Tr e2{p.ws};
  g8::gemm_phase<true>((LAS unsigned char*)smem, W + (size_t)2048 * 1024, H, 1024, S2, e2);
}

DEVI void phase_ret_u(const Params& p, int layer) {
  const int lane = otid() & 63, wid = otid() >> 6, fr = lane & 15, fq = lane >> 4;
  const u16* RKT = (const u16*)(p.ws + OFF_RKT);
  const u16* RVT = (const u16*)(p.ws + OFF_RVT);
  float* U = (float*)(p.ws + OFF_U);
  for (int u = obid() * 8 + wid; u < 2560; u += gridDim.x * 8) {
    const int h = u & 3, cgi = u >> 2, tok0 = cgi * 128;
    const float l2f = log_sigmoid(p.in[8][(layer * 2 + 0) * 4 + h]) * 1.4426950408889634f;
    const float l2b = log_sigmoid(p.in[8][(layer * 2 + 1) * 4 + h]) * 1.4426950408889634f;
#pragma unroll 1
    for (int hf = 0; hf < 2; ++hf) {
      f32x4 aF[4][2], aB[4][2];
      zero_acc<4, 2>(aF);
      zero_acc<4, 2>(aB);
#pragma unroll 1
      for (int ks = 0; ks < 4; ++ks) {
        const int m0 = ks * 32 + fq * 8;
        bf16x8 av[4];
#pragma unroll
        for (int dvt = 0; dvt < 4; ++dvt)
          av[dvt] = *(const bf16x8*)(RVT + (size_t)(h * 64 + dvt * 16 + fr) * M + tok0 + m0);
#pragma unroll
        for (int d2 = 0; d2 < 2; ++d2) {
          const int dkt = hf * 2 + d2;
          uint4 kr = *(const uint4*)(RKT + (size_t)(h * 64 + dkt * 16 + fr) * M + tok0 + m0);
          const unsigned kw[4] = {kr.x, kr.y, kr.z, kr.w};
          V8 kf, kb;
          unsigned of_[4], ob_[4];
#pragma unroll
          for (int e2 = 0; e2 < 4; ++e2) {
            const int m = m0 + e2 * 2;
            const float zf0 = exp2f(l2f * (float)(127 - m)), zf1 = exp2f(l2f * (float)(126 - m));
            const float zb0 = exp2f(l2b * (float)m), zb1 = exp2f(l2b * (float)(m + 1));
            of_[e2] = pack2(lo16(kw[e2]) * zf0, hi16(kw[e2]) * zf1);
            ob_[e2] = pack2(lo16(kw[e2]) * zb0, hi16(kw[e2]) * zb1);
          }
          kf.u = make_uint4(of_[0], of_[1], of_[2], of_[3]);
          kb.u = make_uint4(ob_[0], ob_[1], ob_[2], ob_[3]);
#pragma unroll
          for (int dvt = 0; dvt < 4; ++dvt) {
            aF[dvt][d2] = mfma16(av[dvt], kf.v, aF[dvt][d2]);
            aB[dvt][d2] = mfma16(av[dvt], kb.v, aB[dvt][d2]);
          }
        }
      }
      float* uf = U + (size_t)(u * 2 + 0) * 4096;
      float* ub = U + (size_t)(u * 2 + 1) * 4096;
#pragma unroll
      for (int dvt = 0; dvt < 4; ++dvt)
#pragma unroll
        for (int d2 = 0; d2 < 2; ++d2)
#pragma unroll
          for (int j = 0; j < 4; ++j) {
            const int idx = (dvt * 16 + fq * 4 + j) * 64 + (hf * 2 + d2) * 16 + fr;
            uf[idx] = aF[dvt][d2][j];
            ub[idx] = aB[dvt][d2][j];
          }
    }
  }
}

DEVI void phase_ret_scan(const Params& p, int layer) {
  const float* U = (const float*)(p.ws + OFF_U);
  u16* R = (u16*)(p.ws + OFF_R);
  const int total = 72 * 2 * 4096;
  for (int g = obid() * NTHR + otid(); g < total; g += gridDim.x * NTHR) {
    const int e = g & 4095, dir = (g >> 12) & 1, bh = g >> 13, h = bh & 3, b = bh >> 2;
    int base, N;
    if (b < 16) { base = b * 32; N = 32; } else { base = 512 + (b - 16) * 64; N = 64; }
    const float gC = expf(128.f * log_sigmoid(p.in[8][(layer * 2 + dir) * 4 + h]));
    float run = 0.f;
    const int nb = N >> 4;
#pragma unroll 1
    for (int bb = 0; bb < nb; ++bb) {
      float uv[16];
#pragma unroll
      for (int k = 0; k < 16; ++k) {
        const int n = dir == 0 ? (bb * 16 + k) : (N - 1 - (bb * 16 + k));
        uv[k] = U[((size_t)((base + n) * 4 + h) * 2 + dir) * 4096 + e];
      }
      asm volatile("" ::: "memory");
#pragma unroll
      for (int k = 0; k < 16; ++k) {
        const int n = dir == 0 ? (bb * 16 + k) : (N - 1 - (bb * 16 + k));
        R[((size_t)((base + n) * 4 + h) * 2 + dir) * 4096 + e] = f2bf(run);
        run = gC * run + uv[k];
      }
    }
  }
}

DEVI void phase_ret_out(const Params& p, int layer, unsigned char* smem) {
  constexpr int KLD = 68, VLD = 136, RLD = 72;
  u16* Ks = (u16*)smem;
  u16* Vs = (u16*)(smem + 17408);
  u16* Rfs = (u16*)(smem + 34816);
  u16* Rbs = (u16*)(smem + 44032);
  const int tid = otid(), lane = tid & 63, wid = tid >> 6, fr = lane & 15, fq = lane >> 4;
  const u16* RQ = (const u16*)(p.ws + OFF_RQ);
  const u16* RK = (const u16*)(p.ws + OFF_RK);
  const u16* RVT = (const u16*)(p.ws + OFF_RVT);
  const u16* RG = (const u16*)(p.ws + OFF_RG);
  const u16* R = (const u16*)(p.ws + OFF_R);
  u16* BR = brbuf(p);
  const float* gn = p.in[9] + layer * 256;
  for (int it = obid(); it < 2560; it += gridDim.x) {
    const int h = it & 3, cgi = it >> 2, ctok0 = cgi * 128, c0 = wid * 16, tok0 = ctok0 + c0;
    for (int c = tid; c < 3072; c += NTHR) {
      if (c < 1024) {
        const int k = c >> 3, part = c & 7;
        const uint4 v = *(const uint4*)(RK + (size_t)(ctok0 + k) * 256 + h * 64 + part * 8);
        uint2* d = (uint2*)(Ks + k * KLD + part * 8);
        d[0] = make_uint2(v.x, v.y);
        d[1] = make_uint2(v.z, v.w);
      } else if (c < 2048) {
        const int c2 = c - 1024, d = c2 >> 4, part = c2 & 15;
        *(uint4*)(Vs + d * VLD + part * 8) = *(const uint4*)(RVT + (size_t)(h * 64 + d) * M + ctok0 + part * 8);
      } else {
        const int c2 = c - 2048, dir = c2 >> 9, c3 = c2 & 511, dv = c3 >> 3, part = c3 & 7;
        *(uint4*)((dir ? Rbs : Rfs) + dv * RLD + part * 8) =
            *(const uint4*)(R + (size_t)((cgi * 4 + h) * 2 + dir) * 4096 + dv * 64 + part * 8);
      }
    }
    __syncthreads();
    const float l2f = log_sigmoid(p.in[8][(layer * 2 + 0) * 4 + h]) * 1.4426950408889634f;
    const float l2b = log_sigmoid(p.in[8][(layer * 2 + 1) * 4 + h]) * 1.4426950408889634f;
    const u16* qp = RQ + (size_t)(tok0 + fr) * 256 + h * 64 + fq * 8;
    const bf16x8 q0 = *(const bf16x8*)qp, q1 = *(const bf16x8*)(qp + 32);
    const int c = c0 + fr;
    f32x4 s[8];
    const u16* kl0 = Ks + (8 * (fr >> 2) + (fr & 3)) * KLD + fq * 8;
#pragma unroll
    for (int t = 0; t < 8; ++t) {
      const u16* kp = kl0 + ((t >> 1) * 32 + (t & 1) * 4) * KLD;
      V8 k0, k1;
      k0.h[0] = *(const uint2*)kp;        k0.h[1] = *(const uint2*)(kp + 4);
      k1.h[0] = *(const uint2*)(kp + 32); k1.h[1] = *(const uint2*)(kp + 36);
      f32x4 a = {0.f, 0.f, 0.f, 0.f};
      a = mfma16(k0.v, q0, a);
      a = mfma16(k1.v, q1, a);
#pragma unroll
      for (int j = 0; j < 4; ++j) {
        const int m = (t >> 1) * 32 + 8 * fq + 4 * (t & 1) + j;
        const int diff = c - m;
        const float dec = diff >= 0 ? __builtin_amdgcn_exp2f(l2f * (float)diff) : __builtin_amdgcn_exp2f(l2b * (float)(-diff));
        a[j] *= dec;
      }
      s[t] = a;
      asm volatile("" ::: "memory");
    }
    f32x4 o[4], iF[4], iB[4];
#pragma unroll
    for (int dt = 0; dt < 4; ++dt) { o[dt] = f32x4{0.f, 0.f, 0.f, 0.f}; iF[dt] = o[dt]; iB[dt] = o[dt]; }
    const u16* vl0 = Vs + fr * VLD + fq * 8;
#pragma unroll
    for (int ks = 0; ks < 4; ++ks) {
      V8 pb;
      pb.h[0] = pack4(s[2 * ks][0], s[2 * ks][1], s[2 * ks][2], s[2 * ks][3]);
      pb.h[1] = pack4(s[2 * ks + 1][0], s[2 * ks + 1][1], s[2 * ks + 1][2], s[2 * ks + 1][3]);
#pragma unroll
      for (int dt = 0; dt < 4; ++dt) {
        V8 va;
        va.u = *(const uint4*)(vl0 + dt * 16 * VLD + ks * 32);
        o[dt] = mfma16(va.v, pb.v, o[dt]);
      }
      asm volatile("" ::: "memory");
    }
    {
      const u16* rf = Rfs + fr * RLD + fq * 8;
      const u16* rb = Rbs + fr * RLD + fq * 8;
#pragma unroll
      for (int dt = 0; dt < 4; ++dt) {
        iF[dt] = mfma16(*(const bf16x8*)(rf + dt * 16 * RLD), q0, iF[dt]);
        iF[dt] = mfma16(*(const bf16x8*)(rf + dt * 16 * RLD + 32), q1, iF[dt]);
        iB[dt] = mfma16(*(const bf16x8*)(rb + dt * 16 * RLD), q0, iB[dt]);
        iB[dt] = mfma16(*(const bf16x8*)(rb + dt * 16 * RLD + 32), q1, iB[dt]);
      }
    }
    const float xif = exp2f(l2f * (float)(c + 1)), xib = exp2f(l2b * (float)(128 - c));
    float sum = 0.f;
#pragma unroll
    for (int dt = 0; dt < 4; ++dt)
#pragma unroll
      for (int j = 0; j < 4; ++j) {
        o[dt][j] += xif * iF[dt][j] + xib * iB[dt][j];
        sum += o[dt][j];
      }
    sum += __shfl_xor(sum, 16);
    sum += __shfl_xor(sum, 32);
    const float mu = sum * (1.f / 64.f);
    float vs = 0.f;
#pragma unroll
    for (int dt = 0; dt < 4; ++dt)
#pragma unroll
      for (int j = 0; j < 4; ++j) { float d = o[dt][j] - mu; vs += d * d; }
    vs += __shfl_xor(vs, 16);
    vs += __shfl_xor(vs, 32);
    const float rstd = rsqrtf(vs * (1.f / 64.f) + 1e-6f);
#pragma unroll
    for (int dt = 0; dt < 4; ++dt) {
      const int ch = h * 64 + dt * 16 + fq * 4;
      float4 g = *(const float4*)(gn + ch);
      uint2 sg = *(const uint2*)(RG + (size_t)(tok0 + fr) * 256 + ch);
      float r0 = (o[dt][0] - mu) * rstd * g.x * lo16(sg.x);
      float r1 = (o[dt][1] - mu) * rstd * g.y * hi16(sg.x);
      float r2 = (o[dt][2] - mu) * rstd * g.z * lo16(sg.y);
      float r3 = (o[dt][3] - mu) * rstd * g.w * hi16(sg.y);
      *(uint2*)(BR + (size_t)(tok0 + fr) * 1024 + ch) = pack4(r0, r1, r2, r3);
    }
    __syncthreads();
  }
}

DEVI void phase_conv(const Params& p, int layer, unsigned char* smem) {
  const int tid = otid(), lane = tid & 63, wid = tid >> 6, half = tid >> 8, ct = tid & 255;
  float* su = (float*)smem + half * (62 * 256);
  const u16* CA = (const u16*)(p.ws + OFF_CA);
  const u16* CB = (const u16*)(p.ws + OFF_CB);
  u16* BR = brbuf(p) + 256;
  float w[31];
#pragma unroll
  for (int j = 0; j < 31; ++j) w[j] = p.in[10][(layer * 31 + j) * 256 + ct];
  const float bias = p.in[11][layer * 256 + ct];
  const float4 lg = *(const float4*)(p.in[12] + layer * 256 + lane * 4);
  const float4 lbb = *(const float4*)(p.in[13] + layer * 256 + lane * 4);
  for (int it = obid(); it < 1280; it += gridDim.x) {
    const int t0 = (it * 2 + half) * 32;
    int seq, pos0, T;
    tokinfo(t0, seq, pos0, T);
    const int sb = t0 - pos0;
    {
      const int ch = ct & 31, rr = ct >> 5;
#pragma unroll
      for (int ps = 0; ps < 8; ++ps) {
        const int row = ps * 8 + rr;
        if (row < 62) {
          const int pos = pos0 - 15 + row;
          float u[8];
          if (pos >= 0 && pos < T) {
            uint4 a = *(const uint4*)(CA + (size_t)(sb + pos) * 256 + ch * 8);
            uint4 b = *(const uint4*)(CB + (size_t)(sb + pos) * 256 + ch * 8);
            u[0] = lo16(a.x) * lo16(b.x); u[1] = hi16(a.x) * hi16(b.x);
            u[2] = lo16(a.y) * lo16(b.y); u[3] = hi16(a.y) * hi16(b.y);
            u[4] = lo16(a.z) * lo16(b.z); u[5] = hi16(a.z) * hi16(b.z);
            u[6] = lo16(a.w) * lo16(b.w); u[7] = hi16(a.w) * hi16(b.w);
          } else {
#pragma unroll
            for (int e = 0; e < 8; ++e) u[e] = 0.f;
          }
          float* d = su + row * 256 + ch * 8;
          *(float4*)d = make_float4(u[0], u[1], u[2], u[3]);
          *(float4*)(d + 4) = make_float4(u[4], u[5], u[6], u[7]);
        }
      }
    }
    __syncthreads();
    float y[32];
#pragma unroll
    for (int t = 0; t < 32; ++t) y[t] = bias;
#pragma unroll
    for (int r = 0; r < 62; ++r) {
      const float uv = su[r * 256 + ct];
#pragma unroll
      for (int t = 0; t < 32; ++t) {
        const int j = r - t;
        if (j >= 0 && j < 31) y[t] += uv * w[j];
      }
    }
    __syncthreads();
#pragma unroll
    for (int t = 0; t < 32; ++t) su[t * 256 + ct] = y[t];
    __syncthreads();
#pragma unroll 1
    for (int tt = 0; tt < 8; ++tt) {
      const int t = (wid & 3) * 8 + tt;
      float4 v = *(const float4*)(su + t * 256 + lane * 4);
      float sm = wave_sum(v.x + v.y + v.z + v.w);
      const float mu = sm * (1.f / 256.f);
      float d0 = v.x - mu, d1 = v.y - mu, d2 = v.z - mu, d3 = v.w - mu;
      float vs = wave_sum(d0 * d0 + d1 * d1 + d2 * d2 + d3 * d3);
      const float rstd = rsqrtf(vs * (1.f / 256.f) + 1e-6f);
      float z0 = d0 * rstd * lg.x + lbb.x, z1 = d1 * rstd * lg.y + lbb.y, z2 = d2 * rstd * lg.z + lbb.z,
            z3 = d3 * rstd * lg.w + lbb.w;
      z0 *= sigmoidf_(z0); z1 *= sigmoidf_(z1); z2 *= sigmoidf_(z2); z3 *= sigmoidf_(z3);
      *(uint2*)(BR + (size_t)(t0 + t) * 1024 + lane * 4) = pack4(z0, z1, z2, z3);
    }
    __syncthreads();
  }
}

DEVI void phase_na(const Params& p, int layer, unsigned char* smem) {
  constexpr int KLD = 68, VLD = 488;
  u16* Ks = (u16*)smem;
  u16* Vs = (u16*)(smem + 65280);
  float* rpb = (float*)(smem + 65280 + 62464);
  const int tid = otid(), lane = tid & 63, wid = tid >> 6, fr = lane & 15, fq = lane >> 4;
  const u16* NQ = (const u16*)(p.ws + OFF_NQ);
  const u16* NK = (const u16*)(p.ws + OFF_NK);
  const u16* NVT = (const u16*)(p.ws + OFF_NVT);
  u16* BR = brbuf(p);
  for (int it = obid(); it < 2560; it += gridDim.x) {
    const int h = it & 3, jb = (it >> 2) & 3, rgi = it >> 4;
    int sb, T, rg;
    if (rgi < 128) { sb = (rgi >> 3) * 4096; T = 4096; rg = rgi & 7; }
    else { const int q = rgi - 128; sb = MP + (q >> 4) * 8192; T = 8192; rg = q & 15; }
    const int rows = T >> 6;
    const int r0 = rg * 8;
    int lo = r0 - 4; lo = lo < 0 ? 0 : (lo > rows - 8 ? rows - 8 : lo);
    int hi = r0 + 7 - 4; hi = hi < 0 ? 0 : (hi > rows - 8 ? rows - 8 : hi); hi += 7;
    const int nrow = hi - lo + 1;
    const int kb = jb == 0 ? 0 : (jb == 1 ? 8 : (jb == 2 ? 24 : 32));
    for (int i = tid; i < 465; i += NTHR) rpb[i] = p.in[14][(layer * 4 + h) * 465 + i];
    {
      const int nk = nrow * 32 * 8;
      for (int c = tid; c < nk; c += NTHR) {
        const int k = c >> 3, part = c & 7;
        const uint4 v = *(const uint4*)(NK + (size_t)(sb + (lo + (k >> 5)) * 64 + kb + (k & 31)) * 256 + h * 64 + part * 8);
        uint2* d = (uint2*)(Ks + k * KLD + part * 8);
        d[0] = make_uint2(v.x, v.y);
        d[1] = make_uint2(v.z, v.w);
      }
      const int nv = 64 * nrow * 4;
      for (int c = tid; c < nv; c += NTHR) {
        const int d = c / (nrow * 4), rem = c - d * (nrow * 4), seg = rem >> 2, part = rem & 3;
        const uint4 v = *(const uint4*)(NVT + (size_t)(h * 64 + d) * M + sb + (lo + seg) * 64 + kb + part * 8);
        *(uint4*)(Vs + d * VLD + seg * 32 + part * 8) = v;
      }
    }
    __syncthreads();
    {
      const int r = r0 + wid;
      const int pos0 = r * 64 + jb * 16, tok0 = sb + pos0, qc0 = jb * 16;
      int start = r - 4;
      start = start < 0 ? 0 : (start > rows - 8 ? rows - 8 : start);
      const int rel0 = start - lo;
      const u16* qp = NQ + (size_t)(tok0 + fr) * 256 + h * 64 + fq * 8;
      const bf16x8 q0 = *(const bf16x8*)qp, q1 = *(const bf16x8*)(qp + 32);
      const int qcol = qc0 + fr;
      int wst = qcol - 8;
      wst = wst < 0 ? 0 : (wst > 48 ? 48 : wst);
      f32x4 s[16];
      float mx = -3e38f;
      const u16* kl0 = Ks + (rel0 * 32 + 8 * (fr >> 2) + (fr & 3)) * KLD + fq * 8;
#pragma unroll
      for (int t = 0; t < 16; ++t) {
        const int i = t >> 1, pp = t & 1;
        const u16* kp = kl0 + (i * 32 + pp * 4) * KLD;
        V8 k0, k1;
        k0.h[0] = *(const uint2*)kp;        k0.h[1] = *(const uint2*)(kp + 4);
        k1.h[0] = *(const uint2*)(kp + 32); k1.h[1] = *(const uint2*)(kp + 36);
        f32x4 a = {0.f, 0.f, 0.f, 0.f};
        a = mfma16(k0.v, q0, a);
        a = mfma16(k1.v, q1, a);
        const int dr = start + i - r + 7;
#pragma unroll
        for (int j = 0; j < 4; ++j) {
          const int kcol = kb + 8 * fq + 4 * pp + j;
          const int rel = kcol - wst;
          int dc = kcol - qcol + 15;
          dc = dc < 0 ? 0 : (dc > 30 ? 30 : dc);
          const bool ok = (rel >= 0) && (rel < 16);
          const float v = ok ? a[j] + rpb[dr * 31 + dc] : -1e30f;
          a[j] = v;
          mx = fmaxf(mx, v);
        }
        s[t] = a;
      }
      mx = fmaxf(mx, __shfl_xor(mx, 16));
      mx = fmaxf(mx, __shfl_xor(mx, 32));
      float sum = 0.f;
#pragma unroll
      for (int t = 0; t < 16; ++t)
#pragma unroll
        for (int j = 0; j < 4; ++j) { float e = fast_exp(s[t][j] - mx); s[t][j] = e; sum += e; }
      sum += __shfl_xor(sum, 16);
      sum += __shfl_xor(sum, 32);
      const float inv = fast_rcp(sum);
      f32x4 o[4];
#pragma unroll
      for (int dt = 0; dt < 4; ++dt) o[dt] = f32x4{0.f, 0.f, 0.f, 0.f};
      const u16* vl0 = Vs + fr * VLD + rel0 * 32 + fq * 8;
#pragma unroll
      for (int ks = 0; ks < 8; ++ks) {
        V8 pb;
        pb.h[0] = pack4(s[2 * ks][0] * inv, s[2 * ks][1] * inv, s[2 * ks][2] * inv, s[2 * ks][3] * inv);
        pb.h[1] = pack4(s[2 * ks + 1][0] * inv, s[2 * ks + 1][1] * inv, s[2 * ks + 1][2] * inv, s[2 * ks + 1][3] * inv);
#pragma unroll
        for (int dt = 0; dt < 4; ++dt) {
          V8 va;
          va.u = *(const uint4*)(vl0 + dt * 16 * VLD + ks * 32);
          o[dt] = mfma16(va.v, pb.v, o[dt]);
        }
      }
#pragma unroll
      for (int dt = 0; dt < 4; ++dt)
        *(uint2*)(BR + (size_t)(tok0 + fr) * 1024 + 512 + h * 64 + dt * 16 + fq * 4) =
            pack4(o[dt][0], o[dt][1], o[dt][2], o[dt][3]);
    }
    __syncthreads();
  }
}

DEVI int t5_bucket_dev(int rel) {
  int n = rel < 0 ? -rel : rel;
  int b;
  if (n < 8) b = n;
  else b = 8 + (n >= 12) + (n >= 16) + (n >= 23) + (n >= 32) + (n >= 46) + (n >= 64) + (n >= 91);
  return (rel > 0 ? 16 : 0) + b;
}

DEVI void phase_swa(const Params& p, int layer, unsigned char* smem) {
  constexpr int KLD = 68, VLD = 392;
  u16* Ks = (u16*)smem;
  u16* Vs = (u16*)(smem + 52224);
  float* lut = (float*)(smem + 52224 + 50176);
  const int tid = otid(), lane = tid & 63, wid = tid >> 6, fr = lane & 15, fq = lane >> 4;
  const u16* SQ = (const u16*)(p.ws + OFF_SQ);
  const u16* SK = (const u16*)(p.ws + OFF_SK);
  const u16* SVT = (const u16*)(p.ws + OFF_SVT);
  u16* BR = brbuf(p);
  for (int it = obid(); it < 1280; it += gridDim.x) {
    const int hkv = it & 1, blk = it >> 1, tokb = blk * 128;
    int seq, posb, T;
    tokinfo(tokb, seq, posb, T);
    const int sb = tokb - posb;
    const int wlo = posb - 128;
    for (int i = tid; i < 2 * 257; i += NTHR) {
      const int g = i / 257, rel = (i % 257) - 128;
      lut[i] = p.in[16][t5_bucket_dev(rel) * 4 + hkv * 2 + g];
    }
    for (int c = tid; c < 64 * 48; c += NTHR) {
      const int d = c / 48, rem = c - d * 48, kofs = (rem >> 2) * 32 + (rem & 3) * 8, kpos = wlo + kofs;
      uint4 v = make_uint4(0u, 0u, 0u, 0u);
      if (kpos >= 0 && kpos < T) v = *(const uint4*)(SK + (size_t)(hkv * 64 + d) * M + sb + kpos);
      u16* kd = Ks + kofs * KLD + d;
      kd[0 * KLD] = (u16)(v.x & 0xffffu); kd[1 * KLD] = (u16)(v.x >> 16);
      kd[2 * KLD] = (u16)(v.y & 0xffffu); kd[3 * KLD] = (u16)(v.y >> 16);
      kd[4 * KLD] = (u16)(v.z & 0xffffu); kd[5 * KLD] = (u16)(v.z >> 16);
      kd[6 * KLD] = (u16)(v.w & 0xffffu); kd[7 * KLD] = (u16)(v.w >> 16);
    }
    for (int c = tid; c < 64 * 48; c += NTHR) {
      const int d = c / 48, rem = c - d * 48, kofs = (rem >> 2) * 32 + (rem & 3) * 8, kpos = wlo + kofs;
      uint4 v = make_uint4(0u, 0u, 0u, 0u);
      if (kpos >= 0 && kpos < T) v = *(const uint4*)(SVT + (size_t)(hkv * 64 + d) * M + sb + kpos);
      *(uint4*)(Vs + d * VLD + kofs) = v;
    }
    __syncthreads();
    const int pos0 = posb + wid * 16, tok0 = sb + pos0;
    const int b0 = wid >> 1;
    const int qoff = 128 + (wid & 1) * 16;
    const u16* kl0 = Ks + (b0 * 32 + 8 * (fr >> 2) + (fr & 3)) * KLD + fq * 8;
    const u16* vl0 = Vs + fr * VLD + b0 * 32 + fq * 8;
#pragma unroll 1
    for (int g = 0; g < 2; ++g) {
      const int hq = hkv * 2 + g;
      const float sink = p.in[15][layer * 4 + hq];
      const u16* qp = SQ + (size_t)(tok0 + fr) * 256 + hq * 64 + fq * 8;
      const bf16x8 q0 = *(const bf16x8*)qp, q1 = *(const bf16x8*)(qp + 32);
      f32x4 s[18];
      float mx = sink;
#pragma unroll
      for (int t = 0; t < 18; ++t) {
        const int bs = wlo + (b0 + (t >> 1)) * 32;
        const bool bv = (bs >= 0) && (bs < T);
        const u16* kp = kl0 + ((t >> 1) * 32 + (t & 1) * 4) * KLD;
        V8 k0, k1;
        k0.h[0] = *(const uint2*)kp;        k0.h[1] = *(const uint2*)(kp + 4);
        k1.h[0] = *(const uint2*)(kp + 32); k1.h[1] = *(const uint2*)(kp + 36);
        f32x4 a = {0.f, 0.f, 0.f, 0.f};
        a = mfma16(k0.v, q0, a);
        a = mfma16(k1.v, q1, a);
#pragma unroll
        for (int j = 0; j < 4; ++j) {
          const int rel = (t >> 1) * 32 + 8 * fq + 4 * (t & 1) + j - qoff - fr;
          const bool ok = bv && rel >= -128 && rel <= 128;
          int li = rel + 128;
          li = li < 0 ? 0 : (li > 256 ? 256 : li);
          const float v = ok ? a[j] + lut[g * 257 + li] : -1e30f;
          a[j] = v;
          mx = fmaxf(mx, v);
        }
        s[t] = a;
        asm volatile("" ::: "memory");
      }
      mx = fmaxf(mx, __shfl_xor(mx, 16));
      mx = fmaxf(mx, __shfl_xor(mx, 32));
      float sum = 0.f;
#pragma unroll
      for (int t = 0; t < 18; ++t)
#pragma unroll
        for (int j = 0; j < 4; ++j) { float e = fast_exp(s[t][j] - mx); s[t][j] = e; sum += e; }
      sum += __shfl_xor(sum, 16);
      sum += __shfl_xor(sum, 32);
      const float inv = fast_rcp(sum + fast_exp(sink - mx));
      f32x4 o[4];
#pragma unroll
      for (int dt = 0; dt < 4; ++dt) o[dt] = f32x4{0.f, 0.f, 0.f, 0.f};
#pragma unroll
      for (int ks = 0; ks < 9; ++ks) {
        V8 pb;
        pb.h[0] = pack4(s[2 * ks][0] * inv, s[2 * ks][1] * inv, s[2 * ks][2] * inv, s[2 * ks][3] * inv);
        pb.h[1] = pack4(s[2 * ks + 1][0] * inv, s[2 * ks + 1][1] * inv, s[2 * ks + 1][2] * inv, s[2 * ks + 1][3] * inv);
#pragma unroll
        for (int dt = 0; dt < 4; ++dt) {
          V8 va;
          va.u = *(const uint4*)(vl0 + dt * 16 * VLD + ks * 32);
          o[dt] = mfma16(va.v, pb.v, o[dt]);
        }
        asm volatile("" ::: "memory");
      }
#pragma unroll
      for (int dt = 0; dt < 4; ++dt)
        *(uint2*)(BR + (size_t)(tok0 + fr) * 1024 + 768 + hq * 64 + dt * 16 + fq * 4) =
            pack4(o[dt][0], o[dt][1], o[dt][2], o[dt][3]);
    }
    __syncthreads();
  }
}

struct TileOrder {
  int pm, pn; bool gate; size_t a0, b0;
  DEVI bool next(int ui, g8::Unit& u) const {
    if (ui >= 4) return false;
    u.pm = pm; u.pn = pn; u.aux = ui;
    if (gate) {
      u.nt = 16;
      u.aoff = a0 + (size_t)pm * 256 * 1024 * 2;
      u.boff = b0 + ((size_t)ui * 1024 + pn * 256) * 1024 * 2;
    } else {
      u.nt = 4;
      u.aoff = a0 + ((size_t)pm * 256 * 1024 + ui * 256) * 2;
      u.boff = b0 + ((size_t)pn * 256 * 1024 + ui * 256) * 2;
    }
    return true;
  }
};
struct EpiGateTile {
  u16* scr;
  DEVI bool operator()(f32x4 (&acc)[2][2][4][2], const g8::Unit& u, int wr, int wc, int fr, int fq) const {
    u16* o0 = scr + u.aux * 65536 + (wr * 64 + fr) * 256 + wc * 32 + fq * 8;
#pragma unroll
    for (int ai = 0; ai < 2; ++ai)
#pragma unroll
      for (int m = 0; m < 4; ++m) {
        u16* orow = o0 + (ai * 128 + m * 16) * 256;
#pragma unroll
        for (int bj = 0; bj < 2; ++bj) {
          const f32x4 v0 = acc[ai][bj][m][0], v1 = acc[ai][bj][m][1];
          uint4 w;
          w.x = pack2(sigmoidf_(v0[0]), sigmoidf_(v0[1])); w.y = pack2(sigmoidf_(v0[2]), sigmoidf_(v0[3]));
          w.z = pack2(sigmoidf_(v1[0]), sigmoidf_(v1[1])); w.w = pack2(sigmoidf_(v1[2]), sigmoidf_(v1[3]));
          *(uint4*)(orow + bj * 128) = w;
        }
        asm volatile("" ::: "memory");
      }
    return true;
  }
};
struct EpiMergeTile {
  const u16* scr; u16* MG;
  DEVI bool operator()(f32x4 (&acc)[2][2][4][2], const g8::Unit& u, int wr, int wc, int fr, int fq) const {
    const int i = u.aux;
    const bool last = (i == 3);
    const int gbo = last ? 0 : 65536;
    const u16* g0 = scr + i * 65536 + (wr * 64 + fr) * 256 + wc * 32 + fq * 8;
    u16* o0 = MG + (size_t)(u.pm * 256 + wr * 64 + fr) * 1024 + u.pn * 256 + wc * 32 + fq * 8;
#pragma unroll
    for (int ai = 0; ai < 2; ++ai) {
      uint4 ga[4][2], gb[4][2];
#pragma unroll
      for (int m = 0; m < 4; ++m) {
        const u16* gr = g0 + (ai * 128 + m * 16) * 256;
#pragma unroll
        for (int bj = 0; bj < 2; ++bj) {
          ga[m][bj] = *(const uint4*)(gr + bj * 128);
          gb[m][bj] = *(const uint4*)(gr + gbo + bj * 128);
        }
      }
      asm volatile("" ::: "memory");
#pragma unroll
      for (int m = 0; m < 4; ++m) {
        u16* orow = o0 + (size_t)(ai * 128 + m * 16) * 1024;
#pragma unroll
        for (int bj = 0; bj < 2; ++bj) {
          const uint4 a4 = ga[m][bj], b4 = gb[m][bj];
          f32x4 v0 = acc[ai][bj][m][0], v1 = acc[ai][bj][m][1];
          v0[0] *= lo16(a4.x) * (last ? 1.f : fast_rcp(lo16(b4.x)));
          v0[1] *= hi16(a4.x) * (last ? 1.f : fast_rcp(hi16(b4.x)));
          v0[2] *= lo16(a4.y) * (last ? 1.f : fast_rcp(lo16(b4.y)));
          v0[3] *= hi16(a4.y) * (last ? 1.f : fast_rcp(hi16(b4.y)));
          v1[0] *= lo16(a4.z) * (last ? 1.f : fast_rcp(lo16(b4.z)));
          v1[1] *= hi16(a4.z) * (last ? 1.f : fast_rcp(hi16(b4.z)));
          v1[2] *= lo16(a4.w) * (last ? 1.f : fast_rcp(lo16(b4.w)));
          v1[3] *= hi16(a4.w) * (last ? 1.f : fast_rcp(hi16(b4.w)));
          acc[ai][bj][m][0] = v0;
          acc[ai][bj][m][1] = v1;
          if (last) {
            uint4 w;
            w.x = pack2(v0[0], v0[1]); w.y = pack2(v0[2], v0[3]); w.z = pack2(v1[0], v1[1]); w.w = pack2(v1[2], v1[3]);
            *(uint4*)(orow + bj * 128) = w;
          }
        }
      }
      asm volatile("" ::: "memory");
    }
    return last;
  }
};
DEVI void stage_wait(unsigned* cnt);
DEVI void phase_gm(const Params& p, int layer, unsigned char* smem, unsigned* mixers_done) {
  g8::Order tiles;
  tiles.init(M / 256, 4, gridDim.x, obid(), 1024);
  const int bid = obid();
  u16* scr = bid < 80 ? (u16*)(p.ws + OFF_RKT) + (size_t)bid * 4 * 65536
           : (bid < 240 ? (u16*)(p.ws + OFF_U) + (size_t)(bid - 80) * 4 * 65536
                        : (u16*)(p.ws + OFF_END + 65536) + (size_t)(bid - 240) * 4 * 65536);
#pragma unroll 1
  for (int r = 0;; ++r) {
    g8::Unit tu;
    if (!tiles.next(r, tu)) break;
    {
      TileOrder S{tu.pm, tu.pn, true, 0, OFF_WMERGE + (size_t)layer * SZ_WMERGE * 2};
      EpiGateTile e{scr};
      g8::gemm_phase<true>((LAS unsigned char*)smem, hbuf(p), (const u16*)p.ws, 1024, S, e);
    }
    if (r == 0) stage_wait(mixers_done);
    {
      TileOrder S{tu.pm, tu.pn, false, (size_t)M * 1024 * 2, OFF_WBRANCH + (size_t)layer * SZ_WBRANCH * 2};
      EpiMergeTile e{scr, (u16*)(p.ws + OFF_MERGED)};
      g8::gemm_phase<true>((LAS unsigned char*)smem, hbuf(p), (const u16*)p.ws, 1024, S, e);
    }
  }
}

template <bool FIRST>
struct EpiResid {
  u16* xb; const float* mod; int layer, gsel;
  const float* xp; const float* xs;
  DEVI bool operator()(f32x4 (&acc)[2][2][4][2], const g8::Unit& u, int wr, int wc, int fr, int fq) const {
    const int t0 = u.pm * 256;
    int seq, pos0, T;
    tokinfo(t0, seq, pos0, T);
    const float* gp = mod + (size_t)(layer * 18 + seq) * 6144 + gsel * 1024 + u.pn * 256 + wc * 32 + fq * 8;
    float4 g[2][2];
#pragma unroll
    for (int bj = 0; bj < 2; ++bj)
#pragma unroll
      for (int n = 0; n < 2; ++n) g[bj][n] = *(const float4*)(gp + bj * 128 + n * 4);
    const size_t lo = (size_t)(wr * 64 + fr) * 1024 + u.pn * 256 + wc * 32 + fq * 8;
    u16* o0 = xb + (size_t)t0 * 1024 + lo;
    if (FIRST) {
      const float* i0 = (t0 < MP ? xp + (size_t)t0 * 1024 : xs + (size_t)(t0 - MP) * 1024) + lo;
#pragma unroll
      for (int ai = 0; ai < 2; ++ai)
#pragma unroll
        for (int mh = 0; mh < 2; ++mh) {
          float4 x[2][2][2];
#pragma unroll
          for (int m2 = 0; m2 < 2; ++m2)
#pragma unroll
            for (int bj = 0; bj < 2; ++bj) {
              const float* ip = i0 + (size_t)(ai * 128 + (mh * 2 + m2) * 16) * 1024 + bj * 128;
              x[m2][bj][0] = *(const float4*)ip;
              x[m2][bj][1] = *(const float4*)(ip + 4);
            }
          asm volatile("" ::: "memory");
#pragma unroll
          for (int m2 = 0; m2 < 2; ++m2) {
            const int m = mh * 2 + m2;
            u16* rowp = o0 + (size_t)(ai * 128 + m * 16) * 1024;
#pragma unroll
            for (int bj = 0; bj < 2; ++bj) {
              const float4 xa = x[m2][bj][0], xc = x[m2][bj][1];
              const f32x4 v0 = acc[ai][bj][m][0], v1 = acc[ai][bj][m][1];
              uint4 w;
              w.x = pack2(xa.x + g[bj][0].x * v0[0], xa.y + g[bj][0].y * v0[1]);
              w.y = pack2(xa.z + g[bj][0].z * v0[2], xa.w + g[bj][0].w * v0[3]);
              w.z = pack2(xc.x + g[bj][1].x * v1[0], xc.y + g[bj][1].y * v1[1]);
              w.w = pack2(xc.z + g[bj][1].z * v1[2], xc.w + g[bj][1].w * v1[3]);
              *(uint4*)(rowp + bj * 128) = w;
            }
          }
          asm volatile("" ::: "memory");
        }
    } else {
#pragma unroll
      for (int ai = 0; ai < 2; ++ai) {
        uint4 xw[4][2];
#pragma unroll
        for (int m = 0; m < 4; ++m)
#pragma unroll
          for (int bj = 0; bj < 2; ++bj) xw[m][bj] = *(const uint4*)(o0 + (size_t)(ai * 128 + m * 16) * 1024 + bj * 128);
        asm volatile("" ::: "memory");
#pragma unroll
        for (int m = 0; m < 4; ++m) {
          u16* rowp = o0 + (size_t)(ai * 128 + m * 16) * 1024;
#pragma unroll
          for (int bj = 0; bj < 2; ++bj) {
            const uint4 xv = xw[m][bj];
            const f32x4 v0 = acc[ai][bj][m][0], v1 = acc[ai][bj][m][1];
            uint4 w;
            w.x = pack2(lo16(xv.x) + g[bj][0].x * v0[0], hi16(xv.x) + g[bj][0].y * v0[1]);
            w.y = pack2(lo16(xv.y) + g[bj][0].z * v0[2], hi16(xv.y) + g[bj][0].w * v0[3]);
            w.z = pack2(lo16(xv.z) + g[bj][1].x * v1[0], hi16(xv.z) + g[bj][1].y * v1[1]);
            w.w = pack2(lo16(xv.w) + g[bj][1].z * v1[2], hi16(xv.w) + g[bj][1].w * v1[3]);
            *(uint4*)(rowp + bj * 128) = w;
          }
        }
        asm volatile("" ::: "memory");
      }
    }
    return true;
  }
};
DEVI void phase_resid(const Params& p, int layer, const u16* A, int K, const u16* Wt, int gsel, unsigned char* smem) {
  g8::Order S;
  S.init(M / 256, 4, gridDim.x, obid(), K);
  if (layer == 0 && gsel == 2) {
    EpiResid<true> e{xbuf(p), (const float*)(p.ws + OFF_MOD), layer, gsel, p.in[0], p.in[1]};
    g8::gemm_phase<true>((LAS unsigned char*)smem, A, Wt, K, S, e);
  } else {
    EpiResid<false> e{xbuf(p), (const float*)(p.ws + OFF_MOD), layer, gsel, nullptr, nullptr};
    g8::gemm_phase<true>((LAS unsigned char*)smem, A, Wt, K, S, e);
  }
}

struct EpiFF1 {
  u16* HID;
  DEVI bool operator()(f32x4 (&acc)[2][2][4][2], const g8::Unit& u, int wr, int wc, int fr, int fq) const {
    u16* o0 = HID + (size_t)(u.pm * 256 + wr * 64 + fr) * 4096 + u.pn * 256 + wc * 32 + fq * 8;
#pragma unroll
    for (int ai = 0; ai < 2; ++ai)
#pragma unroll
      for (int m = 0; m < 4; ++m) {
        u16* orow = o0 + (size_t)(ai * 128 + m * 16) * 4096;
#pragma unroll
        for (int bj = 0; bj < 2; ++bj) {
          const f32x4 v0 = acc[ai][bj][m][0], v1 = acc[ai][bj][m][1];
          const float a0 = fmaxf(v0[0], 0.f), a1 = fmaxf(v0[1], 0.f), a2 = fmaxf(v0[2], 0.f), a3 = fmaxf(v0[3], 0.f);
          const float b0 = fmaxf(v1[0], 0.f), b1 = fmaxf(v1[1], 0.f), b2 = fmaxf(v1[2], 0.f), b3 = fmaxf(v1[3], 0.f);
          uint4 w;
          w.x = pack2(a0 * a0, a1 * a1); w.y = pack2(a2 * a2, a3 * a3);
          w.z = pack2(b0 * b0, b1 * b1); w.w = pack2(b2 * b2, b3 * b3);
          *(uint4*)(orow + bj * 128) = w;
        }
        asm volatile("" ::: "memory");
      }
    return true;
  }
};
DEVI void phase_ff1(const Params& p, int layer, unsigned char* smem) {
  g8::Order S;
  S.init(M / 256, 16, gridDim.x, obid(), 1024);
  EpiFF1 e{(u16*)(p.ws + OFF_HID)};
  g8::gemm_phase<true>((LAS unsigned char*)smem, hbuf(p), (const u16*)(p.ws + OFF_WFF1) + (size_t)layer * SZ_WFF, 1024, S, e);
}

struct CtrBarrier { unsigned* ctr; unsigned target; };
DEVI void ctr_barrier(CtrBarrier& b) {
  asm volatile("s_waitcnt vmcnt(0)" ::: "memory");
  __syncthreads();
  b.target += gridDim.x;
  if (threadIdx.x == 0) {
    __builtin_amdgcn_fence(__ATOMIC_RELEASE, "agent");
    asm volatile("s_waitcnt vmcnt(0)" ::: "memory");
    __hip_atomic_fetch_add(b.ctr, 1u, __ATOMIC_RELAXED, __HIP_MEMORY_SCOPE_AGENT);
    unsigned spins = 0;
    while (__hip_atomic_load(b.ctr, __ATOMIC_RELAXED, __HIP_MEMORY_SCOPE_AGENT) < b.target) {
      __builtin_amdgcn_s_sleep(1);
      if (++spins > (1u << 22)) break;
    }
    __builtin_amdgcn_fence(__ATOMIC_ACQUIRE, "agent");
    asm volatile("s_waitcnt vmcnt(0)" ::: "memory");
  }
  __syncthreads();
}

DEVI void stage_signal(unsigned* cnt) {
  asm volatile("s_waitcnt vmcnt(0)" ::: "memory");
  __syncthreads();
  if (threadIdx.x == 0) {
    __builtin_amdgcn_fence(__ATOMIC_RELEASE, "agent");
    asm volatile("s_waitcnt vmcnt(0)" ::: "memory");
    __hip_atomic_fetch_add(cnt, 1u, __ATOMIC_RELAXED, __HIP_MEMORY_SCOPE_AGENT);
  }
}
DEVI void stage_wait(unsigned* cnt) {
  __syncthreads();
  if (threadIdx.x == 0) {
    unsigned spins = 0;
    while (__hip_atomic_load(cnt, __ATOMIC_RELAXED, __HIP_MEMORY_SCOPE_AGENT) < gridDim.x) {
      __builtin_amdgcn_s_sleep(1);
      if (++spins > (1u << 22)) break;
    }
    __builtin_amdgcn_fence(__ATOMIC_ACQUIRE, "agent");
    asm volatile("s_waitcnt vmcnt(0)" ::: "memory");
  }
  __syncthreads();
}

#define REP_GATES 1
#define REP_NA 1
#define REP_SWA 1
#define REP_C1 1
#define REP_C2 1
#define REP_C3 1
#define REP_FF1 1
#define REP_G1 1
#define REP_MERGE 1
#ifndef REP_MIX
#define REP_MIX 1
#endif
__global__ void __launch_bounds__(512, 2) trunk_megakernel(Params p) {
  cg::grid_group grid = cg::this_grid();
  __shared__ __attribute__((aligned(16))) unsigned char smem[SMEM_BYTES];
  CtrBarrier cb{(unsigned*)(p.ws + OFF_BAR), 0u};
  if (blockIdx.x == 0 && threadIdx.x < 8) cb.ctr[threadIdx.x * 16] = 0u;

  phase0(p, smem);
  grid.sync();
#pragma unroll 1
  for (int l = 0; l < 2; ++l) {
    phase_norm(p, l, 0);
    ctr_barrier(cb);
#pragma unroll 1
    for (int rep = 0; rep < REP_G1; ++rep) {
    phase_gemm1(p, l, smem);
    ctr_barrier(cb);
    }
    {
      unsigned* cntA = cb.ctr + 16 * (1 + 2 * l), * cntB = cb.ctr + 16 * (2 + 2 * l);
      phase_ret_u(p, l);
      stage_signal(cntA);
      phase_conv(p, l, smem);
      phase_na(p, l, smem);
      stage_wait(cntA);
      phase_ret_scan(p, l);
      stage_signal(cntB);
      phase_swa(p, l, smem);
      stage_wait(cntB);
      phase_ret_out(p, l, smem);
      stage_signal(cb.ctr + 16 * (5 + l));
    }
    phase_gm(p, l, smem, cb.ctr + 16 * (5 + l));
    ctr_barrier(cb);
    phase_resid(p, l, (const u16*)(p.ws + OFF_MERGED), 1024, (const u16*)(p.ws + OFF_WOUT) + (size_t)l * SZ_WOUT, 2, smem);
    ctr_barrier(cb);
    phase_norm(p, l, 1);
    ctr_barrier(cb);
#pragma unroll 1
    for (int rep = 0; rep < REP_FF1; ++rep) {
    phase_ff1(p, l, smem);
    ctr_barrier(cb);
    }
    phase_resid(p, l, (const u16*)(p.ws + OFF_HID), 4096, (const u16*)(p.ws + OFF_WFF2) + (size_t)l * SZ_WFF, 5, smem);
    ctr_barrier(cb);
  }
  phase_final(p);
}

extern "C" void kernel_launch(void* const* d_in, const int* in_sizes, int n_in, void* d_out, int out_size, void* d_ws,
                              size_t ws_size, hipStream_t stream) {
  static int grid_blocks = 0;
  if (!grid_blocks) {
    int dev = 0, cus = 0, per_cu = 0;
    (void)hipGetDevice(&dev);
    (void)hipDeviceGetAttribute(&cus, hipDeviceAttributeMultiprocessorCount, dev);
    (void)hipOccupancyMaxActiveBlocksPerMultiprocessor(&per_cu, trunk_megakernel, NTHR, 0);
    if (per_cu > 1) per_cu = 1;
    grid_blocks = (cus * per_cu / 8) * 8;
  }
  Params p{};
  for (int i = 0; i < 23; ++i) p.in[i] = (const float*)d_in[i];
  p.out = (float*)d_out;
  p.ws = (unsigned char*)d_ws;
  if (ws_size < WS_NEED) fprintf(stderr, "workspace too small: %zu < %zu\n", ws_size, (size_t)WS_NEED);
  void* args[] = {&p};
  hipError_t e = hipLaunchCooperativeKernel((void*)trunk_megakernel, dim3(grid_blocks), dim3(NTHR), args, 0, stream);
  if (e != hipSuccess) fprintf(stderr, "cooperative launch failed: %s (grid %d)\n", hipGetErrorString(e), grid_blocks);
}
```

```cpp
#include <hip/hip_runtime.h>
#include <hip/hip_cooperative_groups.h>
#include <cstdio>
namespace cg = cooperative_groups;

typedef unsigned short u16;
typedef short bf16x8 __attribute__((ext_vector_type(8)));
typedef float f32x4 __attribute__((ext_vector_type(4)));
#define DEVI __device__ __forceinline__

constexpr int M = 81920;
constexpr int MP = 65536;
constexpr int SMEM_BYTES = 131072;
constexpr int NTHR = 512;
constexpr int MH = M;

struct Params {
  const float* in[23];
  float* out;
  unsigned char* ws;
};

constexpr size_t SZ_WIN = 3072ull * 1024, SZ_WMERGE = 4ull * 1024 * 1024, SZ_WBRANCH = 4ull * 1024 * 256,
                 SZ_WOUT = 1024ull * 1024, SZ_WFF = 4096ull * 1024;
constexpr size_t OFF_WIN = 0;
constexpr size_t OFF_WMERGE = OFF_WIN + 2 * SZ_WIN * 2;
constexpr size_t OFF_WBRANCH = OFF_WMERGE + 2 * SZ_WMERGE * 2;
constexpr size_t OFF_WOUT = OFF_WBRANCH + 2 * SZ_WBRANCH * 2;
constexpr size_t OFF_WFF1 = OFF_WOUT + 2 * SZ_WOUT * 2;
constexpr size_t OFF_WFF2 = OFF_WFF1 + 2 * SZ_WFF * 2;
constexpr size_t OFF_MOD = OFF_WFF2 + 2 * SZ_WFF * 2;
constexpr size_t OFF_ROPE = OFF_MOD + 2ull * 18 * 6144 * 4;
constexpr size_t OFF_H = OFF_ROPE + 8192ull * 64 * 4;
constexpr size_t OFF_X = OFF_H + (size_t)M * 1024 * 2;
constexpr size_t C256 = (size_t)M * 256 * 2, C128 = (size_t)M * 128 * 2;
constexpr size_t OFF_RQ = OFF_X;
constexpr size_t OFF_RK = OFF_RQ + C256;
constexpr size_t OFF_RKT = OFF_RK + C256;
constexpr size_t OFF_RVT = OFF_RKT + C256;
constexpr size_t OFF_RG = OFF_RVT + C256;
constexpr size_t OFF_CA = OFF_RG + C256;
constexpr size_t OFF_CB = OFF_CA + C256;
constexpr size_t OFF_NQ = OFF_CB + C256;
constexpr size_t OFF_NK = OFF_NQ + C256;
constexpr size_t OFF_NVT = OFF_NK + C256;
constexpr size_t OFF_SQ = OFF_NVT + C256;
constexpr size_t OFF_SK = OFF_SQ + C256;
constexpr size_t OFF_SVT = OFF_SK + C128;
constexpr size_t OFF_U = OFF_SVT + C128;
constexpr size_t OFF_R = OFF_U + 2560ull * 2 * 4096 * 4;
constexpr size_t OFF_BR = OFF_R + 2560ull * 2 * 4096 * 2;
constexpr size_t OFF_END = OFF_BR + (size_t)M * 1024 * 2;
constexpr size_t OFF_BAR = OFF_END;
constexpr size_t WS_NEED = OFF_END + 65536 + 16ull * 524288;
static_assert(WS_NEED <= (1ull << 30), "fits the guaranteed 1 GiB workspace");
static_assert(C256 == 80ull * 524288 && 2560ull * 2 * 4096 * 4 == 160ull * 524288, "gate scratch slots");
constexpr size_t OFF_MERGED = OFF_BR;
constexpr size_t OFF_GSCR = OFF_X;
constexpr size_t OFF_GATES = OFF_X;
static_assert(OFF_GATES + (size_t)MH * 4096 * 2 <= OFF_END, "gates fit");
constexpr size_t OFF_HID = OFF_X;
static_assert(OFF_HID + (size_t)M * 4096 * 2 <= OFF_END, "hid fits");

DEVI u16 f2bf(float f) {
  unsigned u = __float_as_uint(f);
  u += 0x7fffu + ((u >> 16) & 1u);
  return (u16)(u >> 16);
}
DEVI float bf2f(u16 h) { return __uint_as_float(((unsigned)h) << 16); }
typedef __bf16 bf16x2_t __attribute__((ext_vector_type(2)));
typedef float f32x2_t __attribute__((ext_vector_type(2)));
DEVI unsigned pack2(float a, float b) {
  f32x2_t v = {a, b};
  bf16x2_t r = __builtin_convertvector(v, bf16x2_t);
  return __builtin_bit_cast(unsigned, r);
}
DEVI uint2 pack4(float a, float b, float c, float d) { return make_uint2(pack2(a, b), pack2(c, d)); }
DEVI float lo16(unsigned u) { return __uint_as_float(u << 16); }
DEVI float hi16(unsigned u) { return __uint_as_float(u & 0xffff0000u); }
union V8 { bf16x8 v; uint4 u; uint2 h[2]; };
DEVI f32x4 mfma16(bf16x8 a, bf16x8 b, f32x4 c) { return __builtin_amdgcn_mfma_f32_16x16x32_bf16(a, b, c, 0, 0, 0); }
DEVI float wave_sum(float v) {
#pragma unroll
  for (int o = 32; o; o >>= 1) v += __shfl_xor(v, o);
  return v;
}
DEVI float fast_rcp(float x) { return __builtin_amdgcn_rcpf(x); }
DEVI float fast_exp(float x) { return __builtin_amdgcn_exp2f(x * 1.4426950408889634f); }
DEVI float sigmoidf_(float x) { return fast_rcp(1.f + fast_exp(-x)); }
DEVI void tokinfo(int tok, int& seq, int& pos, int& T) {
  if (tok < MP) { seq = tok >> 12; pos = tok & 4095; T = 4096; }
  else { int u = tok - MP; seq = 16 + (u >> 13); pos = u & 8191; T = 8192; }
}
DEVI float log_sigmoid(float x) { return -log1pf(expf(-x)); }

DEVI int otid() { int t = threadIdx.x; asm volatile("" : "+v"(t)); return t; }
DEVI int obid() { int t = blockIdx.x; asm volatile("" : "+s"(t)); return t; }
DEVI u16* hbuf(const Params& p) { return (u16*)p.out; }
DEVI u16* brbuf(const Params& p) { return (u16*)p.out + (size_t)M * 1024; }
DEVI u16* xbuf(const Params& p) { return (u16*)(p.ws + OFF_H); }
template <int MI, int NI>
DEVI void gemm_mainloop(const u16* __restrict__ X, int ldx, const u16* __restrict__ Y, int ldy, int K,
                        f32x4 (&acc)[MI][NI], u16* smem) {
  constexpr int XR = MI * 32, YR = NI * 64, LD = 72;
  constexpr int XP = XR / 64, YP = YR / 64;
  u16* sX = smem;
  u16* sY = smem + 2 * XR * LD;
  const int tid = otid(), lane = tid & 63, wid = tid >> 6, wr = wid >> 2, wc = wid & 3, fr = lane & 15,
            fq = lane >> 4;
  const int lrow = tid >> 3, lch = tid & 7;
  uint4 rx[XP], ry[YP];
  const u16* xp = X + (size_t)lrow * ldx + lch * 8;
  const u16* yp = Y + (size_t)lrow * ldy + lch * 8;
#pragma unroll
  for (int i = 0; i < XP; ++i) rx[i] = *(const uint4*)(xp + (size_t)i * 64 * ldx);
#pragma unroll
  for (int i = 0; i < YP; ++i) ry[i] = *(const uint4*)(yp + (size_t)i * 64 * ldy);
#pragma unroll
  for (int i = 0; i < XP; ++i) *(uint4*)(sX + (lrow + i * 64) * LD + lch * 8) = rx[i];
#pragma unroll
  for (int i = 0; i < YP; ++i) *(uint4*)(sY + (lrow + i * 64) * LD + lch * 8) = ry[i];
  __syncthreads();
  const int nk = K >> 6;
  for (int kt = 0; kt < nk; ++kt) {
    const int cur = kt & 1;
    const bool more = (kt + 1 < nk);
    if (more) {
#pragma unroll
      for (int i = 0; i < XP; ++i) rx[i] = *(const uint4*)(xp + (size_t)i * 64 * ldx + (kt + 1) * 64);
#pragma unroll
      for (int i = 0; i < YP; ++i) ry[i] = *(const uint4*)(yp + (size_t)i * 64 * ldy + (kt + 1) * 64);
    }
    const u16* cx = sX + cur * XR * LD + (wr * MI * 16 + fr) * LD + fq * 8;
    const u16* cy = sY + cur * YR * LD + (wc * NI * 16 + fr) * LD + fq * 8;
#pragma unroll
    for (int ks = 0; ks < 2; ++ks) {
      bf16x8 a[MI], b[NI];
#pragma unroll
      for (int mi = 0; mi < MI; ++mi) a[mi] = *(const bf16x8*)(cx + mi * 16 * LD + ks * 32);
#pragma unroll
      for (int ni = 0; ni < NI; ++ni) b[ni] = *(const bf16x8*)(cy + ni * 16 * LD + ks * 32);
#pragma unroll
      for (int mi = 0; mi < MI; ++mi)
#pragma unroll
        for (int ni = 0; ni < NI; ++ni) acc[mi][ni] = mfma16(a[mi], b[ni], acc[mi][ni]);
    }
    if (more) {
      u16* dx = sX + (cur ^ 1) * XR * LD;
      u16* dy = sY + (cur ^ 1) * YR * LD;
#pragma unroll
      for (int i = 0; i < XP; ++i) *(uint4*)(dx + (lrow + i * 64) * LD + lch * 8) = rx[i];
#pragma unroll
      for (int i = 0; i < YP; ++i) *(uint4*)(dy + (lrow + i * 64) * LD + lch * 8) = ry[i];
    }
    __syncthreads();
  }
}

#define LAS __attribute__((address_space(3)))
namespace g8 {
constexpr int BM = 256, BK = 64, HALF = 128, HTB = HALF * BK * 2, NXCD = 8, WGM = 8;
DEVI int lds_byte(int r, int c) {
  const int st = (r >> 4) * 2 + (c >> 5), rr = r & 15, cc = c & 31, ob = rr * 64 + cc * 2;
  return st * 1024 + (ob ^ (((ob >> 9) & 1) << 5));
}
DEVI void stage_rc(int b, int& R, int& C) {
  const int st = b / 1024, sb = b % 1024, swz = sb ^ (((sb >> 9) & 1) << 5);
  R = (st >> 1) * 16 + swz / 64;
  C = (st & 1) * 32 + (swz % 64) / 2;
}
struct Unit { int pm, pn, aux, nt; size_t aoff, boff; };
struct Order {
  int nM, nN, nwg, G, c, K;
  DEVI void init(int nM_, int nN_, int G_, int c_, int K_ = 1024) { nM = nM_; nN = nN_; nwg = nM * nN; G = G_; c = c_; K = K_; }
  DEVI bool next(int i, Unit& u) const {
    const long L = (long)i * G + c;
    if (L >= nwg) return false;
    int wgid = (int)L;
    {
      const int q = nwg / NXCD, r = nwg % NXCD, xcd = wgid % NXCD, off = wgid / NXCD;
      wgid = (xcd < r ? xcd * (q + 1) : r * (q + 1) + (xcd - r) * q) + off;
    }
    const int nig = WGM * nN, gid = wgid / nig, fm = gid * WGM, gsz = (nM - fm) < WGM ? (nM - fm) : WGM;
    u.pm = fm + ((wgid % nig) % gsz);
    u.pn = (wgid % nig) / gsz;
    u.aux = 0;
    u.nt = K >> 6;
    u.aoff = (size_t)u.pm * 512 * K;
    u.boff = (size_t)u.pn * 512 * K;
    return true;
  }
};

DEVI int perm32(int rho) { const int n = rho >> 4, i = rho & 15; return 8 * (i >> 2) + 4 * n + (i & 3); }
template <bool PERM, class Epi, class Sched>
DEVI void gemm_phase(LAS unsigned char* lds, const u16* gA, const u16* gBt, const int K, const Sched& S, const Epi& E) {
  const int tid = otid(), wid = __builtin_amdgcn_readfirstlane(tid >> 6), lane = tid & 63, wr = wid >> 2, wc = wid & 3,
            fr = lane & 15, fq = lane >> 4;
  unsigned voffA[2], voffB[2];
#pragma unroll
  for (int i = 0; i < 2; ++i) {
    int R, C;
    stage_rc(tid * 16 + i * 8192, R, C);
    voffA[i] = (unsigned)(R * K + C) * 2u;
    const int Rb = PERM ? ((R & ~31) + perm32(R & 31)) : R;
    voffB[i] = (unsigned)(Rb * K + C) * 2u;
  }
  const size_t kstep = (size_t)(BK * 2);
  const size_t hstep = (size_t)HALF * K * 2;
  const unsigned ldsw = (unsigned)wid * 1024u;
  const int aoff = lds_byte(wr * 64 + fr, fq * 8), boff = lds_byte(wc * 32 + fr, fq * 8);
#define G8_SA(b, h) (((b) * 2 + (h)) * HTB)
#define G8_SB(b, h) ((4 + (b) * 2 + (h)) * HTB)
#define G8_STAGEV(bufoff, gbase, voff) do { _Pragma("unroll") for (int _i = 0; _i < 2; ++_i) \
    __builtin_amdgcn_global_load_lds((const unsigned*)((const char*)(gbase) + (voff)[_i]), (LAS unsigned*)(lds + (bufoff) + ldsw + _i * 8192), 16, 0, 0); } while (0)
#define G8_LDA(dst, b, h) do { _Pragma("unroll") for (int m = 0; m < 4; ++m) _Pragma("unroll") for (int k = 0; k < 2; ++k) dst[m][k] = *(const LAS bf16x8*)(lds + G8_SA(b, h) + aoff + m * 2048 + k * 1024); } while (0)
#define G8_LDB(dst, b, h) do { _Pragma("unroll") for (int n = 0; n < 2; ++n) _Pragma("unroll") for (int k = 0; k < 2; ++k) dst[n][k] = *(const LAS bf16x8*)(lds + G8_SB(b, h) + boff + n * 2048 + k * 1024); } while (0)
#define G8_MMA(ai, bj, At, Bt) do { __builtin_amdgcn_s_setprio(1); _Pragma("unroll") for (int m = 0; m < 4; ++m) _Pragma("unroll") for (int n = 0; n < 2; ++n) _Pragma("unroll") for (int k = 0; k < 2; ++k) \
    acc[ai][bj][m][n] = __builtin_amdgcn_mfma_f32_16x16x32_bf16(Bt[n][k], At[m][k], acc[ai][bj][m][n], 0, 0, 0); __builtin_amdgcn_s_setprio(0); } while (0)
#define G8_WAIT_V(n) asm volatile("s_waitcnt vmcnt(" #n ")" ::: "memory")
#define G8_WAIT_L(n) asm volatile("s_waitcnt lgkmcnt(" #n ")" ::: "memory")
#define G8_BAR __builtin_amdgcn_s_barrier()
#define G8_SCHED __builtin_amdgcn_sched_barrier(0)
  Unit cur, nxt;
  int ui = 0;
  if (!S.next(0, cur)) return;
  f32x4 acc[2][2][4][2];
#pragma unroll
  for (int a = 0; a < 2; ++a)
#pragma unroll
    for (int b = 0; b < 2; ++b)
#pragma unroll
      for (int m = 0; m < 4; ++m)
#pragma unroll
        for (int n = 0; n < 2; ++n) acc[a][b][m][n] = f32x4{0.f, 0.f, 0.f, 0.f};
  bf16x8 At[4][2], B0[2][2], B1[2][2];
  const char* cA = (const char*)gA + cur.aoff;
  const char* cB = (const char*)gBt + cur.boff;
  G8_STAGEV(G8_SB(0, 0), cB, voffB); G8_STAGEV(G8_SA(0, 0), cA, voffA); G8_STAGEV(G8_SB(0, 1), cB + hstep, voffB); G8_STAGEV(G8_SA(0, 1), cA + hstep, voffA);
  if (wr == 1) G8_BAR;
  G8_WAIT_V(4); G8_BAR;
  G8_STAGEV(G8_SB(1, 0), cB + kstep, voffB); G8_STAGEV(G8_SA(1, 0), cA + kstep, voffA); G8_STAGEV(G8_SB(1, 1), cB + hstep + kstep, voffB);
  G8_WAIT_V(6); G8_BAR;
  for (;;) {
    const bool has_next = S.next(ui + 1, nxt);
    const char* nA = has_next ? (const char*)gA + nxt.aoff : cA;
    const char* nB = has_next ? (const char*)gBt + nxt.boff : cB;
    const int nt = cur.nt;
    for (int t = 0; t < nt; t += 2) {
      const bool last = (t == nt - 2);
      const char* a1 = cA + (size_t)(t + 1) * kstep;
      const char* a2 = last ? nA : cA + (size_t)(t + 2) * kstep;
      const char* b2 = last ? nB : cB + (size_t)(t + 2) * kstep;
      const char* a3 = a2 + kstep;
      const char* b3 = b2 + kstep;
      G8_LDB(B0, 0, 0); G8_SCHED; G8_LDA(At, 0, 0); G8_STAGEV(G8_SA(1, 1), a1 + hstep, voffA);
      G8_WAIT_L(8); G8_BAR; G8_WAIT_L(0); G8_MMA(0, 0, At, B0); G8_BAR; G8_SCHED;
      G8_LDB(B1, 0, 1); G8_STAGEV(G8_SB(0, 0), b2, voffB);
      G8_BAR; G8_WAIT_L(0); G8_MMA(0, 1, At, B1); G8_BAR;
      G8_LDA(At, 0, 1); G8_STAGEV(G8_SA(0, 0), a2, voffA);
      G8_BAR; G8_WAIT_L(0); G8_MMA(1, 0, At, B0); G8_BAR; G8_SCHED;
      G8_STAGEV(G8_SB(0, 1), b2 + hstep, voffB);
      G8_WAIT_V(6); G8_BAR; G8_MMA(1, 1, At, B1); G8_BAR;
      G8_LDB(B0, 1, 0); G8_SCHED; G8_LDA(At, 1, 0); G8_STAGEV(G8_SA(0, 1), a2 + hstep, voffA);
      G8_WAIT_L(8); G8_BAR; G8_WAIT_L(0); G8_MMA(0, 0, At, B0); G8_BAR; G8_SCHED;
      G8_LDB(B1, 1, 1); G8_STAGEV(G8_SB(1, 0), b3, voffB);
      G8_BAR; G8_WAIT_L(0); G8_MMA(0, 1, At, B1); G8_BAR;
      G8_LDA(At, 1, 1); G8_STAGEV(G8_SA(1, 0), a3, voffA);
      G8_BAR; G8_WAIT_L(0); G8_MMA(1, 0, At, B0); G8_BAR; G8_SCHED;
      G8_STAGEV(G8_SB(1, 1), b3 + hstep, voffB);
      G8_WAIT_V(6); G8_BAR; G8_MMA(1, 1, At, B1); G8_BAR;
    }
    const bool zr = E(acc, cur, wr, wc, fr, fq);
    if (!has_next) break;
    if (zr)
#pragma unroll
    for (int a = 0; a < 2; ++a)
#pragma unroll
      for (int b = 0; b < 2; ++b)
#pragma unroll
        for (int m = 0; m < 4; ++m)
#pragma unroll
          for (int n = 0; n < 2; ++n) acc[a][b][m][n] = f32x4{0.f, 0.f, 0.f, 0.f};
    cur = nxt; cA = nA; cB = nB; ++ui;
  }
  G8_WAIT_V(0);
  if (wr == 0) G8_BAR;
  G8_BAR;
#undef G8_SA
#undef G8_SB
#undef G8_STAGEV
#undef G8_LDA
#undef G8_LDB
#undef G8_MMA
#undef G8_WAIT_V
#undef G8_WAIT_L
#undef G8_BAR
#undef G8_SCHED
}
}

template <int MI, int NI>
DEVI void zero_acc(f32x4 (&acc)[MI][NI]) {
#pragma unroll
  for (int mi = 0; mi < MI; ++mi)
#pragma unroll
    for (int ni = 0; ni < NI; ++ni) acc[mi][ni] = f32x4{0.f, 0.f, 0.f, 0.f};
}

DEVI void mod_item(const Params& p, int item, float* smf) {
  const int l = item / 192, n0 = (item % 192) * 32;
  const int tid = otid();
  for (int i = tid; i < 18 * 1024; i += NTHR) {
    int s = i >> 10, k = i & 1023;
    float c = s < 16 ? p.in[2][s * 1024 + k] : p.in[3][(s - 16) * 1024 + k];
    smf[i] = c / (1.f + expf(-c));
  }
  __syncthreads();
  const int ks = tid >> 5, col = tid & 31;
  float acc[18];
#pragma unroll
  for (int s = 0; s < 18; ++s) acc[s] = 0.f;
  const float* w = p.in[4] + ((size_t)l * 1024 + ks * 64) * 6144 + n0 + col;
#pragma unroll 4
  for (int k = 0; k < 64; ++k) {
    float wv = w[(size_t)k * 6144];
#pragma unroll
    for (int s = 0; s < 18; ++s) acc[s] += smf[s * 1024 + ks * 64 + k] * wv;
  }
  __syncthreads();
#pragma unroll
  for (int s = 0; s < 18; ++s) smf[(ks * 18 + s) * 32 + col] = acc[s];
  __syncthreads();
  float* mod = (float*)(p.ws + OFF_MOD);
  for (int i = tid; i < 18 * 32; i += NTHR) {
    int s = i >> 5, c = i & 31;
    float v = p.in[5][l * 6144 + n0 + c];
#pragma unroll
    for (int k2 = 0; k2 < 16; ++k2) v += smf[(k2 * 18 + s) * 32 + c];
    mod[(size_t)(l * 18 + s) * 6144 + n0 + c] = v;
  }
  __syncthreads();
}

DEVI void rope_table(const Params& p) {
  float* rope = (float*)(p.ws + OFF_ROPE);
  const int g0 = obid() * NTHR + otid(), gs = gridDim.x * NTHR;
  for (int g = g0; g < 8192 * 32; g += gs) {
    int pos = g >> 5, i = g & 31;
    float inv = (float)pow(10000.0, -(double)i / 32.0);
    float angf = (float)pos * inv;
    double x = (double)angf;
    const double TWO_PI = 6.283185307179586476925286766559;
    const double PI = 3.14159265358979323846264338327950288;
    double n = rint(x / TWO_PI);
    double r = x - n * TWO_PI;
    double cs = 1.0;
    if (r > 0.5 * PI) { r = PI - r; cs = -1.0; }
    else if (r < -0.5 * PI) { r = -PI - r; cs = -1.0; }
    double r2 = r * r;
    double sp = 1.0 / 51090942171709440000.0;
    sp = sp * r2 - 1.0 / 121645100408832000.0;
    sp = sp * r2 + 1.0 / 355687428096000.0;
    sp = sp * r2 - 1.0 / 1307674368000.0;
    sp = sp * r2 + 1.0 / 6227020800.0;
    sp = sp * r2 - 1.0 / 39916800.0;
    sp = sp * r2 + 1.0 / 362880.0;
    sp = sp * r2 - 1.0 / 5040.0;
    sp = sp * r2 + 1.0 / 120.0;
    sp = sp * r2 - 1.0 / 6.0;
    sp = sp * r2 + 1.0;
    double sn = sp * r;
    double cp = 1.0 / 2432902008176640000.0;
    cp = cp * r2 - 1.0 / 6402373705728000.0;
    cp = cp * r2 + 1.0 / 20922789888000.0;
    cp = cp * r2 - 1.0 / 87178291200.0;
    cp = cp * r2 + 1.0 / 479001600.0;
    cp = cp * r2 - 1.0 / 3628800.0;
    cp = cp * r2 + 1.0 / 40320.0;
    cp = cp * r2 - 1.0 / 720.0;
    cp = cp * r2 + 1.0 / 24.0;
    cp = cp * r2 - 0.5;
    cp = cp * r2 + 1.0;
    rope[pos * 64 + i] = (float)(cs * cp);
    rope[pos * 64 + 32 + i] = (float)sn;
  }
}

struct MapPlain { DEVI void operator()(int db, int& srcc, bool& perm) const { srcc = db * 64; perm = false; } };
struct MapWin {
  DEVI void operator()(int db, int& srcc, bool& perm) const {
    if (db < 32) {
      const int tile = db >> 2, b = db & 3;
      const int base = tile < 2 ? tile * 256 : (tile < 7 ? (tile + 1) * 256 : (tile + 2) * 256);
      srcc = base + b * 64;
      perm = tile < 2;
    } else {
      const int d2 = db - 32, tile = d2 >> 2, b = d2 & 3;
      if (tile == 0) srcc = 512 + b * 64;
      else if (tile == 1) srcc = 2048 + b * 64;
      else if (tile == 2) srcc = 256 + b * 64;
      else srcc = b < 2 ? 2688 + b * 64 : 2560 + (b - 2) * 64;
      perm = false;
    }
  }
};
template <class MapF>
DEVI void xpose_convert(const float* __restrict__ src, int K, int N, int NB, u16* __restrict__ dst, int rot, float* smf, MapF map, int DK = 0, int koff = 0) {
  if (DK == 0) DK = K;
  const int tid = otid();
  const int ntile = (K >> 6) * NB;
  const int G = gridDim.x;
  int start = (int)obid() - (rot % G);
  if (start < 0) start += G;
  for (int t = start; t < ntile; t += G) {
    const int k0 = (t / NB) << 6, db = t % NB;
    int srcc; bool perm;
    map(db, srcc, perm);
    {
      const int ch = tid & 15, kr = tid >> 4;
#pragma unroll
      for (int ps = 0; ps < 2; ++ps) {
        int k = ps * 32 + kr;
        float4 v = *(const float4*)(src + (size_t)(k0 + k) * N + srcc + ch * 4);
        float* d = smf + k * 65 + ch * 4;
        d[0] = v.x; d[1] = v.y; d[2] = v.z; d[3] = v.w;
      }
    }
    __syncthreads();
    {
      const int kc = tid & 7, n = tid >> 3;
      const int nc = perm ? ((n >> 5) * 16 + (n & 15) + ((n >> 4) & 1) * 32) : n;
      const float* sp = smf + (kc * 8) * 65 + nc;
      uint4 o;
      o.x = pack2(sp[0], sp[65]);
      o.y = pack2(sp[2 * 65], sp[3 * 65]);
      o.z = pack2(sp[4 * 65], sp[5 * 65]);
      o.w = pack2(sp[6 * 65], sp[7 * 65]);
      *(uint4*)(dst + (size_t)(db * 64 + n) * DK + koff + k0 + kc * 8) = o;
    }
    __syncthreads();
  }
}

DEVI void phase0(const Params& p, unsigned char* smem) {
  float* smf = (float*)smem;
  for (int it = obid(); it < 384; it += gridDim.x) mod_item(p, it, smf);
  rope_table(p);
  int rot = 384;
  for (int l = 0; l < 2; ++l) {
    xpose_convert(p.in[7] + (size_t)l * 2816 * 1024, 1024, 2816, 48, (u16*)(p.ws + OFF_WIN) + (size_t)l * SZ_WIN, rot, smf, MapWin());
    rot += 768;
    for (int i = 0; i < 4; ++i) {
      xpose_convert(p.in[18] + ((size_t)l * 4 + i) * 1024 * 1024, 1024, 1024, 16,
                    (u16*)(p.ws + OFF_WMERGE) + ((size_t)l * 4 + i) * 1024 * 1024, rot, smf, MapPlain());
      rot += 256;
    }
    for (int i = 0; i < 4; ++i) {
      xpose_convert(p.in[17] + ((size_t)l * 4 + i) * 256 * 1024, 256, 1024, 16,
                    (u16*)(p.ws + OFF_WBRANCH) + (size_t)l * SZ_WBRANCH, rot, smf, MapPlain(), 1024, i * 256);
      rot += 64;
    }
    xpose_convert(p.in[19] + (size_t)l * SZ_WOUT, 1024, 1024, 16, (u16*)(p.ws + OFF_WOUT) + (size_t)l * SZ_WOUT, rot, smf, MapPlain());
    rot += 256;
    xpose_convert(p.in[20] + (size_t)l * SZ_WFF, 1024, 4096, 64, (u16*)(p.ws + OFF_WFF1) + (size_t)l * SZ_WFF, rot, smf, MapPlain());
    rot += 1024;
    xpose_convert(p.in[21] + (size_t)l * SZ_WFF, 4096, 1024, 16, (u16*)(p.ws + OFF_WFF2) + (size_t)l * SZ_WFF, rot, smf, MapPlain());
    rot += 1024;
  }
}

DEVI void phase_norm(const Params& p, int layer, int which) {
  const int lane = otid() & 63, wid = otid() >> 6;
  const float* mod = (const float*)(p.ws + OFF_MOD);
  u16* H = hbuf(p);
  const u16* XB = xbuf(p);
  const float* gain = p.in[6] + (layer * 2 + which) * 1024;
  const bool first = (layer == 0 && which == 0);
  float4 g[4];
#pragma unroll
  for (int i = 0; i < 2; ++i) {
    g[2 * i] = *(const float4*)(gain + i * 512 + lane * 8);
    g[2 * i + 1] = *(const float4*)(gain + i * 512 + lane * 8 + 4);
  }
  for (int tp = obid() * 8 + wid; tp < M / 2; tp += gridDim.x * 8) {
    const int tok = tp * 2;
    int seq, pos, T;
    tokinfo(tok, seq, pos, T);
    float4 v[2][4];
    if (first) {
      const float* xr = tok < MP ? p.in[0] + (size_t)tok * 1024 : p.in[1] + (size_t)(tok - MP) * 1024;
#pragma unroll
      for (int k = 0; k < 2; ++k)
#pragma unroll
        for (int i = 0; i < 2; ++i) {
          v[k][2 * i] = *(const float4*)(xr + k * 1024 + i * 512 + lane * 8);
          v[k][2 * i + 1] = *(const float4*)(xr + k * 1024 + i * 512 + lane * 8 + 4);
        }
    } else {
      const u16* xr = XB + (size_t)tok * 1024;
#pragma unroll
      for (int k = 0; k < 2; ++k)
#pragma unroll
        for (int i = 0; i < 2; ++i) {
          const uint4 w = *(const uint4*)(xr + k * 1024 + i * 512 + lane * 8);
          v[k][2 * i] = make_float4(lo16(w.x), hi16(w.x), lo16(w.y), hi16(w.y));
          v[k][2 * i + 1] = make_float4(lo16(w.z), hi16(w.z), lo16(w.w), hi16(w.w));
        }
    }
    const float* msh = mod + (size_t)(layer * 18 + seq) * 6144 + (which ? 3 : 0) * 1024;
    const float* msc = msh + 1024;
    float4 sh[4], sc[4];
#pragma unroll
    for (int i = 0; i < 2; ++i) {
      const int c = i * 512 + lane * 8;
      sh[2 * i] = *(const float4*)(msh + c); sh[2 * i + 1] = *(const float4*)(msh + c + 4);
      sc[2 * i] = *(const float4*)(msc + c); sc[2 * i + 1] = *(const float4*)(msc + c + 4);
    }
    asm volatile("" ::: "memory");
    float ss0 = 0.f, ss1 = 0.f;
#pragma unroll
    for (int i = 0; i < 4; ++i) {
      ss0 += v[0][i].x * v[0][i].x + v[0][i].y * v[0][i].y + v[0][i].z * v[0][i].z + v[0][i].w * v[0][i].w;
      ss1 += v[1][i].x * v[1][i].x + v[1][i].y * v[1][i].y + v[1][i].z * v[1][i].z + v[1][i].w * v[1][i].w;
    }
    ss0 = wave_sum(ss0);
    ss1 = wave_sum(ss1);
    const float rs[2] = {rsqrtf(ss0 * (1.f / 1024.f) + 1e-6f), rsqrtf(ss1 * (1.f / 1024.f) + 1e-6f)};
#pragma unroll
    for (int k = 0; k < 2; ++k)
#pragma unroll
      for (int i = 0; i < 2; ++i) {
        const float rstd = rs[k];
        const float4 xa = v[k][2 * i], xb = v[k][2 * i + 1];
        const float4 ga = g[2 * i], gb = g[2 * i + 1], sa = sc[2 * i], sb2 = sc[2 * i + 1], ha = sh[2 * i], hb = sh[2 * i + 1];
        uint4 w;
        w.x = pack2(xa.x * rstd * ga.x * (1.f + sa.x) + ha.x, xa.y * rstd * ga.y * (1.f + sa.y) + ha.y);
        w.y = pack2(xa.z * rstd * ga.z * (1.f + sa.z) + ha.z, xa.w * rstd * ga.w * (1.f + sa.w) + ha.w);
        w.z = pack2(xb.x * rstd * gb.x * (1.f + sb2.x) + hb.x, xb.y * rstd * gb.y * (1.f + sb2.y) + hb.y);
        w.w = pack2(xb.z * rstd * gb.z * (1.f + sb2.z) + hb.z, xb.w * rstd * gb.w * (1.f + sb2.w) + hb.w);
        *(uint4*)(H + (size_t)(tok + k) * 1024 + i * 512 + lane * 8) = w;
      }
  }
}

DEVI void phase_final(const Params& p) {
  const int lane = otid() & 63, wid = otid() >> 6;
  const float* gain = p.in[22];
  const u16* XB = xbuf(p);
  float4 gg[4];
#pragma unroll
  for (int i = 0; i < 2; ++i) {
    gg[2 * i] = *(const float4*)(gain + i * 512 + lane * 8);
    gg[2 * i + 1] = *(const float4*)(gain + i * 512 + lane * 8 + 4);
  }
  for (int tp = obid() * 8 + wid; tp < M / 2; tp += gridDim.x * 8) {
    const u16* xr = XB + (size_t)tp * 2048;
    float* orow = p.out + (size_t)tp * 2048;
    float4 v[2][4];
#pragma unroll
    for (int k = 0; k < 2; ++k)
#pragma unroll
      for (int i = 0; i < 2; ++i) {
        const uint4 w = *(const uint4*)(xr + k * 1024 + i * 512 + lane * 8);
        v[k][2 * i] = make_float4(lo16(w.x), hi16(w.x), lo16(w.y), hi16(w.y));
        v[k][2 * i + 1] = make_float4(lo16(w.z), hi16(w.z), lo16(w.w), hi16(w.w));
      }
    asm volatile("" ::: "memory");
    float ss0 = 0.f, ss1 = 0.f;
#pragma unroll
    for (int i = 0; i < 4; ++i) {
      ss0 += v[0][i].x * v[0][i].x + v[0][i].y * v[0][i].y + v[0][i].z * v[0][i].z + v[0][i].w * v[0][i].w;
      ss1 += v[1][i].x * v[1][i].x + v[1][i].y * v[1][i].y + v[1][i].z * v[1][i].z + v[1][i].w * v[1][i].w;
    }
    ss0 = wave_sum(ss0);
    ss1 = wave_sum(ss1);
    const float rs[2] = {rsqrtf(ss0 * (1.f / 1024.f) + 1e-6f), rsqrtf(ss1 * (1.f / 1024.f) + 1e-6f)};
#pragma unroll
    for (int k = 0; k < 2; ++k)
#pragma unroll
      for (int i = 0; i < 4; ++i) {
        const int c = (i >> 1) * 512 + lane * 8 + (i & 1) * 4;
        float4 o;
        o.x = v[k][i].x * rs[k] * gg[i].x; o.y = v[k][i].y * rs[k] * gg[i].y;
        o.z = v[k][i].z * rs[k] * gg[i].z; o.w = v[k][i].w * rs[k] * gg[i].w;
        *(float4*)(orow + k * 1024 + c) = o;
      }
  }
}

struct EpiG1Nat {
  unsigned char* ws;
  DEVI bool operator()(f32x4 (&acc)[2][2][4][2], const g8::Unit& u, int wr, int wc, int fr, int fq) const {
    const int t0 = u.pm * 256, pn = u.pn;
    int seq, pos0, T;
    tokinfo(t0, seq, pos0, T);
    if (pn < 2) {
      const float* rope = (const float*)(ws + OFF_ROPE);
      u16* dst = (u16*)(ws + (pn == 0 ? OFF_RQ : OFF_RK));
      const float scale = pn == 0 ? 0.125f : 1.f;
      const int d1 = (wc & 1) * 16 + fq * 4;
      const float* rp0 = rope + (size_t)(pos0 + wr * 64 + fr) * 64 + d1;
      u16* o0 = dst + (size_t)(t0 + wr * 64 + fr) * 256 + (wc >> 1) * 64 + d1;
#pragma unroll
      for (int ai = 0; ai < 2; ++ai) {
        float4 cc[4], ss[4];
#pragma unroll
        for (int m = 0; m < 4; ++m) {
          const float* rp = rp0 + (ai * 128 + m * 16) * 64;
          cc[m] = *(const float4*)rp;
          ss[m] = *(const float4*)(rp + 32);
        }
        asm volatile("" ::: "memory");
#pragma unroll
        for (int m = 0; m < 4; ++m) {
          const float4 c = cc[m], sn = ss[m];
#pragma unroll
          for (int bj = 0; bj < 2; ++bj) {
            const f32x4 x1 = acc[ai][bj][m][0], x2 = acc[ai][bj][m][1];
            u16* o = o0 + (ai * 128 + m * 16) * 256 + bj * 128;
            *(uint2*)o = pack4((x1[0] * c.x - x2[0] * sn.x) * scale, (x1[1] * c.y - x2[1] * sn.y) * scale,
                               (x1[2] * c.z - x2[2] * sn.z) * scale, (x1[3] * c.w - x2[3] * sn.w) * scale);
            *(uint2*)(o + 32) = pack4((x1[0] * sn.x + x2[0] * c.x) * scale, (x1[1] * sn.y + x2[1] * c.y) * scale,
                                      (x1[2] * sn.z + x2[2] * c.z) * scale, (x1[3] * sn.w + x2[3] * c.w) * scale);
          }
        }
        asm volatile("" ::: "memory");
      }
    } else {
      size_t off; int width = 256, op = 0; float scale = 1.f;
      if (pn == 2) { off = OFF_RG; op = 2; }
      else if (pn == 3) { off = OFF_CA; }
      else if (pn == 4) { off = OFF_CB; op = 3; }
      else if (pn == 5) { off = OFF_NQ; scale = 0.125f; }
      else if (pn == 6) { off = OFF_NK; }
      else if (pn == 7) { off = OFF_SQ; scale = 0.125f; }
      else { off = OFF_SK; width = 128; }
      u16* o0 = (u16*)(ws + off) + (size_t)(t0 + wr * 64 + fr) * width + wc * 32 + fq * 4;
#pragma unroll
      for (int ai = 0; ai < 2; ++ai)
#pragma unroll
        for (int m = 0; m < 4; ++m) {
          u16* orow = o0 + (size_t)((ai * 128 + m * 16) * width);
#pragma unroll
          for (int bj = 0; bj < 2; ++bj) {
            if (pn == 8 && bj == 1) continue;
#pragma unroll
            for (int n = 0; n < 2; ++n) {
              const f32x4 v = acc[ai][bj][m][n];
              float q0, q1, q2, q3;
              if (op == 2) { q0 = v[0] * sigmoidf_(v[0]); q1 = v[1] * sigmoidf_(v[1]); q2 = v[2] * sigmoidf_(v[2]); q3 = v[3] * sigmoidf_(v[3]); }
              else if (op == 3) { q0 = sigmoidf_(v[0]); q1 = sigmoidf_(v[1]); q2 = sigmoidf_(v[2]); q3 = sigmoidf_(v[3]); }
              else { q0 = v[0] * scale; q1 = v[1] * scale; q2 = v[2] * scale; q3 = v[3] * scale; }
              *(uint2*)(orow + bj * 128 + n * 16) = pack4(q0, q1, q2, q3);
            }
          }
          asm volatile("" ::: "memory");
        }
    }
    return true;
  }
};
struct EpiG1Tr {
  unsigned char* ws;
  DEVI bool operator()(f32x4 (&acc)[2][2][4][2], const g8::Unit& u, int wr, int wc, int fr, int fq) const {
    const int pm = u.pm, tb = u.pn * 256;
    int seq, pos0, T;
    tokinfo(tb, seq, pos0, T);
    if (pm == 2) {
      const float* rope = (const float*)(ws + OFF_ROPE);
      u16* dst = (u16*)(ws + OFF_RKT);
      const float* rp0 = rope + (size_t)(pos0 + wc * 32 + fq * 8) * 64 + fr;
      u16* o0 = dst + (size_t)(wr * 64 + fr) * M + tb + wc * 32 + fq * 8;
#pragma unroll
      for (int ai = 0; ai < 2; ++ai)
#pragma unroll
        for (int m = 0; m < 2; ++m) {
          float cv[2][2][4], sv[2][2][4];
#pragma unroll
          for (int bj = 0; bj < 2; ++bj)
#pragma unroll
            for (int n = 0; n < 2; ++n) {
              const float* rp = rp0 + (bj * 128 + n * 4) * 64 + m * 16;
#pragma unroll
              for (int j = 0; j < 4; ++j) { cv[bj][n][j] = rp[j * 64]; sv[bj][n][j] = rp[j * 64 + 32]; }
            }
          asm volatile("" ::: "memory");
#pragma unroll
          for (int bj = 0; bj < 2; ++bj) {
            float o1[2][4], o2[2][4];
#pragma unroll
            for (int n = 0; n < 2; ++n) {
              const f32x4 x1 = acc[ai][bj][m][n], x2 = acc[ai][bj][m + 2][n];
#pragma unroll
              for (int j = 0; j < 4; ++j) {
                const float c = cv[bj][n][j], sn = sv[bj][n][j];
                o1[n][j] = x1[j] * c - x2[j] * sn;
                o2[n][j] = x1[j] * sn + x2[j] * c;
              }
            }
            u16* o = o0 + (size_t)(ai * 128 + m * 16) * M + bj * 128;
            uint4 w1, w2;
            w1.x = pack2(o1[0][0], o1[0][1]); w1.y = pack2(o1[0][2], o1[0][3]); w1.z = pack2(o1[1][0], o1[1][1]); w1.w = pack2(o1[1][2], o1[1][3]);
            w2.x = pack2(o2[0][0], o2[0][1]); w2.y = pack2(o2[0][2], o2[0][3]); w2.z = pack2(o2[1][0], o2[1][1]); w2.w = pack2(o2[1][2], o2[1][3]);
            *(uint4*)o = w1;
            *(uint4*)(o + (size_t)32 * M) = w2;
          }
          asm volatile("" ::: "memory");
        }
    } else {
      u16* dst = (u16*)(ws + (pm == 0 ? OFF_RVT : (pm == 1 ? OFF_NVT : OFF_SVT)));
      u16* o0 = dst + (size_t)(wr * 64 + fr) * M + tb + wc * 32 + fq * 8;
      const long half1 = pm == 3 ? ((long)(OFF_SK - OFF_SVT) / 2 - (long)128 * M) : 0;
#pragma unroll
      for (int ai = 0; ai < 2; ++ai) {
#pragma unroll
        for (int m = 0; m < 4; ++m) {
          u16* orow = o0 + (size_t)(ai * 128 + m * 16) * M + (ai ? half1 : 0);
#pragma unroll
          for (int bj = 0; bj < 2; ++bj) {
            const f32x4 v0 = acc[ai][bj][m][0], v1 = acc[ai][bj][m][1];
            uint4 w;
            w.x = pack2(v0[0], v0[1]); w.y = pack2(v0[2], v0[3]); w.z = pack2(v1[0], v1[1]); w.w = pack2(v1[2], v1[3]);
            *(uint4*)(orow + bj * 128) = w;
          }
          asm volatile("" ::: "memory");
        }
      }
    }
    return true;
  }
};
DEVI void phase_gemm1(const Params& p, int layer, unsigned char* smem) {
  const u16* H = hbuf(p);
  const u16* W = (const u16*)(p.ws + OFF_WIN) + (size_t)layer * SZ_WIN;
  g8::Order S;
  S.init(M / 256, 8, gridDim.x, obid(), 1024);
  EpiG1Nat e1{p.ws};
  g8::gemm_phase<false>((LAS unsigned char*)smem, H, W, 1024, S, e1);
  g8::Order S2;
  S2.init(4, M / 256, gridDim.x, obid(), 1024);
  EpiG1Tr e2{p.ws};
  g8::gemm_phase<true>((LAS unsigned char*)smem, W + (size_t)2048 * 1024, H, 1024, S2, e2);
}

DEVI int vrow(int d) { return (d & 32) + ((d >> 2) & 1) * 16 + ((d >> 3) & 3) * 4 + (d & 3); }
DEVI void phase_ret_u(const Params& p, int layer) {
  const int lane = otid() & 63, wid = otid() >> 6, fr = lane & 15, fq = lane >> 4;
  const u16* RKT = (const u16*)(p.ws + OFF_RKT);
  const u16* RVT = (const u16*)(p.ws + OFF_RVT);
  float* U = (float*)(p.ws + OFF_U);
  for (int u = obid() * 8 + wid; u < 2560; u += gridDim.x * 8) {
    const int h = u & 3, cgi = u >> 2, tok0 = cgi * 128;
    const float l2f = log_sigmoid(p.in[8][(layer * 2 + 0) * 4 + h]) * 1.4426950408889634f;
    const float l2b = log_sigmoid(p.in[8][(layer * 2 + 1) * 4 + h]) * 1.4426950408889634f;
#pragma unroll 1
    for (int hf = 0; hf < 2; ++hf) {
      f32x4 aF[4][2], aB[4][2];
      zero_acc<4, 2>(aF);
      zero_acc<4, 2>(aB);
#pragma unroll 1
      for (int ks = 0; ks < 4; ++ks) {
        const int m0 = ks * 32 + fq * 8;
        bf16x8 av[4];
#pragma unroll
        for (int dvt = 0; dvt < 4; ++dvt)
          av[dvt] = *(const bf16x8*)(RVT + (size_t)(h * 64 + dvt * 16 + fr) * M + tok0 + m0);
#pragma unroll
        for (int d2 = 0; d2 < 2; ++d2) {
          const int dkt = hf * 2 + d2;
          uint4 kr = *(const uint4*)(RKT + (size_t)(h * 64 + dkt * 16 + fr) * M + tok0 + m0);
          const unsigned kw[4] = {kr.x, kr.y, kr.z, kr.w};
          V8 kf, kb;
          unsigned of_[4], ob_[4];
#pragma unroll
          for (int e2 = 0; e2 < 4; ++e2) {
            const int m = m0 + e2 * 2;
            const float zf0 = exp2f(l2f * (float)(127 - m)), zf1 = exp2f(l2f * (float)(126 - m));
            const float zb0 = exp2f(l2b * (float)m), zb1 = exp2f(l2b * (float)(m + 1));
            of_[e2] = pack2(lo16(kw[e2]) * zf0, hi16(kw[e2]) * zf1);
            ob_[e2] = pack2(lo16(kw[e2]) * zb0, hi16(kw[e2]) * zb1);
          }
          kf.u = make_uint4(of_[0], of_[1], of_[2], of_[3]);
          kb.u = make_uint4(ob_[0], ob_[1], ob_[2], ob_[3]);
#pragma unroll
          for (int dvt = 0; dvt < 4; ++dvt) {
            aF[dvt][d2] = mfma16(av[dvt], kf.v, aF[dvt][d2]);
            aB[dvt][d2] = mfma16(av[dvt], kb.v, aB[dvt][d2]);
          }
        }
      }
      float* uf = U + (size_t)(u * 2 + 0) * 4096;
      float* ub = U + (size_t)(u * 2 + 1) * 4096;
#pragma unroll
      for (int dvt = 0; dvt < 4; ++dvt)
#pragma unroll
        for (int d2 = 0; d2 < 2; ++d2)
#pragma unroll
          for (int j = 0; j < 4; ++j) {
            const int idx = (dvt * 16 + fq * 4 + j) * 64 + (hf * 2 + d2) * 16 + fr;
            uf[idx] = aF[dvt][d2][j];
            ub[idx] = aB[dvt][d2][j];
          }
    }
  }
}

DEVI void phase_ret_scan(const Params& p, int layer) {
  const float* U = (const float*)(p.ws + OFF_U);
  u16* R = (u16*)(p.ws + OFF_R);
  const int total = 72 * 2 * 4096;
  for (int g = obid() * NTHR + otid(); g < total; g += gridDim.x * NTHR) {
    const int e = g & 4095, dir = (g >> 12) & 1, bh = g >> 13, h = bh & 3, b = bh >> 2;
    int base, N;
    if (b < 16) { base = b * 32; N = 32; } else { base = 512 + (b - 16) * 64; N = 64; }
    const float gC = expf(128.f * log_sigmoid(p.in[8][(layer * 2 + dir) * 4 + h]));
    float run = 0.f;
    const int nb = N >> 4;
#pragma unroll 1
    for (int bb = 0; bb < nb; ++bb) {
      float uv[16];
#pragma unroll
      for (int k = 0; k < 16; ++k) {
        const int n = dir == 0 ? (bb * 16 + k) : (N - 1 - (bb * 16 + k));
        uv[k] = U[((size_t)((base + n) * 4 + h) * 2 + dir) * 4096 + e];
      }
      asm volatile("" ::: "memory");
#pragma unroll
      for (int k = 0; k < 16; ++k) {
        const int n = dir == 0 ? (bb * 16 + k) : (N - 1 - (bb * 16 + k));
        R[((size_t)((base + n) * 4 + h) * 2 + dir) * 4096 + e] = f2bf(run);
        run = gC * run + uv[k];
      }
    }
  }
}

DEVI void phase_ret_out(const Params& p, int layer, unsigned char* smem) {
  constexpr int KLD = 68, VLD = 136, RLD = 72;
  u16* Ks = (u16*)smem;
  u16* Vs = (u16*)(smem + 17408);
  u16* Rfs = (u16*)(smem + 34816);
  u16* Rbs = (u16*)(smem + 44032);
  const int tid = otid(), lane = tid & 63, wid = tid >> 6, fr = lane & 15, fq = lane >> 4;
  const u16* RQ = (const u16*)(p.ws + OFF_RQ);
  const u16* RK = (const u16*)(p.ws + OFF_RK);
  const u16* RVT = (const u16*)(p.ws + OFF_RVT);
  const u16* RG = (const u16*)(p.ws + OFF_RG);
  const u16* R = (const u16*)(p.ws + OFF_R);
  u16* BR = brbuf(p);
  const float* gn = p.in[9] + layer * 256;
  for (int it = obid(); it < 2560; it += gridDim.x) {
    const int h = it & 3, cgi = it >> 2, ctok0 = cgi * 128, c0 = wid * 16, tok0 = ctok0 + c0;
    for (int c = tid; c < 3072; c += NTHR) {
      if (c < 1024) {
        const int k = c >> 3, part = c & 7;
        const uint4 v = *(const uint4*)(RK + (size_t)(ctok0 + k) * 256 + h * 64 + part * 8);
        uint2* d = (uint2*)(Ks + k * KLD + part * 8);
        d[0] = make_uint2(v.x, v.y);
        d[1] = make_uint2(v.z, v.w);
      } else if (c < 2048) {
        const int c2 = c - 1024, d = c2 >> 4, part = c2 & 15;
        *(uint4*)(Vs + vrow(d) * VLD + part * 8) = *(const uint4*)(RVT + (size_t)(h * 64 + d) * M + ctok0 + part * 8);
      } else {
        const int c2 = c - 2048, dir = c2 >> 9, c3 = c2 & 511, dv = c3 >> 3, part = c3 & 7;
        *(uint4*)((dir ? Rbs : Rfs) + vrow(dv) * RLD + part * 8) =
            *(const uint4*)(R + (size_t)((cgi * 4 + h) * 2 + dir) * 4096 + dv * 64 + part * 8);
      }
    }
    __syncthreads();
    const float l2f = log_sigmoid(p.in[8][(layer * 2 + 0) * 4 + h]) * 1.4426950408889634f;
    const float l2b = log_sigmoid(p.in[8][(layer * 2 + 1) * 4 + h]) * 1.4426950408889634f;
    const u16* qp = RQ + (size_t)(tok0 + fr) * 256 + h * 64 + fq * 8;
    const bf16x8 q0 = *(const bf16x8*)qp, q1 = *(const bf16x8*)(qp + 32);
    const int c = c0 + fr;
    f32x4 s[8];
    const u16* kl0 = Ks + (8 * (fr >> 2) + (fr & 3)) * KLD + fq * 8;
#pragma unroll
    for (int t = 0; t < 8; ++t) {
      const u16* kp = kl0 + ((t >> 1) * 32 + (t & 1) * 4) * KLD;
      V8 k0, k1;
      k0.h[0] = *(const uint2*)kp;        k0.h[1] = *(const uint2*)(kp + 4);
      k1.h[0] = *(const uint2*)(kp + 32); k1.h[1] = *(const uint2*)(kp + 36);
      f32x4 a = {0.f, 0.f, 0.f, 0.f};
      a = mfma16(k0.v, q0, a);
      a = mfma16(k1.v, q1, a);
#pragma unroll
      for (int j = 0; j < 4; ++j) {
        const int m = (t >> 1) * 32 + 8 * fq + 4 * (t & 1) + j;
        const int diff = c - m;
        const float dec = diff >= 0 ? __builtin_amdgcn_exp2f(l2f * (float)diff) : __builtin_amdgcn_exp2f(l2b * (float)(-diff));
        a[j] *= dec;
      }
      s[t] = a;
      asm volatile("" ::: "memory");
    }
    f32x4 o[4], iF[4], iB[4];
#pragma unroll
    for (int dt = 0; dt < 4; ++dt) { o[dt] = f32x4{0.f, 0.f, 0.f, 0.f}; iF[dt] = o[dt]; iB[dt] = o[dt]; }
    const u16* vl0 = Vs + fr * VLD + fq * 8;
#pragma unroll
    for (int ks = 0; ks < 4; ++ks) {
      V8 pb;
      pb.h[0] = pack4(s[2 * ks][0], s[2 * ks][1], s[2 * ks][2], s[2 * ks][3]);
      pb.h[1] = pack4(s[2 * ks + 1][0], s[2 * ks + 1][1], s[2 * ks + 1][2], s[2 * ks + 1][3]);
#pragma unroll
      for (int dt = 0; dt < 4; ++dt) {
        V8 va;
        va.u = *(const uint4*)(vl0 + dt * 16 * VLD + ks * 32);
        o[dt] = mfma16(va.v, pb.v, o[dt]);
      }
      asm volatile("" ::: "memory");
    }
    {
      const u16* rf = Rfs + fr * RLD + fq * 8;
      const u16* rb = Rbs + fr * RLD + fq * 8;
#pragma unroll
      for (int dt = 0; dt < 4; ++dt) {
        iF[dt] = mfma16(*(const bf16x8*)(rf + dt * 16 * RLD), q0, iF[dt]);
        iF[dt] = mfma16(*(const bf16x8*)(rf + dt * 16 * RLD + 32), q1, iF[dt]);
        iB[dt] = mfma16(*(const bf16x8*)(rb + dt * 16 * RLD), q0, iB[dt]);
        iB[dt] = mfma16(*(const bf16x8*)(rb + dt * 16 * RLD + 32), q1, iB[dt]);
      }
    }
    const float xif = exp2f(l2f * (float)(c + 1)), xib = exp2f(l2b * (float)(128 - c));
    float sum = 0.f;
#pragma unroll
    for (int dt = 0; dt < 4; ++dt)
#pragma unroll
      for (int j = 0; j < 4; ++j) {
        o[dt][j] += xif * iF[dt][j] + xib * iB[dt][j];
        sum += o[dt][j];
      }
    sum += __shfl_xor(sum, 16);
    sum += __shfl_xor(sum, 32);
    const float mu = sum * (1.f / 64.f);
    float vs = 0.f;
#pragma unroll
    for (int dt = 0; dt < 4; ++dt)
#pragma unroll
      for (int j = 0; j < 4; ++j) { float d = o[dt][j] - mu; vs += d * d; }
    vs += __shfl_xor(vs, 16);
    vs += __shfl_xor(vs, 32);
    const float rstd = rsqrtf(vs * (1.f / 64.f) + 1e-6f);
#pragma unroll
    for (int pp = 0; pp < 2; ++pp) {
      const int ch = h * 64 + pp * 32 + fq * 8;
      const float4 ga = *(const float4*)(gn + ch), gb = *(const float4*)(gn + ch + 4);
      const uint4 sg = *(const uint4*)(RG + (size_t)(tok0 + fr) * 256 + ch);
      const f32x4 oa = o[2 * pp], ob = o[2 * pp + 1];
      uint4 w;
      w.x = pack2((oa[0] - mu) * rstd * ga.x * lo16(sg.x), (oa[1] - mu) * rstd * ga.y * hi16(sg.x));
      w.y = pack2((oa[2] - mu) * rstd * ga.z * lo16(sg.y), (oa[3] - mu) * rstd * ga.w * hi16(sg.y));
      w.z = pack2((ob[0] - mu) * rstd * gb.x * lo16(sg.z), (ob[1] - mu) * rstd * gb.y * hi16(sg.z));
      w.w = pack2((ob[2] - mu) * rstd * gb.z * lo16(sg.w), (ob[3] - mu) * rstd * gb.w * hi16(sg.w));
      *(uint4*)(BR + (size_t)(tok0 + fr) * 1024 + ch) = w;
    }
    __syncthreads();
  }
}

DEVI void phase_conv(const Params& p, int layer, unsigned char* smem) {
  const int tid = otid(), lane = tid & 63, wid = tid >> 6, half = tid >> 8, ct = tid & 255;
  float* su = (float*)smem + half * (62 * 256);
  const u16* CA = (const u16*)(p.ws + OFF_CA);
  const u16* CB = (const u16*)(p.ws + OFF_CB);
  u16* BR = brbuf(p) + 256;
  float w[31];
#pragma unroll
  for (int j = 0; j < 31; ++j) w[j] = p.in[10][(layer * 31 + j) * 256 + ct];
  const float bias = p.in[11][layer * 256 + ct];
  const float4 lg = *(const float4*)(p.in[12] + layer * 256 + lane * 4);
  const float4 lbb = *(const float4*)(p.in[13] + layer * 256 + lane * 4);
  for (int it = obid(); it < 1280; it += gridDim.x) {
    const int t0 = (it * 2 + half) * 32;
    int seq, pos0, T;
    tokinfo(t0, seq, pos0, T);
    const int sb = t0 - pos0;
    {
      const int ch = ct & 31, rr = ct >> 5;
#pragma unroll
      for (int ps = 0; ps < 8; ++ps) {
        const int row = ps * 8 + rr;
        if (row < 62) {
          const int pos = pos0 - 15 + row;
          float u[8];
          if (pos >= 0 && pos < T) {
            uint4 a = *(const uint4*)(CA + (size_t)(sb + pos) * 256 + ch * 8);
            uint4 b = *(const uint4*)(CB + (size_t)(sb + pos) * 256 + ch * 8);
            u[0] = lo16(a.x) * lo16(b.x); u[1] = hi16(a.x) * hi16(b.x);
            u[2] = lo16(a.y) * lo16(b.y); u[3] = hi16(a.y) * hi16(b.y);
            u[4] = lo16(a.z) * lo16(b.z); u[5] = hi16(a.z) * hi16(b.z);
            u[6] = lo16(a.w) * lo16(b.w); u[7] = hi16(a.w) * hi16(b.w);
          } else {
#pragma unroll
            for (int e = 0; e < 8; ++e) u[e] = 0.f;
          }
          float* d = su + row * 256 + ch * 8;
          *(float4*)d = make_float4(u[0], u[1], u[2], u[3]);
          *(float4*)(d + 4) = make_float4(u[4], u[5], u[6], u[7]);
        }
      }
    }
    __syncthreads();
    float y[32];
#pragma unroll
    for (int t = 0; t < 32; ++t) y[t] = bias;
#pragma unroll
    for (int r = 0; r < 62; ++r) {
      const float uv = su[r * 256 + ct];
#pragma unroll
      for (int t = 0; t < 32; ++t) {
        const int j = r - t;
        if (j >= 0 && j < 31) y[t] += uv * w[j];
      }
    }
    __syncthreads();
#pragma unroll
    for (int t = 0; t < 32; ++t) su[t * 256 + ct] = y[t];
    __syncthreads();
#pragma unroll 1
    for (int tt = 0; tt < 8; ++tt) {
      const int t = (wid & 3) * 8 + tt;
      float4 v = *(const float4*)(su + t * 256 + lane * 4);
      float sm = wave_sum(v.x + v.y + v.z + v.w);
      const float mu = sm * (1.f / 256.f);
      float d0 = v.x - mu, d1 = v.y - mu, d2 = v.z - mu, d3 = v.w - mu;
      float vs = wave_sum(d0 * d0 + d1 * d1 + d2 * d2 + d3 * d3);
      const float rstd = rsqrtf(vs * (1.f / 256.f) + 1e-6f);
      float z0 = d0 * rstd * lg.x + lbb.x, z1 = d1 * rstd * lg.y + lbb.y, z2 = d2 * rstd * lg.z + lbb.z,
            z3 = d3 * rstd * lg.w + lbb.w;
      z0 *= sigmoidf_(z0); z1 *= sigmoidf_(z1); z2 *= sigmoidf_(z2); z3 *= sigmoidf_(z3);
      *(uint2*)(BR + (size_t)(t0 + t) * 1024 + lane * 4) = pack4(z0, z1, z2, z3);
    }
    __syncthreads();
  }
}

DEVI void phase_na(const Params& p, int layer, unsigned char* smem) {
  constexpr int KLD = 68, VLD = 488;
  u16* Ks = (u16*)smem;
  u16* Vs = (u16*)(smem + 65280);
  float* rpb = (float*)(smem + 65280 + 62464);
  const int tid = otid(), lane = tid & 63, wid = tid >> 6, fr = lane & 15, fq = lane >> 4;
  const u16* NQ = (const u16*)(p.ws + OFF_NQ);
  const u16* NK = (const u16*)(p.ws + OFF_NK);
  const u16* NVT = (const u16*)(p.ws + OFF_NVT);
  u16* BR = brbuf(p);
  for (int it = obid(); it < 2560; it += gridDim.x) {
    const int h = it & 3, jb = (it >> 2) & 3, rgi = it >> 4;
    int sb, T, rg;
    if (rgi < 128) { sb = (rgi >> 3) * 4096; T = 4096; rg = rgi & 7; }
    else { const int q = rgi - 128; sb = MP + (q >> 4) * 8192; T = 8192; rg = q & 15; }
    const int rows = T >> 6;
    const int r0 = rg * 8;
    int lo = r0 - 4; lo = lo < 0 ? 0 : (lo > rows - 8 ? rows - 8 : lo);
    int hi = r0 + 7 - 4; hi = hi < 0 ? 0 : (hi > rows - 8 ? rows - 8 : hi); hi += 7;
    const int nrow = hi - lo + 1;
    const int kb = jb == 0 ? 0 : (jb == 1 ? 8 : (jb == 2 ? 24 : 32));
    for (int i = tid; i < 465; i += NTHR) rpb[i] = p.in[14][(layer * 4 + h) * 465 + i];
    {
      const int nk = nrow * 32 * 8;
      for (int c = tid; c < nk; c += NTHR) {
        const int k = c >> 3, part = c & 7;
        const uint4 v = *(const uint4*)(NK + (size_t)(sb + (lo + (k >> 5)) * 64 + kb + (k & 31)) * 256 + h * 64 + part * 8);
        uint2* d = (uint2*)(Ks + k * KLD + part * 8);
        d[0] = make_uint2(v.x, v.y);
        d[1] = make_uint2(v.z, v.w);
      }
      const int nv = 64 * nrow * 4;
      for (int c = tid; c < nv; c += NTHR) {
        const int d = c / (nrow * 4), rem = c - d * (nrow * 4), seg = rem >> 2, part = rem & 3;
        const uint4 v = *(const uint4*)(NVT + (size_t)(h * 64 + d) * M + sb + (lo + seg) * 64 + kb + part * 8);
        *(uint4*)(Vs + vrow(d) * VLD + seg * 32 + part * 8) = v;
      }
    }
    __syncthreads();
    {
      const int r = r0 + wid;
      const int pos0 = r * 64 + jb * 16, tok0 = sb + pos0, qc0 = jb * 16;
      int start = r - 4;
      start = start < 0 ? 0 : (start > rows - 8 ? rows - 8 : start);
      const int rel0 = start - lo;
      const u16* qp = NQ + (size_t)(tok0 + fr) * 256 + h * 64 + fq * 8;
      const bf16x8 q0 = *(const bf16x8*)qp, q1 = *(const bf16x8*)(qp + 32);
      const int qcol = qc0 + fr;
      int wst = qcol - 8;
      wst = wst < 0 ? 0 : (wst > 48 ? 48 : wst);
      f32x4 s[16];
      float mx = -3e38f;
      const u16* kl0 = Ks + (rel0 * 32 + 8 * (fr >> 2) + (fr & 3)) * KLD + fq * 8;
#pragma unroll
      for (int t = 0; t < 16; ++t) {
        const int i = t >> 1, pp = t & 1;
        const u16* kp = kl0 + (i * 32 + pp * 4) * KLD;
        V8 k0, k1;
        k0.h[0] = *(const uint2*)kp;        k0.h[1] = *(const uint2*)(kp + 4);
        k1.h[0] = *(const uint2*)(kp + 32); k1.h[1] = *(const uint2*)(kp + 36);
        f32x4 a = {0.f, 0.f, 0.f, 0.f};
        a = mfma16(k0.v, q0, a);
        a = mfma16(k1.v, q1, a);
        const int dr = start + i - r + 7;
#pragma unroll
        for (int j = 0; j < 4; ++j) {
          const int kcol = kb + 8 * fq + 4 * pp + j;
          const int rel = kcol - wst;
          int dc = kcol - qcol + 15;
          dc = dc < 0 ? 0 : (dc > 30 ? 30 : dc);
          const bool ok = (rel >= 0) && (rel < 16);
          const float v = ok ? a[j] + rpb[dr * 31 + dc] : -1e30f;
          a[j] = v;
          mx = fmaxf(mx, v);
        }
        s[t] = a;
      }
      mx = fmaxf(mx, __shfl_xor(mx, 16));
      mx = fmaxf(mx, __shfl_xor(mx, 32));
      float sum = 0.f;
#pragma unroll
      for (int t = 0; t < 16; ++t)
#pragma unroll
        for (int j = 0; j < 4; ++j) { float e = fast_exp(s[t][j] - mx); s[t][j] = e; sum += e; }
      sum += __shfl_xor(sum, 16);
      sum += __shfl_xor(sum, 32);
      const float inv = fast_rcp(sum);
      f32x4 o[4];
#pragma unroll
      for (int dt = 0; dt < 4; ++dt) o[dt] = f32x4{0.f, 0.f, 0.f, 0.f};
      const u16* vl0 = Vs + fr * VLD + rel0 * 32 + fq * 8;
#pragma unroll
      for (int ks = 0; ks < 8; ++ks) {
        V8 pb;
        pb.h[0] = pack4(s[2 * ks][0] * inv, s[2 * ks][1] * inv, s[2 * ks][2] * inv, s[2 * ks][3] * inv);
        pb.h[1] = pack4(s[2 * ks + 1][0] * inv, s[2 * ks + 1][1] * inv, s[2 * ks + 1][2] * inv, s[2 * ks + 1][3] * inv);
#pragma unroll
        for (int dt = 0; dt < 4; ++dt) {
          V8 va;
          va.u = *(const uint4*)(vl0 + dt * 16 * VLD + ks * 32);
          o[dt] = mfma16(va.v, pb.v, o[dt]);
        }
      }
#pragma unroll
      for (int pp = 0; pp < 2; ++pp) {
        uint4 w;
        w.x = pack2(o[2 * pp][0], o[2 * pp][1]); w.y = pack2(o[2 * pp][2], o[2 * pp][3]);
        w.z = pack2(o[2 * pp + 1][0], o[2 * pp + 1][1]); w.w = pack2(o[2 * pp + 1][2], o[2 * pp + 1][3]);
        *(uint4*)(BR + (size_t)(tok0 + fr) * 1024 + 512 + h * 64 + pp * 32 + fq * 8) = w;
      }
    }
    __syncthreads();
  }
}

DEVI int t5_bucket_dev(int rel) {
  int n = rel < 0 ? -rel : rel;
  int b;
  if (n < 8) b = n;
  else b = 8 + (n >= 12) + (n >= 16) + (n >= 23) + (n >= 32) + (n >= 46) + (n >= 64) + (n >= 91);
  return (rel > 0 ? 16 : 0) + b;
}

DEVI void phase_swa(const Params& p, int layer, unsigned char* smem) {
  constexpr int KLD = 68, VLD = 392;
  u16* Ks = (u16*)smem;
  u16* Vs = (u16*)(smem + 52224);
  float* lut = (float*)(smem + 52224 + 50176);
  const int tid = otid(), lane = tid & 63, wid = tid >> 6, fr = lane & 15, fq = lane >> 4;
  const u16* SQ = (const u16*)(p.ws + OFF_SQ);
  const u16* SK = (const u16*)(p.ws + OFF_SK);
  const u16* SVT = (const u16*)(p.ws + OFF_SVT);
  u16* BR = brbuf(p);
  for (int it = obid(); it < 1280; it += gridDim.x) {
    const int hkv = it & 1, blk = it >> 1, tokb = blk * 128;
    int seq, posb, T;
    tokinfo(tokb, seq, posb, T);
    const int sb = tokb - posb;
    const int wlo = posb - 128;
    for (int i = tid; i < 2 * 257; i += NTHR) {
      const int g = i / 257, rel = (i % 257) - 128;
      lut[i] = p.in[16][t5_bucket_dev(rel) * 4 + hkv * 2 + g];
    }
    for (int c = tid; c < 64 * 48; c += NTHR) {
      const int d = c / 48, rem = c - d * 48, kofs = (rem >> 2) * 32 + (rem & 3) * 8, kpos = wlo + kofs;
      uint4 v = make_uint4(0u, 0u, 0u, 0u);
      if (kpos >= 0 && kpos < T) v = *(const uint4*)(SK + (size_t)(hkv * 64 + d) * M + sb + kpos);
      u16* kd = Ks + kofs * KLD + d;
      kd[0 * KLD] = (u16)(v.x & 0xffffu); kd[1 * KLD] = (u16)(v.x >> 16);
      kd[2 * KLD] = (u16)(v.y & 0xffffu); kd[3 * KLD] = (u16)(v.y >> 16);
      kd[4 * KLD] = (u16)(v.z & 0xffffu); kd[5 * KLD] = (u16)(v.z >> 16);
      kd[6 * KLD] = (u16)(v.w & 0xffffu); kd[7 * KLD] = (u16)(v.w >> 16);
    }
    for (int c = tid; c < 64 * 48; c += NTHR) {
      const int d = c / 48, rem = c - d * 48, kofs = (rem >> 2) * 32 + (rem & 3) * 8, kpos = wlo + kofs;
      uint4 v = make_uint4(0u, 0u, 0u, 0u);
      if (kpos >= 0 && kpos < T) v = *(const uint4*)(SVT + (size_t)(hkv * 64 + d) * M + sb + kpos);
      *(uint4*)(Vs + vrow(d) * VLD + kofs) = v;
    }
    __syncthreads();
    const int pos0 = posb + wid * 16, tok0 = sb + pos0;
    const int b0 = wid >> 1;
    const int qoff = 128 + (wid & 1) * 16;
    const u16* kl0 = Ks + (b0 * 32 + 8 * (fr >> 2) + (fr & 3)) * KLD + fq * 8;
    const u16* vl0 = Vs + fr * VLD + b0 * 32 + fq * 8;
#pragma unroll 1
    for (int g = 0; g < 2; ++g) {
      const int hq = hkv * 2 + g;
      const float sink = p.in[15][layer * 4 + hq];
      const u16* qp = SQ + (size_t)(tok0 + fr) * 256 + hq * 64 + fq * 8;
      const bf16x8 q0 = *(const bf16x8*)qp, q1 = *(const bf16x8*)(qp + 32);
      f32x4 s[18];
      float mx = sink;
#pragma unroll
      for (int t = 0; t < 18; ++t) {
        const int bs = wlo + (b0 + (t >> 1)) * 32;
        const bool bv = (bs >= 0) && (bs < T);
        const u16* kp = kl0 + ((t >> 1) * 32 + (t & 1) * 4) * KLD;
        V8 k0, k1;
        k0.h[0] = *(const uint2*)kp;        k0.h[1] = *(const uint2*)(kp + 4);
        k1.h[0] = *(const uint2*)(kp + 32); k1.h[1] = *(const uint2*)(kp + 36);
        f32x4 a = {0.f, 0.f, 0.f, 0.f};
        a = mfma16(k0.v, q0, a);
        a = mfma16(k1.v, q1, a);
#pragma unroll
        for (int j = 0; j < 4; ++j) {
          const int rel = (t >> 1) * 32 + 8 * fq + 4 * (t & 1) + j - qoff - fr;
          const bool ok = bv && rel >= -128 && rel <= 128;
          int li = rel + 128;
          li = li < 0 ? 0 : (li > 256 ? 256 : li);
          const float v = ok ? a[j] + lut[g * 257 + li] : -1e30f;
          a[j] = v;
          mx = fmaxf(mx, v);
        }
        s[t] = a;
        asm volatile("" ::: "memory");
      }
      mx = fmaxf(mx, __shfl_xor(mx, 16));
      mx = fmaxf(mx, __shfl_xor(mx, 32));
      float sum = 0.f;
#pragma unroll
      for (int t = 0; t < 18; ++t)
#pragma unroll
        for (int j = 0; j < 4; ++j) { float e = fast_exp(s[t][j] - mx); s[t][j] = e; sum += e; }
      sum += __shfl_xor(sum, 16);
      sum += __shfl_xor(sum, 32);
      const float inv = fast_rcp(sum + fast_exp(sink - mx));
      f32x4 o[4];
#pragma unroll
      for (int dt = 0; dt < 4; ++dt) o[dt] = f32x4{0.f, 0.f, 0.f, 0.f};
#pragma unroll
      for (int ks = 0; ks < 9; ++ks) {
        V8 pb;
        pb.h[0] = pack4(s[2 * ks][0] * inv, s[2 * ks][1] * inv, s[2 * ks][2] * inv, s[2 * ks][3] * inv);
        pb.h[1] = pack4(s[2 * ks + 1][0] * inv, s[2 * ks + 1][1] * inv, s[2 * ks + 1][2] * inv, s[2 * ks + 1][3] * inv);
#pragma unroll
        for (int dt = 0; dt < 4; ++dt) {
          V8 va;
          va.u = *(const uint4*)(vl0 + dt * 16 * VLD + ks * 32);
          o[dt] = mfma16(va.v, pb.v, o[dt]);
        }
        asm volatile("" ::: "memory");
      }
#pragma unroll
      for (int pp = 0; pp < 2; ++pp) {
        uint4 w;
        w.x = pack2(o[2 * pp][0], o[2 * pp][1]); w.y = pack2(o[2 * pp][2], o[2 * pp][3]);
        w.z = pack2(o[2 * pp + 1][0], o[2 * pp + 1][1]); w.w = pack2(o[2 * pp + 1][2], o[2 * pp + 1][3]);
        *(uint4*)(BR + (size_t)(tok0 + fr) * 1024 + 768 + hq * 64 + pp * 32 + fq * 8) = w;
      }
    }
    __syncthreads();
  }
}

struct TileOrder {
  int pm, pn; bool gate; size_t a0, b0;
  DEVI bool next(int ui, g8::Unit& u) const {
    if (ui >= 4) return false;
    u.pm = pm; u.pn = pn; u.aux = ui;
    if (gate) {
      u.nt = 16;
      u.aoff = a0 + (size_t)pm * 256 * 1024 * 2;
      u.boff = b0 + ((size_t)ui * 1024 + pn * 256) * 1024 * 2;
    } else {
      u.nt = 4;
      u.aoff = a0 + ((size_t)pm * 256 * 1024 + ui * 256) * 2;
      u.boff = b0 + ((size_t)pn * 256 * 1024 + ui * 256) * 2;
    }
    return true;
  }
};
struct EpiGateTile {
  u16* scr;
  DEVI bool operator()(f32x4 (&acc)[2][2][4][2], const g8::Unit& u, int wr, int wc, int fr, int fq) const {
    u16* o0 = scr + u.aux * 65536 + (wr * 64 + fr) * 256 + wc * 32 + fq * 8;
#pragma unroll
    for (int ai = 0; ai < 2; ++ai)
#pragma unroll
      for (int m = 0; m < 4; ++m) {
        u16* orow = o0 + (ai * 128 + m * 16) * 256;
#pragma unroll
        for (int bj = 0; bj < 2; ++bj) {
          const f32x4 v0 = acc[ai][bj][m][0], v1 = acc[ai][bj][m][1];
          uint4 w;
          w.x = pack2(sigmoidf_(v0[0]), sigmoidf_(v0[1])); w.y = pack2(sigmoidf_(v0[2]), sigmoidf_(v0[3]));
          w.z = pack2(sigmoidf_(v1[0]), sigmoidf_(v1[1])); w.w = pack2(sigmoidf_(v1[2]), sigmoidf_(v1[3]));
          *(uint4*)(orow + bj * 128) = w;
        }
        asm volatile("" ::: "memory");
      }
    return true;
  }
};
struct EpiMergeTile {
  const u16* scr; u16* MG;
  DEVI bool operator()(f32x4 (&acc)[2][2][4][2], const g8::Unit& u, int wr, int wc, int fr, int fq) const {
    const int i = u.aux;
    const bool last = (i == 3);
    const int gbo = last ? 0 : 65536;
    const u16* g0 = scr + i * 65536 + (wr * 64 + fr) * 256 + wc * 32 + fq * 8;
    u16* o0 = MG + (size_t)(u.pm * 256 + wr * 64 + fr) * 1024 + u.pn * 256 + wc * 32 + fq * 8;
#pragma unroll
    for (int ai = 0; ai < 2; ++ai) {
      uint4 ga[4][2], gb[4][2];
#pragma unroll
      for (int m = 0; m < 4; ++m) {
        const u16* gr = g0 + (ai * 128 + m * 16) * 256;
#pragma unroll
        for (int bj = 0; bj < 2; ++bj) {
          ga[m][bj] = *(const uint4*)(gr + bj * 128);
          gb[m][bj] = *(const uint4*)(gr + gbo + bj * 128);
        }
      }
      asm volatile("" ::: "memory");
#pragma unroll
      for (int m = 0; m < 4; ++m) {
        u16* orow = o0 + (size_t)(ai * 128 + m * 16) * 1024;
#pragma unroll
        for (int bj = 0; bj < 2; ++bj) {
          const uint4 a4 = ga[m][bj], b4 = gb[m][bj];
          f32x4 v0 = acc[ai][bj][m][0], v1 = acc[ai][bj][m][1];
          v0[0] *= lo16(a4.x) * (last ? 1.f : fast_rcp(lo16(b4.x)));
          v0[1] *= hi16(a4.x) * (last ? 1.f : fast_rcp(hi16(b4.x)));
          v0[2] *= lo16(a4.y) * (last ? 1.f : fast_rcp(lo16(b4.y)));
          v0[3] *= hi16(a4.y) * (last ? 1.f : fast_rcp(hi16(b4.y)));
          v1[0] *= lo16(a4.z) * (last ? 1.f : fast_rcp(lo16(b4.z)));
          v1[1] *= hi16(a4.z) * (last ? 1.f : fast_rcp(hi16(b4.z)));
          v1[2] *= lo16(a4.w) * (last ? 1.f : fast_rcp(lo16(b4.w)));
          v1[3] *= hi16(a4.w) * (last ? 1.f : fast_rcp(hi16(b4.w)));
          acc[ai][bj][m][0] = v0;
          acc[ai][bj][m][1] = v1;
          if (last) {
            uint4 w;
            w.x = pack2(v0[0], v0[1]); w.y = pack2(v0[2], v0[3]); w.z = pack2(v1[0], v1[1]); w.w = pack2(v1[2], v1[3]);
            *(uint4*)(orow + bj * 128) = w;
          }
        }
      }
      asm volatile("" ::: "memory");
    }
    return last;
  }
};
DEVI void stage_wait(unsigned* cnt);
DEVI void phase_gm(const Params& p, int layer, unsigned char* smem, unsigned* mixers_done) {
  g8::Order tiles;
  tiles.init(M / 256, 4, gridDim.x, obid(), 1024);
  const int bid = obid();
  u16* scr = bid < 80 ? (u16*)(p.ws + OFF_RKT) + (size_t)bid * 4 * 65536
           : (bid < 240 ? (u16*)(p.ws + OFF_U) + (size_t)(bid - 80) * 4 * 65536
                        : (u16*)(p.ws + OFF_END + 65536) + (size_t)(bid - 240) * 4 * 65536);
#pragma unroll 1
  for (int r = 0;; ++r) {
    g8::Unit tu;
    if (!tiles.next(r, tu)) break;
    {
      TileOrder S{tu.pm, tu.pn, true, 0, OFF_WMERGE + (size_t)layer * SZ_WMERGE * 2};
      EpiGateTile e{scr};
      g8::gemm_phase<true>((LAS unsigned char*)smem, hbuf(p), (const u16*)p.ws, 1024, S, e);
    }
    if (r == 0) stage_wait(mixers_done);
    {
      TileOrder S{tu.pm, tu.pn, false, (size_t)M * 1024 * 2, OFF_WBRANCH + (size_t)layer * SZ_WBRANCH * 2};
      EpiMergeTile e{scr, (u16*)(p.ws + OFF_MERGED)};
      g8::gemm_phase<true>((LAS unsigned char*)smem, hbuf(p), (const u16*)p.ws, 1024, S, e);
    }
  }
}

template <bool FIRST>
struct EpiResid {
  u16* xb; const float* mod; int layer, gsel;
  const float* xp; const float* xs;
  DEVI bool operator()(f32x4 (&acc)[2][2][4][2], const g8::Unit& u, int wr, int wc, int fr, int fq) const {
    const int t0 = u.pm * 256;
    int seq, pos0, T;
    tokinfo(t0, seq, pos0, T);
    const float* gp = mod + (size_t)(layer * 18 + seq) * 6144 + gsel * 1024 + u.pn * 256 + wc * 32 + fq * 8;
    float4 g[2][2];
#pragma unroll
    for (int bj = 0; bj < 2; ++bj)
#pragma unroll
      for (int n = 0; n < 2; ++n) g[bj][n] = *(const float4*)(gp + bj * 128 + n * 4);
    const size_t lo = (size_t)(wr * 64 + fr) * 1024 + u.pn * 256 + wc * 32 + fq * 8;
    u16* o0 = xb + (size_t)t0 * 1024 + lo;
    if (FIRST) {
      const float* i0 = (t0 < MP ? xp + (size_t)t0 * 1024 : xs + (size_t)(t0 - MP) * 1024) + lo;
#pragma unroll
      for (int ai = 0; ai < 2; ++ai)
#pragma unroll
        for (int mh = 0; mh < 2; ++mh) {
          float4 x[2][2][2];
#pragma unroll
          for (int m2 = 0; m2 < 2; ++m2)
#pragma unroll
            for (int bj = 0; bj < 2; ++bj) {
              const float* ip = i0 + (size_t)(ai * 128 + (mh * 2 + m2) * 16) * 1024 + bj * 128;
              x[m2][bj][0] = *(const float4*)ip;
              x[m2][bj][1] = *(const float4*)(ip + 4);
            }
          asm volatile("" ::: "memory");
#pragma unroll
          for (int m2 = 0; m2 < 2; ++m2) {
            const int m = mh * 2 + m2;
            u16* rowp = o0 + (size_t)(ai * 128 + m * 16) * 1024;
#pragma unroll
            for (int bj = 0; bj < 2; ++bj) {
              const float4 xa = x[m2][bj][0], xc = x[m2][bj][1];
              const f32x4 v0 = acc[ai][bj][m][0], v1 = acc[ai][bj][m][1];
              uint4 w;
              w.x = pack2(xa.x + g[bj][0].x * v0[0], xa.y + g[bj][0].y * v0[1]);
              w.y = pack2(xa.z + g[bj][0].z * v0[2], xa.w + g[bj][0].w * v0[3]);
              w.z = pack2(xc.x + g[bj][1].x * v1[0], xc.y + g[bj][1].y * v1[1]);
              w.w = pack2(xc.z + g[bj][1].z * v1[2], xc.w + g[bj][1].w * v1[3]);
              *(uint4*)(rowp + bj * 128) = w;
            }
          }
          asm volatile("" ::: "memory");
        }
    } else {
#pragma unroll
      for (int ai = 0; ai < 2; ++ai) {
        uint4 xw[4][2];
#pragma unroll
        for (int m = 0; m < 4; ++m)
#pragma unroll
          for (int bj = 0; bj < 2; ++bj) xw[m][bj] = *(const uint4*)(o0 + (size_t)(ai * 128 + m * 16) * 1024 + bj * 128);
        asm volatile("" ::: "memory");
#pragma unroll
        for (int m = 0; m < 4; ++m) {
          u16* rowp = o0 + (size_t)(ai * 128 + m * 16) * 1024;
#pragma unroll
          for (int bj = 0; bj < 2; ++bj) {
            const uint4 xv = xw[m][bj];
            const f32x4 v0 = acc[ai][bj][m][0], v1 = acc[ai][bj][m][1];
            uint4 w;
            w.x = pack2(lo16(xv.x) + g[bj][0].x * v0[0], hi16(xv.x) + g[bj][0].y * v0[1]);
            w.y = pack2(lo16(xv.y) + g[bj][0].z * v0[2], hi16(xv.y) + g[bj][0].w * v0[3]);
            w.z = pack2(lo16(xv.z) + g[bj][1].x * v1[0], hi16(xv.z) + g[bj][1].y * v1[1]);
            w.w = pack2(lo16(xv.w) + g[bj][1].z * v1[2], hi16(xv.w) + g[bj][1].w * v1[3]);
            *(uint4*)(rowp + bj * 128) = w;
          }
        }
        asm volatile("" ::: "memory");
      }
    }
    return true;
  }
};
DEVI void phase_resid(const Params& p, int layer, const u16* A, int K, const u16* Wt, int gsel, unsigned char* smem) {
  g8::Order S;
  S.init(M / 256, 4, gridDim.x, obid(), K);
  if (layer == 0 && gsel == 2) {
    EpiResid<true> e{xbuf(p), (const float*)(p.ws + OFF_MOD), layer, gsel, p.in[0], p.in[1]};
    g8::gemm_phase<true>((LAS unsigned char*)smem, A, Wt, K, S, e);
  } else {
    EpiResid<false> e{xbuf(p), (const float*)(p.ws + OFF_MOD), layer, gsel, nullptr, nullptr};
    g8::gemm_phase<true>((LAS unsigned char*)smem, A, Wt, K, S, e);
  }
}

struct EpiFF1 {
  u16* HID;
  DEVI bool operator()(f32x4 (&acc)[2][2][4][2], const g8::Unit& u, int wr, int wc, int fr, int fq) const {
    u16* o0 = HID + (size_t)(u.pm * 256 + wr * 64 + fr) * 4096 + u.pn * 256 + wc * 32 + fq * 8;
#pragma unroll
    for (int ai = 0; ai < 2; ++ai)
#pragma unroll
      for (int m = 0; m < 4; ++m) {
        u16* orow = o0 + (size_t)(ai * 128 + m * 16) * 4096;
#pragma unroll
        for (int bj = 0; bj < 2; ++bj) {
          const f32x4 v0 = acc[ai][bj][m][0], v1 = acc[ai][bj][m][1];
          const float a0 = fmaxf(v0[0], 0.f), a1 = fmaxf(v0[1], 0.f), a2 = fmaxf(v0[2], 0.f), a3 = fmaxf(v0[3], 0.f);
          const float b0 = fmaxf(v1[0], 0.f), b1 = fmaxf(v1[1], 0.f), b2 = fmaxf(v1[2], 0.f), b3 = fmaxf(v1[3], 0.f);
          uint4 w;
          w.x = pack2(a0 * a0, a1 * a1); w.y = pack2(a2 * a2, a3 * a3);
          w.z = pack2(b0 * b0, b1 * b1); w.w = pack2(b2 * b2, b3 * b3);
          *(uint4*)(orow + bj * 128) = w;
        }
        asm volatile("" ::: "memory");
      }
    return true;
  }
};
DEVI void phase_ff1(const Params& p, int layer, unsigned char* smem) {
  g8::Order S;
  S.init(M / 256, 16, gridDim.x, obid(), 1024);
  EpiFF1 e{(u16*)(p.ws + OFF_HID)};
  g8::gemm_phase<true>((LAS unsigned char*)smem, hbuf(p), (const u16*)(p.ws + OFF_WFF1) + (size_t)layer * SZ_WFF, 1024, S, e);
}

struct CtrBarrier { unsigned* ctr; unsigned target; };
DEVI void ctr_barrier(CtrBarrier& b) {
  asm volatile("s_waitcnt vmcnt(0)" ::: "memory");
  __syncthreads();
  b.target += gridDim.x;
  if (threadIdx.x == 0) {
    __builtin_amdgcn_fence(__ATOMIC_RELEASE, "agent");
    asm volatile("s_waitcnt vmcnt(0)" ::: "memory");
    __hip_atomic_fetch_add(b.ctr, 1u, __ATOMIC_RELAXED, __HIP_MEMORY_SCOPE_AGENT);
    unsigned spins = 0;
    while (__hip_atomic_load(b.ctr, __ATOMIC_RELAXED, __HIP_MEMORY_SCOPE_AGENT) < b.target) {
      __builtin_amdgcn_s_sleep(1);
      if (++spins > (1u << 22)) break;
    }
    __builtin_amdgcn_fence(__ATOMIC_ACQUIRE, "agent");
    asm volatile("s_waitcnt vmcnt(0)" ::: "memory");
  }
  __syncthreads();
}

DEVI void stage_signal(unsigned* cnt) {
  asm volatile("s_waitcnt vmcnt(0)" ::: "memory");
  __syncthreads();
  if (threadIdx.x == 0) {
    __builtin_amdgcn_fence(__ATOMIC_RELEASE, "agent");
    asm volatile("s_waitcnt vmcnt(0)" ::: "memory");
    __hip_atomic_fetch_add(cnt, 1u, __ATOMIC_RELAXED, __HIP_MEMORY_SCOPE_AGENT);
  }
}
DEVI void stage_wait(unsigned* cnt) {
  __syncthreads();
  if (threadIdx.x == 0) {
    unsigned spins = 0;
    while (__hip_atomic_load(cnt, __ATOMIC_RELAXED, __HIP_MEMORY_SCOPE_AGENT) < gridDim.x) {
      __builtin_amdgcn_s_sleep(1);
      if (++spins > (1u << 22)) break;
    }
    __builtin_amdgcn_fence(__ATOMIC_ACQUIRE, "agent");
    asm volatile("s_waitcnt vmcnt(0)" ::: "memory");
  }
  __syncthreads();
}

#define REP_GATES 1
#define REP_NA 1
#define REP_SWA 1
#define REP_C1 1
#define REP_C2 1
#define REP_C3 1
#define REP_FF1 1
#define REP_G1 1
#define REP_MERGE 1
#ifndef REP_MIX
#define REP_MIX 1
#endif
__global__ void __launch_bounds__(512, 2) trunk_megakernel(Params p) {
  cg::grid_group grid = cg::this_grid();
  __shared__ __attribute__((aligned(16))) unsigned char smem[SMEM_BYTES];
  CtrBarrier cb{(unsigned*)(p.ws + OFF_BAR), 0u};
  if (blockIdx.x == 0 && threadIdx.x < 8) cb.ctr[threadIdx.x * 16] = 0u;

  phase0(p, smem);
  grid.sync();
#pragma unroll 1
  for (int l = 0; l < 2; ++l) {
    phase_norm(p, l, 0);
    ctr_barrier(cb);
#pragma unroll 1
    for (int rep = 0; rep < REP_G1; ++rep) {
    phase_gemm1(p, l, smem);
    ctr_barrier(cb);
    }
    {
      unsigned* cntA = cb.ctr + 16 * (1 + 2 * l), * cntB = cb.ctr + 16 * (2 + 2 * l);
      phase_ret_u(p, l);
      stage_signal(cntA);
      phase_conv(p, l, smem);
      phase_na(p, l, smem);
      stage_wait(cntA);
      phase_ret_scan(p, l);
      stage_signal(cntB);
      phase_swa(p, l, smem);
      stage_wait(cntB);
      phase_ret_out(p, l, smem);
      stage_signal(cb.ctr + 16 * (5 + l));
    }
    phase_gm(p, l, smem, cb.ctr + 16 * (5 + l));
    ctr_barrier(cb);
    phase_resid(p, l, (const u16*)(p.ws + OFF_MERGED), 1024, (const u16*)(p.ws + OFF_WOUT) + (size_t)l * SZ_WOUT, 2, smem);
    ctr_barrier(cb);
    phase_norm(p, l, 1);
    ctr_barrier(cb);
#pragma unroll 1
    for (int rep = 0; rep < REP_FF1; ++rep) {
    phase_ff1(p, l, smem);
    ctr_barrier(cb);
    }
    phase_resid(p, l, (const u16*)(p.ws + OFF_HID), 4096, (const u16*)(p.ws + OFF_WFF2) + (size_t)l * SZ_WFF, 5, smem);
    ctr_barrier(cb);
  }
  phase_final(p);
}

extern "C" void kernel_launch(void* const* d_in, const int* in_sizes, int n_in, void* d_out, int out_size, void* d_ws,
                              size_t ws_size, hipStream_t stream) {
  static int grid_blocks = 0;
  if (!grid_blocks) {
    int dev = 0, cus = 0, per_cu = 0;
    (void)hipGetDevice(&dev);
    (void)hipDeviceGetAttribute(&cus, hipDeviceAttributeMultiprocessorCount, dev);
    (void)hipOccupancyMaxActiveBlocksPerMultiprocessor(&per_cu, trunk_megakernel, NTHR, 0);
    if (per_cu > 1) per_cu = 1;
    grid_blocks = (cus * per_cu / 8) * 8;
  }
  Params p{};
  for (int i = 0; i < 23; ++i) p.in[i] = (const float*)d_in[i];
  p.out = (float*)d_out;
  p.ws = (unsigned char*)d_ws;
  if (ws_size < WS_NEED) fprintf(stderr, "workspace too small: %zu < %zu\n", ws_size, (size_t)WS_NEED);
  void* args[] = {&p};
  hipError_t e = hipLaunchCooperativeKernel((void*)trunk_megakernel, dim3(grid_blocks), dim3(NTHR), args, 0, stream);
  if (e != hipSuccess) fprintf(stderr, "cooperative launch failed: %s (grid %d)\n", hipGetErrorString(e), grid_blocks);
}
```
